# Optimizing an MI355X kernel written in HIP

```python
import math
import jax
import jax.numpy as jnp
from jax import lax
import numpy as np

D_MODEL = 1024
BATCH = 4
SEQ = 4096
DEPTH = 2

HEAD_DIM = 64
D_MIX = D_MODEL
N_HEADS_MIX = D_MIX // HEAD_DIM
A_HEADS = N_HEADS_MIX // 4
A_WIDTH = A_HEADS * HEAD_DIM
DILATED_PATTERNS = ((128, 1), (512, 4), (2048, 16))
C_HEADS = N_HEADS_MIX // 4
C_WIDTH = C_HEADS * HEAD_DIM
MOBA_BLOCK = 256
MOBA_TOPK = 3
MOBA_Q_CHUNK = 64
B_HEADS = N_HEADS_MIX - A_HEADS - C_HEADS
SSM_HEAD_DIM = HEAD_DIM
D_SSM = B_HEADS * SSM_HEAD_DIM
SSM_STATE = 128
SSM_GROUPS = 2
SSM_CONV = 4
SSM_CHUNK = 128
CONV_DIM = D_SSM + 2 * SSM_GROUPS * SSM_STATE
D_FF = 4 * D_MODEL
D_IN = 3 * A_WIDTH + 3 * C_WIDTH + D_SSM + CONV_DIM + B_HEADS
H_ATTN = A_HEADS + C_HEADS
EPS = 1e-6
NEG_INF = -1e30

kernel_name = "hybrid_dilated_ssd_moba_block"


def rms_norm(x, w):
    xf = x.astype(jnp.float32)
    y = xf * lax.rsqrt(jnp.mean(xf * xf, axis=-1, keepdims=True) + EPS)
    return (y * w.astype(jnp.float32)).astype(x.dtype)


def alibi_slopes():
    return 2.0 ** (-8.0 * jnp.arange(1, H_ATTN + 1, dtype=jnp.float32) / H_ATTN)


def dilated_band_attention(q, k, v, slopes, window, dilation):
    bsz, seq, nh, hd = q.shape
    n_off = window // dilation
    blk = n_off
    length = seq // dilation
    n_blk = -(-length // blk)
    lp = n_blk * blk

    def to_sub(t):
        return t.reshape(bsz, length, dilation, nh, hd).transpose(0, 2, 1, 3, 4)

    qs = jnp.pad(to_sub(q), ((0, 0), (0, 0), (0, lp - length), (0, 0), (0, 0)))
    qs = qs.reshape(bsz, dilation, n_blk, blk, nh, hd)
    pad_kv = ((0, 0), (0, 0), (blk, lp - length), (0, 0), (0, 0))

    def windows(t):
        tb = jnp.pad(to_sub(t), pad_kv).reshape(bsz, dilation, n_blk + 1, blk, nh, hd)
        return jnp.concatenate([tb[:, :, :-1], tb[:, :, 1:]], axis=3)

    kw, vw = windows(k), windows(v)
    logits = jnp.einsum('brmahe,brmche->brhmac', qs, kw) * (hd ** -0.5)
    a_idx = jnp.arange(blk)[:, None]
    c_idx = jnp.arange(2 * blk)[None, :]
    offset = a_idx + blk - c_idx
    key_idx = jnp.arange(n_blk)[:, None, None] * blk - blk + c_idx[None]
    valid = (offset >= 0) & (offset <= n_off) & (key_idx >= 0)
    bias = -slopes[:, None, None, None] * (dilation * offset).astype(jnp.float32)
    logits = jnp.where(valid, logits + bias, NEG_INF)
    lse = jax.nn.logsumexp(logits, axis=-1)
    probs = jnp.exp(logits - lse[..., None])
    out = jnp.einsum('brhmac,brmche->brmahe', probs, vw)
    out = out.reshape(bsz, dilation, lp, nh, hd)[:, :, :length]
    out = out.transpose(0, 2, 1, 3, 4).reshape(bsz, seq, nh, hd)
    lse = lse.transpose(0, 1, 3, 4, 2).reshape(bsz, dilation, lp, nh)[:, :, :length]
    lse = lse.transpose(0, 2, 1, 3).reshape(bsz, seq, nh)
    return out, lse


def dilated_mixture(q, k, v, slopes):
    outs, lses = [], []
    for window, dilation in DILATED_PATTERNS:
        o, l = dilated_band_attention(q, k, v, slopes, window, dilation)
        outs.append(o)
        lses.append(l)
    w = jax.nn.softmax(jnp.stack(lses, axis=0), axis=0)
    return jnp.einsum('pbsh,pbshe->bshe', w, jnp.stack(outs, axis=0))


def causal_depthwise_conv(x, w, b):
    out = lax.conv_general_dilated(
        x, w[:, None, :].astype(x.dtype), window_strides=(1,),
        padding=((SSM_CONV - 1, 0),), dimension_numbers=('NWC', 'WIO', 'NWC'),
        feature_group_count=x.shape[-1])
    return out + b.astype(x.dtype)


def segsum_exp(a_cs):
    l = a_cs.shape[-1]
    mask = jnp.tril(jnp.ones((l, l), dtype=bool))
    diff = a_cs[..., :, None] - a_cs[..., None, :]
    return jnp.where(mask, jnp.exp(jnp.where(mask, diff, 0.0)), 0.0)


def ssd_scan(x, dt, a, b_mat, c_mat):
    bsz, seq, nh, hp = x.shape
    nc, l = seq // SSM_CHUNK, SSM_CHUNK
    xd = (x * dt[..., None]).reshape(bsz, nc, l, nh, hp)
    da = (dt * a).reshape(bsz, nc, l, nh).transpose(0, 1, 3, 2)
    bc = b_mat.reshape(bsz, nc, l, nh, -1)
    cc = c_mat.reshape(bsz, nc, l, nh, -1)
    a_cs = jnp.cumsum(da, axis=-1)
    scores = jnp.einsum('bclhn,bcshn->bchls', cc, bc) * segsum_exp(a_cs)
    y_diag = jnp.einsum('bchls,bcshp->bclhp', scores, xd)
    decay_states = jnp.exp(a_cs[..., -1:] - a_cs)
    chunk_states = jnp.einsum('bclhn,bchl,bclhp->bchpn', bc, decay_states, xd)
    chunk_decay = jnp.exp(a_cs[..., -1])

    def step(state, inp):
        cs, dec = inp
        return state * dec[..., None, None] + cs, state

    init = jnp.zeros((bsz, nh, hp, bc.shape[-1]), jnp.float32)
    _, states_in = lax.scan(step, init, (chunk_states.transpose(1, 0, 2, 3, 4),
                                         chunk_decay.transpose(1, 0, 2)))
    states_in = states_in.transpose(1, 0, 2, 3, 4)
    y_off = jnp.einsum('bclhn,bchpn,bchl->bclhp', cc, states_in, jnp.exp(a_cs))
    return (y_diag + y_off).reshape(bsz, seq, nh, hp)


def mamba2_mixer(z, xbc, dt_raw, conv_w, conv_b, dt_bias, a_log, d_skip, norm_w):
    bsz, seq, _ = z.shape
    xbc = jax.nn.silu(causal_depthwise_conv(xbc, conv_w, conv_b)).astype(jnp.float32)
    xs = xbc[..., :D_SSM].reshape(bsz, seq, B_HEADS, SSM_HEAD_DIM)
    rep = B_HEADS // SSM_GROUPS
    bm = jnp.repeat(xbc[..., D_SSM:D_SSM + SSM_GROUPS * SSM_STATE].reshape(bsz, seq, SSM_GROUPS, SSM_STATE), rep, axis=2)
    cm = jnp.repeat(xbc[..., D_SSM + SSM_GROUPS * SSM_STATE:].reshape(bsz, seq, SSM_GROUPS, SSM_STATE), rep, axis=2)
    dt = jax.nn.softplus(dt_raw.astype(jnp.float32) + dt_bias.astype(jnp.float32))
    a = -jnp.exp(a_log.astype(jnp.float32))
    y = ssd_scan(xs, dt, a, bm, cm) + d_skip.astype(jnp.float32)[:, None] * xs
    y = y.reshape(bsz, seq, D_SSM) * jax.nn.silu(z.astype(jnp.float32))
    y = rms_norm(y.reshape(bsz, seq, SSM_GROUPS, D_SSM // SSM_GROUPS),
                 norm_w.reshape(SSM_GROUPS, D_SSM // SSM_GROUPS))
    return y.reshape(bsz, seq, D_SSM)


def moba_attention(q, k, v, slopes):
    bsz, seq, nh, hd = q.shape
    n_blk = -(-seq // MOBA_BLOCK)
    sp = n_blk * MOBA_BLOCK
    pad = ((0, 0), (0, sp - seq), (0, 0), (0, 0))
    q, k, v = jnp.pad(q, pad), jnp.pad(k, pad), jnp.pad(v, pad)
    kb = k.reshape(bsz, n_blk, MOBA_BLOCK, nh, hd)
    vb = v.reshape(bsz, n_blk, MOBA_BLOCK, nh, hd)
    k_mean = kb.mean(axis=2)
    kbh = kb.transpose(0, 3, 1, 2, 4)
    vbh = vb.transpose(0, 3, 1, 2, 4)
    n_sel = min(MOBA_TOPK, n_blk - 1)
    chunks_per_blk = MOBA_BLOCK // MOBA_Q_CHUNK
    n_chunks = sp // MOBA_Q_CHUNK
    scale = hd ** -0.5
    q_chunks = q.reshape(bsz, n_chunks, MOBA_Q_CHUNK, nh, hd).transpose(1, 0, 2, 3, 4)
    in_blk = jnp.arange(MOBA_BLOCK)
    b_idx = jnp.arange(bsz)[:, None, None, None]
    h_idx = jnp.arange(nh)[None, None, :, None]

    def chunk_fn(args):
        qi, ci = args
        blk = ci // chunks_per_blk
        pos_q = ci * MOBA_Q_CHUNK + jnp.arange(MOBA_Q_CHUNK)
        k_own = lax.dynamic_index_in_dim(kb, blk, axis=1, keepdims=False)
        v_own = lax.dynamic_index_in_dim(vb, blk, axis=1, keepdims=False)
        dist_own = pos_q[:, None] - (blk * MOBA_BLOCK + in_blk)[None, :]
        logit_own = (jnp.einsum('bqhe,bkhe->bhqk', qi, k_own) * scale
                     - slopes[:, None, None] * dist_own.astype(jnp.float32))
        logit_own = jnp.where(dist_own >= 0, logit_own, NEG_INF)
        if n_sel == 0:
            p_own = jax.nn.softmax(logit_own, axis=-1)
            return jnp.einsum('bhqk,bkhe->bqhe', p_own, v_own)
        gate = jnp.einsum('bqhe,bnhe->bqhn', qi, k_mean)
        gate = jnp.where(jnp.arange(n_blk) < blk, gate, NEG_INF)
        _, idx = lax.top_k(gate, n_sel)
        k_sel = kbh[b_idx, h_idx, idx]
        v_sel = vbh[b_idx, h_idx, idx]
        dist_sel = pos_q[None, :, None, None, None] - (idx[..., None] * MOBA_BLOCK + in_blk)
        logit_sel = (jnp.einsum('bqhe,bqhsje->bqhsj', qi, k_sel) * scale
                     - slopes[None, None, :, None, None] * dist_sel.astype(jnp.float32))
        sel_valid = jnp.arange(n_sel) < blk
        logit_sel = jnp.where(sel_valid[:, None], logit_sel, NEG_INF)
        logit_sel = logit_sel.reshape(bsz, MOBA_Q_CHUNK, nh, n_sel * MOBA_BLOCK).transpose(0, 2, 1, 3)
        probs = jax.nn.softmax(jnp.concatenate([logit_own, logit_sel], axis=-1), axis=-1)
        p_own = probs[..., :MOBA_BLOCK]
        p_sel = probs[..., MOBA_BLOCK:].transpose(0, 2, 1, 3).reshape(bsz, MOBA_Q_CHUNK, nh, n_sel, MOBA_BLOCK)
        return (jnp.einsum('bhqk,bkhe->bqhe', p_own, v_own)
                + jnp.einsum('bqhsj,bqhsje->bqhe', p_sel, v_sel))

    out = lax.map(chunk_fn, (q_chunks, jnp.arange(n_chunks)))
    return out.transpose(1, 0, 2, 3, 4).reshape(bsz, sp, nh, hd)[:, :seq]


def hybrid_layer(x, norm1_w, w_in, a_q_norm, a_k_norm, c_q_norm, c_k_norm,
                 conv_w, conv_b, dt_bias, a_log, d_skip, ssm_norm_w, w_out,
                 norm2_w, w_mlp_in, w_mlp_out, slopes):
    bsz, seq, _ = x.shape
    h = rms_norm(x, norm1_w)
    proj = h @ w_in
    sizes = [A_WIDTH] * 3 + [C_WIDTH] * 3 + [D_SSM, CONV_DIM]
    points, acc = [], 0
    for s in sizes:
        acc += s
        points.append(acc)
    qa, ka, va, qc, kc, vc, z, xbc, dt_raw = jnp.split(proj, points, axis=-1)

    def heads(t, n):
        return t.reshape(bsz, seq, n, HEAD_DIM)

    f32 = jnp.float32
    ya = dilated_mixture(rms_norm(heads(qa, A_HEADS), a_q_norm).astype(f32),
                         rms_norm(heads(ka, A_HEADS), a_k_norm).astype(f32),
                         heads(va, A_HEADS).astype(f32), slopes[0::2])
    yb = mamba2_mixer(z, xbc, dt_raw, conv_w, conv_b, dt_bias, a_log, d_skip, ssm_norm_w)
    yc = moba_attention(rms_norm(heads(qc, C_HEADS), c_q_norm).astype(f32),
                        rms_norm(heads(kc, C_HEADS), c_k_norm).astype(f32),
                        heads(vc, C_HEADS).astype(f32), slopes[1::2])
    y = jnp.concatenate([ya.reshape(bsz, seq, A_WIDTH), yb, yc.reshape(bsz, seq, C_WIDTH)],
                        axis=-1).astype(x.dtype)
    x = x + y @ w_out
    h = rms_norm(x, norm2_w)
    return x + jnp.square(jax.nn.relu(h @ w_mlp_in)) @ w_mlp_out


def setup_inputs(seed: int = 0) -> dict:
    key = jax.random.key(seed)
    ks = jax.random.split(key, 17)
    f32 = jnp.float32

    def nrm(k, shape, scale):
        return jax.random.normal(k, shape, f32) * scale

    def gain(k, shape, noise=0.02):
        return 1.0 + noise * jax.random.normal(k, shape, f32)

    dt = jnp.exp(jax.random.uniform(ks[9], (DEPTH, B_HEADS), f32, math.log(1e-3), math.log(1e-1)))
    return {
        "x": jax.random.normal(ks[0], (BATCH, SEQ, D_MODEL), f32),
        "norm1_w": gain(ks[1], (DEPTH, D_MODEL)),
        "w_in": nrm(ks[2], (DEPTH, D_MODEL, D_IN), D_MODEL ** -0.5),
        "a_q_norm": gain(ks[3], (DEPTH, HEAD_DIM)),
        "a_k_norm": gain(ks[4], (DEPTH, HEAD_DIM)),
        "c_q_norm": gain(ks[5], (DEPTH, HEAD_DIM)),
        "c_k_norm": gain(ks[6], (DEPTH, HEAD_DIM)),
        "conv_w": nrm(ks[7], (DEPTH, SSM_CONV, CONV_DIM), SSM_CONV ** -0.5),
        "conv_b": nrm(ks[8], (DEPTH, CONV_DIM), 0.02),
        "dt_bias": dt + jnp.log(-jnp.expm1(-dt)),
        "a_log": jnp.log(jax.random.uniform(ks[10], (DEPTH, B_HEADS), f32, 1.0, 16.0)),
        "d_skip": gain(ks[11], (DEPTH, B_HEADS), 0.1),
        "ssm_norm_w": gain(ks[12], (DEPTH, D_SSM)),
        "w_out": nrm(ks[13], (DEPTH, D_MIX, D_MODEL), D_MIX ** -0.5),
        "norm2_w": gain(ks[14], (DEPTH, D_MODEL)),
        "w_mlp_in": nrm(ks[15], (DEPTH, D_MODEL, D_FF), D_MODEL ** -0.5),
        "w_mlp_out": nrm(ks[16], (DEPTH, D_FF, D_MODEL), D_FF ** -0.5),
    }


def reference(x, norm1_w, w_in, a_q_norm, a_k_norm, c_q_norm, c_k_norm, conv_w, conv_b,
              dt_bias, a_log, d_skip, ssm_norm_w, w_out, norm2_w, w_mlp_in, w_mlp_out):
    slopes = alibi_slopes()
    for i in range(DEPTH):
        x = hybrid_layer(x, norm1_w[i], w_in[i], a_q_norm[i], a_k_norm[i], c_q_norm[i],
                         c_k_norm[i], conv_w[i], conv_b[i], dt_bias[i], a_log[i], d_skip[i],
                         ssm_norm_w[i], w_out[i], norm2_w[i], w_mlp_in[i], w_mlp_out[i], slopes)
    return x
```

```cpp
#include <hip/hip_runtime.h>
#include <cstdio>
#include <cstdint>
#include <cmath>
namespace pg8 {
#define PG8_LAS __attribute__((address_space(3)))
typedef unsigned short bf16_t;
typedef short bf16x8 __attribute__((ext_vector_type(8)));
typedef float f32x4 __attribute__((ext_vector_type(4)));
typedef unsigned u32x4 __attribute__((ext_vector_type(4)));
constexpr int BM = 256, BK = 64, HALF = 128, HTB = HALF * BK * 2  , STAGE_BYTES = 8 * HTB, NXCD = 8, WGM = 8;

__host__ __device__ __forceinline__ int lds_byte(int r, int c) { const int st = (r >> 4) * 2 + (c >> 5), rr = r & 15, cc = c & 31, ob = rr * 64 + cc * 2; return st * 1024 + (ob ^ (((ob >> 9) & 1) << 5)); }
__host__ __device__ __forceinline__ void stage_rc(int b, int& R, int& C) { const int st = b / 1024, sb = b % 1024, swz = sb ^ (((sb >> 9) & 1) << 5); R = (st >> 1) * 16 + swz / 64; C = (st & 1) * 32 + (swz % 64) / 2; }
__host__ __device__ __forceinline__ int perm32(int rho) { const int n = rho >> 4, i = rho & 15; return 8 * (i >> 2) + 4 * n + (i & 3); }

struct Unit { int pm, pn; };
struct Gemm { const bf16_t* A; const bf16_t* Bt; int M, N, K; };

struct StaticOrder {
    int nM, nN, nwg, G, c;
    __host__ __device__ void init(int M, int N, int G_, int c_) { nM = M / BM; nN = N / BM; nwg = nM * nN; G = G_; c = c_; }
    __host__ __device__ bool next(int i, Unit& u) const {
        const long L = (long)i * G + c; if (L >= nwg) return false;
        int wgid = (int)L; { const int q = nwg / NXCD, r = nwg % NXCD, xcd = wgid % NXCD, off = wgid / NXCD; wgid = (xcd < r ? xcd * (q + 1) : r * (q + 1) + (xcd - r) * q) + off; }
        const int nig = WGM * nN, gid = wgid / nig, fm = gid * WGM, gsz = (nM - fm) < WGM ? (nM - fm) : WGM;
        u.pm = fm + ((wgid % nig) % gsz); u.pn = (wgid % nig) / gsz; return true;
    }
    __device__ __forceinline__ void a_ready(const Unit&) const {}
    __device__ __forceinline__ void done(const Unit&) const {}
};

__device__ __forceinline__ unsigned cvt_pk_bf16(float lo, float hi) { unsigned r; asm volatile("v_cvt_pk_bf16_f32 %0, %1, %2" : "=v"(r) : "v"(lo), "v"(hi)); return r; }
typedef float f32x2 __attribute__((ext_vector_type(2)));
typedef unsigned u32x2 __attribute__((ext_vector_type(2)));
struct EpiProj {
    static constexpr bool PERM = true, AFTER_DRAIN = false;
    bf16_t* P; const float* rstd; const float *g0, *g1, *g2, *g3;
    __device__ __forceinline__ void operator()(const f32x4 (&acc)[2][2][4][2], const Unit& u, int wr, int wc, int fr, int fq) const {
        const int pn = u.pn; const int nsel = (pn == 0) ? 0 : (pn == 1) ? 1 : (pn == 3) ? 2 : (pn == 4) ? 3 : -1;
        const int row0 = u.pm * BM + wr * 64 + fr;
        const float* nw = (nsel == 0) ? g0 : (nsel == 1) ? g1 : (nsel == 2) ? g2 : g3;
        f32x4 g[2][2];
#pragma unroll
        for (int bj = 0; bj < 2; ++bj)
#pragma unroll
            for (int n = 0; n < 2; ++n) g[bj][n] = (nsel >= 0) ? *(const f32x4*)(nw + 32 * bj + 8 * fq + 4 * n) : (f32x4){1.f, 1.f, 1.f, 1.f};
#pragma unroll
        for (int ai = 0; ai < 2; ++ai)
#pragma unroll
            for (int m = 0; m < 4; ++m) {
                const int row = row0 + ai * HALF + m * 16; const float r = rstd[row];
                f32x4 v[2][2]; float ss = 0.f;
#pragma unroll
                for (int bj = 0; bj < 2; ++bj)
#pragma unroll
                    for (int n = 0; n < 2; ++n) { v[bj][n] = acc[ai][bj][m][n] * r; const f32x4 x = v[bj][n]; ss += (x[0] * x[0] + x[1] * x[1]) + (x[2] * x[2] + x[3] * x[3]); }
                if (nsel >= 0) {
                    ss += __shfl_xor(ss, 16); ss += __shfl_xor(ss, 32);
                    const float hr = 1.0f / sqrtf(ss * (1.0f / 64.0f) + 1e-6f);
#pragma unroll
                    for (int bj = 0; bj < 2; ++bj)
#pragma unroll
                        for (int n = 0; n < 2; ++n) v[bj][n] = v[bj][n] * hr * g[bj][n];
                }
                bf16_t* rowp = P + (size_t)row * 3072 + pn * BM + wc * 64 + 8 * fq;
#pragma unroll
                for (int bj = 0; bj < 2; ++bj) { u32x4 w; w.x = cvt_pk_bf16(v[bj][0][0], v[bj][0][1]); w.y = cvt_pk_bf16(v[bj][0][2], v[bj][0][3]); w.z = cvt_pk_bf16(v[bj][1][0], v[bj][1][1]); w.w = cvt_pk_bf16(v[bj][1][2], v[bj][1][3]);
                    *(u32x4*)(rowp + 32 * bj) = w; }
            }
    }
};
struct EpiRes1 {
    static constexpr bool PERM = false, AFTER_DRAIN = false;
    const float* base; float* out; bf16_t* xb; float* ssq;
    __device__ __forceinline__ void operator()(const f32x4 (&acc)[2][2][4][2], const Unit& u, int wr, int wc, int fr, int fq) const {
        const int col0 = u.pn * BM + wc * 32 + 4 * fq;
#pragma unroll
        for (int ai = 0; ai < 2; ++ai)
#pragma unroll
            for (int m = 0; m < 4; ++m) {
                const int row = u.pm * BM + ai * HALF + wr * 64 + m * 16 + fr; const size_t off = (size_t)row * 1024 + col0; float ss = 0.f;
#pragma unroll
                for (int bj = 0; bj < 2; ++bj)
#pragma unroll
                    for (int n = 0; n < 2; ++n) { const size_t o2 = off + bj * HALF + n * 16; const f32x4 o = *(const f32x4*)(base + o2) + acc[ai][bj][m][n];
                        *(f32x4*)(out + o2) = o; u32x2 w; w.x = cvt_pk_bf16(o[0], o[1]); w.y = cvt_pk_bf16(o[2], o[3]); *(u32x2*)(xb + o2) = w;
                        ss += (o[0] * o[0] + o[1] * o[1]) + (o[2] * o[2] + o[3] * o[3]); }
                ss += __shfl_xor(ss, 16); ss += __shfl_xor(ss, 32);
                if (fq == 0) atomicAdd(ssq + row, ss);
            }
    }
};
struct EpiRelu2 {
    static constexpr bool PERM = true, AFTER_DRAIN = false;
    bf16_t* H; const float* ssq;
    __device__ __forceinline__ void operator()(const f32x4 (&acc)[2][2][4][2], const Unit& u, int wr, int wc, int fr, int fq) const {
        const int col0 = u.pn * BM + wc * 32 + 8 * fq;
#pragma unroll
        for (int ai = 0; ai < 2; ++ai)
#pragma unroll
            for (int m = 0; m < 4; ++m) {
                const int row = u.pm * BM + ai * HALF + wr * 64 + m * 16 + fr; const float r = 1.0f / sqrtf(ssq[row] * (1.0f / 1024.0f) + 1e-6f);
                bf16_t* rowp = H + (size_t)row * 4096 + col0;
#pragma unroll
                for (int bj = 0; bj < 2; ++bj) { f32x4 v0 = acc[ai][bj][m][0] * r, v1 = acc[ai][bj][m][1] * r;
#pragma unroll
                    for (int e = 0; e < 4; ++e) { const float a = fmaxf(v0[e], 0.f), b = fmaxf(v1[e], 0.f); v0[e] = a * a; v1[e] = b * b; }
                    u32x4 w; w.x = cvt_pk_bf16(v0[0], v0[1]); w.y = cvt_pk_bf16(v0[2], v0[3]); w.z = cvt_pk_bf16(v1[0], v1[1]); w.w = cvt_pk_bf16(v1[2], v1[3]);
                    *(u32x4*)(rowp + bj * HALF) = w; }
            }
    }
};
struct EpiRes2 {
    static constexpr bool PERM = false, AFTER_DRAIN = false;
    float* out;
    __device__ __forceinline__ void operator()(const f32x4 (&acc)[2][2][4][2], const Unit& u, int wr, int wc, int fr, int fq) const {
        const int col0 = u.pn * BM + wc * 32 + 4 * fq;
#pragma unroll
        for (int ai = 0; ai < 2; ++ai)
#pragma unroll
            for (int m = 0; m < 4; ++m) {
                const int row = u.pm * BM + ai * HALF + wr * 64 + m * 16 + fr; const size_t off = (size_t)row * 1024 + col0;
#pragma unroll
                for (int bj = 0; bj < 2; ++bj)
#pragma unroll
                    for (int n = 0; n < 2; ++n) { const size_t o2 = off + bj * HALF + n * 16; const f32x4 o = *(const f32x4*)(out + o2) + acc[ai][bj][m][n]; *(f32x4*)(out + o2) = o; }
            }
    }
};
template <class Epi, class Sched, bool ALIGN_EPI = false, bool SP2 = false>
__device__ __forceinline__ void gemm_phase(PG8_LAS unsigned char* lds, const Gemm g, const Sched& S, const Epi& E) {
    int tid_ = threadIdx.x; asm volatile("" : "+v"(tid_));
    const int tid = tid_, wid = __builtin_amdgcn_readfirstlane(tid >> 6), lane = tid & 63, wr = wid >> 2, wc = wid & 3, fr = lane & 15, fq = lane >> 4;
    const int K = g.K, nt = K / BK;
    unsigned voffA[2], voffB[2];
#pragma unroll
    for (int i = 0; i < 2; ++i) { int R, C; stage_rc(tid * 16 + i * 8192, R, C); const int Rb = Epi::PERM ? ((R & ~31) + perm32(R & 31)) : R;
        voffA[i] = (unsigned)(R * K + C) * 2u; voffB[i] = (unsigned)(Rb * K + C) * 2u; }
    const size_t kstep = (size_t)(BK * 2);
    const size_t hstep = (size_t)HALF * K * 2;
    const size_t tstep = 2 * hstep;
    const unsigned ldsw = (unsigned)wid * 1024u;
    const int aoff = lds_byte(wr * 64 + fr, fq * 8), boff = lds_byte(wc * 32 + fr, fq * 8);
#define PG8_SA(b, h) (((b) * 2 + (h)) * HTB)
#define PG8_SB(b, h) ((4 + (b) * 2 + (h)) * HTB)
#define PG8_STAGE(bufoff, gbase, voff) do { _Pragma("unroll") for (int _i = 0; _i < 2; ++_i) \
        __builtin_amdgcn_global_load_lds((const unsigned*)((const char*)(gbase) + (voff)[_i]), (PG8_LAS unsigned*)(lds + (bufoff) + ldsw + _i * 8192), 16, 0, 0); } while (0)
#define PG8_LDA(dst, b, h) do { _Pragma("unroll") for (int m = 0; m < 4; ++m) _Pragma("unroll") for (int k = 0; k < 2; ++k) dst[m][k] = *(const PG8_LAS bf16x8*)(lds + PG8_SA(b, h) + aoff + m * 2048 + k * 1024); } while (0)
#define PG8_LDB(dst, b, h) do { _Pragma("unroll") for (int n = 0; n < 2; ++n) _Pragma("unroll") for (int k = 0; k < 2; ++k) dst[n][k] = *(const PG8_LAS bf16x8*)(lds + PG8_SB(b, h) + boff + n * 2048 + k * 1024); } while (0)
#define PG8_MMA(ai, bj, At, Bt) do { __builtin_amdgcn_s_setprio(1); _Pragma("unroll") for (int m = 0; m < 4; ++m) _Pragma("unroll") for (int n = 0; n < 2; ++n) _Pragma("unroll") for (int k = 0; k < 2; ++k) \
        acc[ai][bj][m][n] = __builtin_amdgcn_mfma_f32_16x16x32_bf16(Bt[n][k], At[m][k], acc[ai][bj][m][n], 0, 0, 0); __builtin_amdgcn_s_setprio(0); } while (0)
#define PG8_WAIT_V(n) asm volatile("s_waitcnt vmcnt(" #n ")" ::: "memory")
#define PG8_WAIT_L(n) asm volatile("s_waitcnt lgkmcnt(" #n ")" ::: "memory")
#define PG8_BAR __builtin_amdgcn_s_barrier()
#define PG8_SCHED __builtin_amdgcn_sched_barrier(0)
    Unit cur, nxt; int ui = 0;
    if (!S.next(0, cur)) return;
    f32x4 acc[2][2][4][2];
#pragma unroll
    for (int a = 0; a < 2; ++a)
#pragma unroll
        for (int b = 0; b < 2; ++b)
#pragma unroll
            for (int m = 0; m < 4; ++m)
#pragma unroll
                for (int n = 0; n < 2; ++n) acc[a][b][m][n] = (f32x4){0.f, 0.f, 0.f, 0.f};
    bf16x8 At[4][2], B0[2][2], B1[2][2];
    const char* cA = (const char*)g.A + (size_t)cur.pm * tstep; const char* cB = (const char*)g.Bt + (size_t)cur.pn * tstep;
    S.a_ready(cur);
    if constexpr (SP2) {
        PG8_STAGE(PG8_SB(0, 0), cB, voffB); PG8_STAGE(PG8_SB(0, 1), cB + hstep, voffB); PG8_STAGE(PG8_SA(0, 0), cA, voffA); PG8_STAGE(PG8_SA(0, 1), cA + hstep, voffA);
        if (wr == 1) PG8_BAR;
        PG8_WAIT_V(2); PG8_BAR;
        PG8_STAGE(PG8_SB(1, 0), cB + kstep, voffB); PG8_STAGE(PG8_SA(1, 0), cA + kstep, voffA); PG8_STAGE(PG8_SB(1, 1), cB + hstep + kstep, voffB);
        PG8_WAIT_V(6); PG8_BAR;
    } else {
        PG8_STAGE(PG8_SB(0, 0), cB, voffB); PG8_STAGE(PG8_SA(0, 0), cA, voffA); PG8_STAGE(PG8_SB(0, 1), cB + hstep, voffB); PG8_STAGE(PG8_SA(0, 1), cA + hstep, voffA);
        if (wr == 1) PG8_BAR;
        PG8_WAIT_V(4); PG8_BAR;
        PG8_STAGE(PG8_SB(1, 0), cB + kstep, voffB); PG8_STAGE(PG8_SA(1, 0), cA + kstep, voffA); PG8_STAGE(PG8_SB(1, 1), cB + hstep + kstep, voffB);
        PG8_WAIT_V(6); PG8_BAR;
    }
    for (;;) {
        const bool has_next = S.next(ui + 1, nxt);
        const char* nA = has_next ? (const char*)g.A + (size_t)nxt.pm * tstep : cA; const char* nB = has_next ? (const char*)g.Bt + (size_t)nxt.pn * tstep : cB;
        for (int t = 0; t < nt; t += 2) {
            const bool last = (t == nt - 2);
            const char* a1 = cA + (size_t)(t + 1) * kstep;
            const char* a2 = last ? nA : cA + (size_t)(t + 2) * kstep; const char* b2 = last ? nB : cB + (size_t)(t + 2) * kstep;
            const char* a3 = a2 + kstep; const char* b3 = b2 + kstep;
            if (last && has_next) S.a_ready(nxt);
            if constexpr (SP2) {
            PG8_LDB(B0, 0, 0); PG8_LDB(B1, 0, 1); PG8_SCHED; PG8_LDA(At, 0, 0); PG8_STAGE(PG8_SA(1, 1), a1 + hstep, voffA);
            PG8_WAIT_V(8); PG8_WAIT_L(0); PG8_BAR; PG8_MMA(0, 0, At, B0); PG8_MMA(0, 1, At, B1); PG8_BAR; PG8_SCHED;
            PG8_LDA(At, 0, 1); PG8_STAGE(PG8_SB(0, 0), b2, voffB); PG8_STAGE(PG8_SB(0, 1), b2 + hstep, voffB); PG8_STAGE(PG8_SA(0, 0), a2, voffA);
            PG8_WAIT_V(8); PG8_WAIT_L(0); PG8_BAR; PG8_MMA(1, 0, At, B0); PG8_MMA(1, 1, At, B1); PG8_BAR; PG8_SCHED;
            PG8_LDB(B0, 1, 0); PG8_LDB(B1, 1, 1); PG8_SCHED; PG8_LDA(At, 1, 0); PG8_STAGE(PG8_SA(0, 1), a2 + hstep, voffA);
            PG8_WAIT_V(8); PG8_WAIT_L(0); PG8_BAR; PG8_MMA(0, 0, At, B0); PG8_MMA(0, 1, At, B1); PG8_BAR; PG8_SCHED;
            PG8_LDA(At, 1, 1); PG8_STAGE(PG8_SB(1, 0), b3, voffB); PG8_STAGE(PG8_SB(1, 1), b3 + hstep, voffB); PG8_STAGE(PG8_SA(1, 0), a3, voffA);
            PG8_WAIT_V(8); PG8_WAIT_L(0); PG8_BAR; PG8_MMA(1, 0, At, B0); PG8_MMA(1, 1, At, B1); PG8_BAR; PG8_SCHED;
            } else {
            PG8_LDB(B0, 0, 0); PG8_SCHED; PG8_LDA(At, 0, 0); PG8_STAGE(PG8_SA(1, 1), a1 + hstep, voffA);
            PG8_WAIT_L(8); PG8_BAR; PG8_WAIT_L(0); PG8_MMA(0, 0, At, B0); PG8_BAR; PG8_SCHED;
            PG8_LDB(B1, 0, 1); PG8_STAGE(PG8_SB(0, 0), b2, voffB);
            PG8_BAR; PG8_WAIT_L(0); PG8_MMA(0, 1, At, B1); PG8_BAR;
            PG8_LDA(At, 0, 1); PG8_STAGE(PG8_SA(0, 0), a2, voffA);
            PG8_BAR; PG8_WAIT_L(0); PG8_MMA(1, 0, At, B0); PG8_BAR; PG8_SCHED;
            PG8_STAGE(PG8_SB(0, 1), b2 + hstep, voffB);
            PG8_WAIT_V(6); PG8_BAR; PG8_MMA(1, 1, At, B1); PG8_BAR;
            PG8_LDB(B0, 1, 0); PG8_SCHED; PG8_LDA(At, 1, 0); PG8_STAGE(PG8_SA(0, 1), a2 + hstep, voffA);
            PG8_WAIT_L(8); PG8_BAR; PG8_WAIT_L(0); PG8_MMA(0, 0, At, B0); PG8_BAR; PG8_SCHED;
            PG8_LDB(B1, 1, 1); PG8_STAGE(PG8_SB(1, 0), b3, voffB);
            PG8_BAR; PG8_WAIT_L(0); PG8_MMA(0, 1, At, B1); PG8_BAR;
            PG8_LDA(At, 1, 1); PG8_STAGE(PG8_SA(1, 0), a3, voffA);
            PG8_BAR; PG8_WAIT_L(0); PG8_MMA(1, 0, At, B0); PG8_BAR; PG8_SCHED;
            PG8_STAGE(PG8_SB(1, 1), b3 + hstep, voffB);
            PG8_WAIT_V(6); PG8_BAR; PG8_MMA(1, 1, At, B1); PG8_BAR;
            }
        }
        if constexpr (ALIGN_EPI) { if (wr == 0) PG8_BAR; }
        if constexpr (!Epi::AFTER_DRAIN) { E(acc, cur, wr, wc, fr, fq); S.done(cur); }
        if (!has_next) break;
#pragma unroll
        for (int a = 0; a < 2; ++a)
#pragma unroll
            for (int b = 0; b < 2; ++b)
#pragma unroll
                for (int m = 0; m < 4; ++m)
#pragma unroll
                    for (int n = 0; n < 2; ++n) acc[a][b][m][n] = (f32x4){0.f, 0.f, 0.f, 0.f};
        cur = nxt; cA = nA; cB = nB; ++ui;
        if constexpr (ALIGN_EPI) { if (wr == 1) PG8_BAR; }
    }
    PG8_WAIT_V(0);
    if constexpr (!ALIGN_EPI) { if (wr == 0) PG8_BAR; }
    PG8_BAR;
    if constexpr (Epi::AFTER_DRAIN) { E.fused(acc, cur, wr, wc, fr, fq, lds, wid, lane); S.done(cur); }
#undef PG8_SA
#undef PG8_SB
#undef PG8_STAGE
#undef PG8_LDA
#undef PG8_LDB
#undef PG8_MMA
#undef PG8_WAIT_V
#undef PG8_WAIT_L
#undef PG8_BAR
#undef PG8_SCHED
}
}
#define GAS __attribute__((address_space(1)))
#define LAS __attribute__((address_space(3)))
typedef unsigned short bf16;
typedef unsigned v4u __attribute__((ext_vector_type(4)));
typedef float f32x4 __attribute__((ext_vector_type(4)));
typedef short bf16x8 __attribute__((ext_vector_type(8)));
typedef GAS unsigned gu32;
typedef GAS unsigned long long gu64;
#define RLX_AGENT __ATOMIC_RELAXED, __HIP_MEMORY_SCOPE_AGENT
#define LDS_WAIT() asm volatile("s_waitcnt lgkmcnt(0)" ::: "memory")
#define VM_WAIT() asm volatile("s_waitcnt vmcnt(0)" ::: "memory")
__device__ __forceinline__ unsigned long long rt() { return __builtin_amdgcn_s_memrealtime(); }
__device__ __forceinline__ unsigned f2bf(float f) { unsigned u = __builtin_bit_cast(unsigned, f); return (u + 0x7fffu + ((u >> 16) & 1u)) >> 16; }
__device__ __forceinline__ unsigned pk2(float lo, float hi) { return f2bf(lo) | (f2bf(hi) << 16); }
#define XB_TMO      128
#define XB_XCNT(j)  (256  + 64 * (j))
#define XB_XSUB(j)  (1280 + 64 * (j))
#define XB_XGEN(j)  (2304 + 64 * (j))
#define XB_TOP      3328
#define XB_TOPGEN   3392
#define XCD_BAR_WORDS 3456
#define XB_SPIN_CAP (1u << 18)

__device__ __forceinline__ unsigned xb_ld(unsigned* p)              { return __hip_atomic_load(p, __ATOMIC_RELAXED, __HIP_MEMORY_SCOPE_AGENT); }
__device__ __forceinline__ unsigned xb_add(unsigned* p, unsigned v) { return __hip_atomic_fetch_add(p, v, __ATOMIC_RELAXED, __HIP_MEMORY_SCOPE_AGENT); }
__device__ __forceinline__ unsigned xb_xcc_id() { return (unsigned)__builtin_amdgcn_s_getreg((3 << 11) | 20) & 0xFu; }
#define XB_SPIN(cond, bar) do { unsigned _sp = 0; while (cond) { __builtin_amdgcn_s_sleep(1); \
    if ((++_sp & 255u) == 0u) { if (xb_ld(&(bar)[XB_TMO])) break; if (_sp > XB_SPIN_CAP) { atomicAdd(&(bar)[XB_TMO], 1u); break; } } } } while (0)

struct XcdBarrier {
    unsigned* bar; unsigned x;
    volatile LAS unsigned* st;
};

__device__ __forceinline__ XcdBarrier xcd_barrier_post(unsigned* bar, volatile LAS unsigned* st) {
    XcdBarrier b; b.bar = bar; b.x = xb_xcc_id(); b.st = st;
    if (threadIdx.x == 0) (void)xb_add(&bar[XB_XCNT(b.x)], 1u);
    return b;
}
__device__ __forceinline__ void xcd_barrier_complete(unsigned* bar, unsigned x, unsigned& nloc, unsigned& nx) {
    const unsigned G = gridDim.x * gridDim.y * gridDim.z;
    unsigned sum, cnt, mine, sp = 0u;
    for (;;) {
        sum = 0u; cnt = 0u; mine = 0u;
#pragma unroll
        for (unsigned j = 0; j < 16; ++j) { const unsigned c = xb_ld(&bar[XB_XCNT(j)]); sum += c; cnt += (c > 0u) ? 1u : 0u; mine = (j == x) ? c : mine; }
        if (sum == G) break;
        __builtin_amdgcn_s_sleep(1);
        if ((++sp & 255u) == 0u) { if (xb_ld(&bar[XB_TMO])) break; if (sp > XB_SPIN_CAP) { atomicAdd(&bar[XB_TMO], 1u); break; } }
    }
    nloc = mine > 0u ? mine : 1u; nx = cnt > 0u ? cnt : 1u;
}

__device__ __forceinline__ void xcd_barrier(const XcdBarrier& b) {
    asm volatile("s_waitcnt vmcnt(0)" ::: "memory");
    __syncthreads();
    unsigned zoff_ = 0u; asm volatile("s_mov_b32 %0, 0" : "=s"(zoff_)); unsigned* bar_ = b.bar + zoff_;
    if (threadIdx.x == 0) {
        unsigned* bar = bar_;
        __builtin_amdgcn_s_waitcnt(0);
        unsigned nloc = b.st[0], nx = b.st[1];
        if (nloc == 0u) { xcd_barrier_complete(bar, b.x, nloc, nx); b.st[0] = nloc; b.st[1] = nx; }
        const unsigned old = xb_add(&bar[XB_XSUB(b.x)], 1u);
        const unsigned gen = old / nloc;
        if (old + 1u == (gen + 1u) * nloc) {
            __builtin_amdgcn_fence(__ATOMIC_RELEASE, "agent");
            asm volatile("s_waitcnt vmcnt(0)" ::: "memory");
            const unsigned og = xb_add(&bar[XB_TOP], 1u);
            const unsigned tg = og / nx;
            if (og + 1u == (tg + 1u) * nx) xb_add(&bar[XB_TOPGEN], 1u);
            else XB_SPIN(xb_ld(&bar[XB_TOPGEN]) == tg, bar);
            __builtin_amdgcn_fence(__ATOMIC_ACQUIRE, "agent");
            xb_add(&bar[XB_XGEN(b.x)], 1u);
            asm volatile("s_waitcnt vmcnt(0)" ::: "memory");
        } else {
            XB_SPIN(xb_ld(&bar[XB_XGEN(b.x)]) == gen, bar);
            __builtin_amdgcn_fence(__ATOMIC_ACQUIRE, "agent");
            asm volatile("s_waitcnt vmcnt(0)" ::: "memory");
        }
    }
    __syncthreads();
}
constexpr int NWAVES = 8;
constexpr int BATCH = 4, SEQ = 4096, DM = 1024, M = BATCH * SEQ, DIN = 3080, NPROJ = 3072, FF = 4096, DEPTH = 2;
constexpr int OFF_QA = 0, OFF_KA = 256, OFF_VA = 512, OFF_QC = 768, OFF_KC = 1024, OFF_VC = 1280, OFF_Z = 1536, OFF_XBC = 2048;
constexpr float EPS = 1e-6f;
constexpr size_t MiB = 1u << 20;
constexpr size_t WS_CTL = 0, CTL_ZERO_BYTES = 1 * MiB;
constexpr size_t WS_SSQ = 256 * 1024;
constexpr size_t WS_W = 2 * MiB, W_LAYER = 24 * MiB, W_IN = 0, W_OUT = 6 * MiB, W_1 = 8 * MiB, W_2 = 16 * MiB;
constexpr size_t WS_RSTD = 50 * MiB, WS_DT = 51 * MiB, WS_KMEAN = 52 * MiB;
constexpr size_t WS_PROJ = 56 * MiB, WS_Y = 152 * MiB, WS_H = 56 * MiB, WS_XB = 184 * MiB, WS_ST = 216 * MiB, WS_END = 256 * MiB;
static_assert(WS_PROJ + (size_t)M * NPROJ * 2 <= WS_Y && WS_Y + (size_t)M * DM * 2 <= WS_XB && WS_H + (size_t)M * FF * 2 <= WS_XB && WS_XB + (size_t)M * DM * 2 <= WS_ST && WS_ST + 32 * MiB <= WS_END, "d_ws map");
constexpr int CW_BAR = 4096;
constexpr int RING_OFF = 0, RING_BYTES = 131072;
constexpr int LDSCTL_OFF = RING_BYTES, MISC_OFF = LDSCTL_OFF + 320;
constexpr int LDS_BYTES = 147456;

struct Frame {
    LAS unsigned char* lds; volatile LAS unsigned* MISC;
    int tid, lane, wave, vcu, G;
};
typedef const __attribute__((address_space(4))) unsigned char* kptr_t;
__device__ __forceinline__ kptr_t kargs() { kptr_t p = (kptr_t)__builtin_amdgcn_kernarg_segment_ptr(); asm volatile("" : "+s"(p)); return p; }
#define ARGF(i) (*(const float* const __attribute__((address_space(4)))*)(kargs() + 8 * (i)))
#define ARGOUT() (*(float* const __attribute__((address_space(4)))*)(kargs() + 8 * 17))
#define ARGWS() (*(unsigned char* const __attribute__((address_space(4)))*)(kargs() + 8 * 18))
__device__ __forceinline__ float wave_sum(float v) {
#pragma unroll
    for (int o = 1; o < 64; o <<= 1) v += __shfl_xor(v, o);
    return v;
}
__device__ __forceinline__ float wave_max(float v) {
#pragma unroll
    for (int o = 1; o < 64; o <<= 1) v = fmaxf(v, __shfl_xor(v, o));
    return v;
}
__device__ __forceinline__ float blo(unsigned w) { return __uint_as_float(w << 16); }
__device__ __forceinline__ float bhi(unsigned w) { return __uint_as_float(w & 0xffff0000u); }
__device__ __forceinline__ float bf2f(bf16 u) { return __uint_as_float((unsigned)u << 16); }

__device__ __forceinline__ void p0_transpose_item(const float* W, int ldw, int K, int nblk, bf16* WT, LAS float* scr, int item, int lane, const float* kscale, bool perm) {
    const int kb = item / nblk, nb = item % nblk, k0 = 64 * kb, n0 = 32 * nb;
#pragma unroll 8
    for (int i = 0; i < 32; ++i) { const int kk = 2 * i + (lane >> 5); float v = W[(size_t)(k0 + kk) * ldw + n0 + (lane & 31)]; if (kscale) v *= kscale[k0 + kk]; scr[kk * 33 + (lane & 31)] = v; }
    LDS_WAIT(); asm volatile("" ::: "memory");
    const int c = lane & 7;
#pragma unroll
    for (int j = 0; j < 4; ++j) { const int n = (lane >> 3) + 8 * j; const LAS float* s = scr + (8 * c) * 33 + n;
        v4u o; o.x = pk2(s[0 * 33], s[1 * 33]); o.y = pk2(s[2 * 33], s[3 * 33]); o.z = pk2(s[4 * 33], s[5 * 33]); o.w = pk2(s[6 * 33], s[7 * 33]);
        int cc = n0 + n; if (perm) { const int cl = cc & 255; cc = (cc & ~255) + 128 * ((cl >> 5) & 1) + 32 * (cl >> 6) + (cl & 31); }
        *(GAS v4u*)(WT + (size_t)cc * K + k0 + 8 * c) = o; }
    LDS_WAIT(); asm volatile("" ::: "memory");
}
__device__ __forceinline__ void p0_weights(Frame& F) {
    LAS float* scr = (LAS float*)(F.lds + RING_OFF + F.wave * 16384);
    const int gw = F.vcu * NWAVES + F.wave, NGW = F.G * NWAVES;
    constexpr int I_IN = (DM / 64) * (NPROJ / 32), I_O = (DM / 64) * (DM / 32), I_1 = (DM / 64) * (FF / 32), I_2 = (FF / 64) * (DM / 32);
    constexpr int PER_L = I_IN + I_O + I_1 + I_2;
    for (int it = gw; it < DEPTH * PER_L; it += NGW) {
        const int l = it / PER_L; int r = it % PER_L;
        unsigned char* wb = ARGWS() + WS_W + (size_t)l * W_LAYER;
        if (r < I_IN) { p0_transpose_item(ARGF(2) + (size_t)l * DM * DIN, DIN, DM, NPROJ / 32, (bf16*)(wb + W_IN), scr, r, F.lane, ARGF(1) + l * DM, true); continue; } r -= I_IN;
        if (r < I_O) { p0_transpose_item(ARGF(13) + (size_t)l * DM * DM, DM, DM, DM / 32, (bf16*)(wb + W_OUT), scr, r, F.lane, nullptr, false); continue; } r -= I_O;
        if (r < I_1) { p0_transpose_item(ARGF(15) + (size_t)l * DM * FF, FF, DM, FF / 32, (bf16*)(wb + W_1), scr, r, F.lane, ARGF(14) + l * DM, false); continue; } r -= I_1;
        p0_transpose_item(ARGF(16) + (size_t)l * FF * DM, DM, FF, DM / 32, (bf16*)(wb + W_2), scr, r, F.lane, nullptr, false);
    }
}
__device__ __forceinline__ void pre_rows(Frame& F, const float* xs, int l) {
    LAS float* wdt = (LAS float*)(F.lds + RING_OFF);
    const float* win = ARGF(2) + (size_t)l * DM * DIN; const float* nw = ARGF(1) + l * DM;
    for (int i = F.tid; i < 8 * DM; i += NWAVES * 64) { const int j = i & 7, k = i >> 3; wdt[j * DM + k] = nw[k] * win[(size_t)k * DIN + NPROJ + j]; }
    __syncthreads();
    const int gw = F.vcu * NWAVES + F.wave, NGW = F.G * NWAVES;
    bf16* xb = (bf16*)(ARGWS() + WS_XB); float* rstd1 = (float*)(ARGWS() + WS_RSTD); float* dt = (float*)(ARGWS() + WS_DT);
    const float bias = (F.lane < 8) ? ARGF(9)[l * 8 + F.lane] : 0.f;
    for (int row = gw; row < M; row += NGW) {
        const f32x4* xr = (const f32x4*)(xs + (size_t)row * DM) + F.lane;
        f32x4 v[4]; float ss = 0.f;
#pragma unroll
        for (int j = 0; j < 4; ++j) { v[j] = xr[64 * j]; ss += (v[j].x * v[j].x + v[j].y * v[j].y) + (v[j].z * v[j].z + v[j].w * v[j].w); }
        const float rstd = 1.0f / sqrtf(wave_sum(ss) * (1.0f / DM) + EPS);
        unsigned long long* o8 = (unsigned long long*)(xb + (size_t)row * DM) + F.lane;
#pragma unroll
        for (int j = 0; j < 4; ++j) o8[64 * j] = (unsigned long long)pk2(v[j].x, v[j].y) | ((unsigned long long)pk2(v[j].z, v[j].w) << 32);
        float mine = 0.f;
#pragma unroll
        for (int jj = 0; jj < 8; ++jj) { float d = 0.f;
#pragma unroll
            for (int j = 0; j < 4; ++j) { const f32x4 w = *(const LAS f32x4*)(wdt + jj * DM + 256 * j + 4 * F.lane); d += (v[j].x * w.x + v[j].y * w.y) + (v[j].z * w.z + v[j].w * w.w); }
            d = wave_sum(d); if (F.lane == jj) mine = d; }
        if (F.lane < 8) { const float r = mine * rstd + bias; dt[(size_t)row * 8 + F.lane] = fmaxf(r, 0.f) + log1pf(expf(-fabsf(r))); }
        if (F.lane == 0) rstd1[row] = rstd;
    }
    __syncthreads();
}

__device__ __forceinline__ void load_q64(float (&q)[64], const bf16* p) {
#pragma unroll
    for (int c = 0; c < 8; ++c) { const v4u u = ((const v4u*)p)[c]; q[8 * c] = blo(u.x); q[8 * c + 1] = bhi(u.x); q[8 * c + 2] = blo(u.y); q[8 * c + 3] = bhi(u.y); q[8 * c + 4] = blo(u.z); q[8 * c + 5] = bhi(u.z); q[8 * c + 6] = blo(u.w); q[8 * c + 7] = bhi(u.w); }
}
__device__ __forceinline__ float dot64(const float (&q)[64], const bf16* p) {
    float s = 0.f;
#pragma unroll
    for (int c = 0; c < 8; ++c) { const v4u u = ((const v4u*)p)[c];
        s += (q[8 * c] * blo(u.x) + q[8 * c + 1] * bhi(u.x)) + (q[8 * c + 2] * blo(u.y) + q[8 * c + 3] * bhi(u.y)) + (q[8 * c + 4] * blo(u.z) + q[8 * c + 5] * bhi(u.z)) + (q[8 * c + 6] * blo(u.w) + q[8 * c + 7] * bhi(u.w)); }
    return s;
}
__device__ __forceinline__ int dilA_dist(int idx) { return idx < 129 ? idx : (idx < 225 ? 132 + 4 * (idx - 129) : 528 + 16 * (idx - 225)); }
__device__ __forceinline__ void mixA_naive(Frame& F) {
    const bf16* proj = (const bf16*)(ARGWS() + WS_PROJ); bf16* y = (bf16*)(ARGWS() + WS_Y);
    LAS float* pw = (LAS float*)(F.lds + RING_OFF) + F.wave * 1024;
    const int gw = F.vcu * NWAVES + F.wave, NGW = F.G * NWAVES, lane = F.lane;
    for (int it = gw; it < M * 4; it += NGW) {
        const int row = it >> 2, h = it & 3, t = row & (SEQ - 1);
        float q[64]; load_q64(q, proj + (size_t)row * NPROJ + OFF_QA + h * 64);
        const float slope = exp2f(-(float)(2 * h + 1));
        float s[6]; float mx = -INFINITY;
#pragma unroll
        for (int j = 0; j < 6; ++j) { const int idx = lane + 64 * j, dist = dilA_dist(idx); const bool valid = idx < 321 && dist <= t;
            const int kr = valid ? row - dist : row;
            const float d = dot64(q, proj + (size_t)kr * NPROJ + OFF_KA + h * 64) * 0.125f - slope * (float)dist;
            s[j] = valid ? d : -INFINITY; mx = fmaxf(mx, s[j]); }
        mx = wave_max(mx);
        float sum = 0.f;
#pragma unroll
        for (int j = 0; j < 6; ++j) { const int idx = lane + 64 * j, dist = dilA_dist(idx);
            const float mult = (float)((dist <= 128 ? 1 : 0) + (((dist & 3) == 0 && dist <= 512) ? 1 : 0) + (((dist & 15) == 0) ? 1 : 0));
            const float p = (s[j] == -INFINITY) ? 0.f : mult * expf(s[j] - mx); sum += p; pw[idx] = p; }
        sum = wave_sum(sum);
        LDS_WAIT(); asm volatile("" ::: "memory");
        float o = 0.f;
#pragma unroll 8
        for (int idx = 0; idx < 321; ++idx) { const float p = pw[idx]; const int dist = dilA_dist(idx); const int kr = (dist <= t) ? row - dist : row;
            o += p * bf2f(proj[(size_t)kr * NPROJ + OFF_VA + h * 64 + lane]); }
        y[(size_t)row * DM + h * 64 + lane] = (bf16)f2bf(o / sum);
        LDS_WAIT(); asm volatile("" ::: "memory");
    }
}
__device__ __forceinline__ void kmean_naive(Frame& F) {
    const bf16* proj = (const bf16*)(ARGWS() + WS_PROJ); float* km = (float*)(ARGWS() + WS_KMEAN);
    const int gw = F.vcu * NWAVES + F.wave, NGW = F.G * NWAVES, lane = F.lane;
    for (int it = gw; it < BATCH * 16 * 4; it += NGW) {
        const int h = it & 3, blk = (it >> 2) & 15, b = it >> 6; const int row0 = b * SEQ + blk * 256; float s = 0.f;
#pragma unroll 8
        for (int r = 0; r < 256; ++r) s += bf2f(proj[(size_t)(row0 + r) * NPROJ + OFF_KC + h * 64 + lane]);
        km[(size_t)it * 64 + lane] = s * (1.0f / 256.0f);
    }
}
__device__ __forceinline__ void mixC_naive(Frame& F) {
    const bf16* proj = (const bf16*)(ARGWS() + WS_PROJ); bf16* y = (bf16*)(ARGWS() + WS_Y); const float* km = (const float*)(ARGWS() + WS_KMEAN);
    LAS float* pw = (LAS float*)(F.lds + RING_OFF) + F.wave * 1024;
    const int gw = F.vcu * NWAVES + F.wave, NGW = F.G * NWAVES, lane = F.lane;
    for (int it = gw; it < M * 4; it += NGW) {
        const int row = it >> 2, h = it & 3, t = row & (SEQ - 1), b = row >> 12, blk = t >> 8;
        float q[64]; load_q64(q, proj + (size_t)row * NPROJ + OFF_QC + h * 64);
        const float slope = exp2f(-(float)(2 * h + 2));
        float g = -INFINITY;
        if (lane < blk) { const float* kp = km + ((size_t)((b * 16 + lane) * 4 + h)) * 64; float a = 0.f;
#pragma unroll
            for (int d = 0; d < 64; ++d) a += q[d] * kp[d];
            g = a; }
        int sel0 = -1, sel1 = -1, sel2 = -1;
#pragma unroll
        for (int s = 0; s < 3; ++s) { float bv = -INFINITY; int best = -1;
#pragma unroll
            for (int n = 0; n < 16; ++n) { const float gn = __shfl(g, n); if (n < blk && n != sel0 && n != sel1 && gn > bv) { bv = gn; best = n; } }
            if (s == 0) sel0 = best; else if (s == 1) sel1 = best; else sel2 = best; }
        const int nseg = 1 + (blk < 3 ? blk : 3);
        float mx = -INFINITY;
        for (int seg = 0; seg < nseg; ++seg) { const int kb = (seg == 0) ? blk : (seg == 1) ? sel0 : (seg == 2) ? sel1 : sel2;
#pragma unroll
            for (int jj = 0; jj < 4; ++jj) { const int j = lane + 64 * jj, kpos = kb * 256 + j, dist = t - kpos; const bool valid = dist >= 0;
                const int kr = valid ? b * SEQ + kpos : row;
                const float d = dot64(q, proj + (size_t)kr * NPROJ + OFF_KC + h * 64) * 0.125f - slope * (float)dist;
                const float sv = valid ? d : -INFINITY; pw[seg * 256 + j] = sv; mx = fmaxf(mx, sv); } }
        mx = wave_max(mx);
        float sum = 0.f;
        for (int seg = 0; seg < nseg; ++seg) {
#pragma unroll
            for (int jj = 0; jj < 4; ++jj) { const int j = lane + 64 * jj; const float sv = pw[seg * 256 + j]; const float p = (sv == -INFINITY) ? 0.f : expf(sv - mx); sum += p; pw[seg * 256 + j] = p; } }
        sum = wave_sum(sum);
        LDS_WAIT(); asm volatile("" ::: "memory");
        float o = 0.f;
        for (int seg = 0; seg < nseg; ++seg) { const int kb = (seg == 0) ? blk : (seg == 1) ? sel0 : (seg == 2) ? sel1 : sel2;
#pragma unroll 8
            for (int j = 0; j < 256; ++j) { const float p = pw[seg * 256 + j]; const int kpos = kb * 256 + j; const int kr = (kpos <= t) ? b * SEQ + kpos : row;
                o += p * bf2f(proj[(size_t)kr * NPROJ + OFF_VC + h * 64 + lane]); } }
        y[(size_t)row * DM + 768 + h * 64 + lane] = (bf16)f2bf(o / sum);
        LDS_WAIT(); asm volatile("" ::: "memory");
    }
}
__device__ __forceinline__ void conv_naive(Frame& F, int l) {
    const bf16* proj = (const bf16*)(ARGWS() + WS_PROJ); bf16* xc = (bf16*)(ARGWS() + WS_XB);
    const float* cw = ARGF(7) + (size_t)l * 4 * 1024; const float* cb = ARGF(8) + (size_t)l * 1024;
    const int gt = F.vcu * (NWAVES * 64) + F.tid, NGT = F.G * NWAVES * 64;
    for (int it = gt; it < M * 128; it += NGT) {
        const int row = it >> 7, c0 = (it & 127) * 8, t = row & (SEQ - 1);
        float a[8];
#pragma unroll
        for (int e = 0; e < 8; ++e) a[e] = cb[c0 + e];
#pragma unroll
        for (int j = 0; j < 4; ++j) { if (t - 3 + j >= 0) { const v4u u = *(const v4u*)(proj + (size_t)(row - 3 + j) * NPROJ + OFF_XBC + c0); const float* w = cw + j * 1024 + c0;
            a[0] += w[0] * blo(u.x); a[1] += w[1] * bhi(u.x); a[2] += w[2] * blo(u.y); a[3] += w[3] * bhi(u.y); a[4] += w[4] * blo(u.z); a[5] += w[5] * bhi(u.z); a[6] += w[6] * blo(u.w); a[7] += w[7] * bhi(u.w); } }
#pragma unroll
        for (int e = 0; e < 8; ++e) a[e] = a[e] / (1.0f + expf(-a[e]));
        v4u o; o.x = pk2(a[0], a[1]); o.y = pk2(a[2], a[3]); o.z = pk2(a[4], a[5]); o.w = pk2(a[6], a[7]);
        *(v4u*)(xc + (size_t)row * 1024 + c0) = o;
    }
}
__device__ __forceinline__ void scan_naive(Frame& F, int l) {
    const bf16* xc = (const bf16*)(ARGWS() + WS_XB); const float* dt = (const float*)(ARGWS() + WS_DT); float* ypre = (float*)(ARGWS() + WS_ST);
    const int gw = F.vcu * NWAVES + F.wave, NGW = F.G * NWAVES, lane = F.lane;
    for (int it = gw; it < BATCH * 8 * 64; it += NGW) {
        const int p = it & 63, h = (it >> 6) & 7, b = it >> 9, g = h >> 2;
        const float A = -expf(ARGF(10)[l * 8 + h]), Dk = ARGF(11)[l * 8 + h];
        float s0 = 0.f, s1 = 0.f;
        for (int t0 = 0; t0 < SEQ; t0 += 8) {
            float xv[8], dv[8], b0[8], b1[8], c0[8], c1[8];
#pragma unroll
            for (int k = 0; k < 8; ++k) { const size_t row = (size_t)b * SEQ + t0 + k; const bf16* xr = xc + row * 1024;
                xv[k] = bf2f(xr[h * 64 + p]); dv[k] = dt[row * 8 + h]; b0[k] = bf2f(xr[512 + g * 128 + lane]); b1[k] = bf2f(xr[512 + g * 128 + 64 + lane]);
                c0[k] = bf2f(xr[768 + g * 128 + lane]); c1[k] = bf2f(xr[768 + g * 128 + 64 + lane]); }
#pragma unroll
            for (int k = 0; k < 8; ++k) { const float dec = expf(dv[k] * A), xd = xv[k] * dv[k];
                s0 = s0 * dec + xd * b0[k]; s1 = s1 * dec + xd * b1[k];
                float yv = wave_sum(c0[k] * s0 + c1[k] * s1);
                if (lane == 0) ypre[((size_t)b * SEQ + t0 + k) * 512 + h * 64 + p] = yv + Dk * xv[k]; }
        }
    }
}
__device__ __forceinline__ void gate_norm_naive(Frame& F, int l) {
    const bf16* proj = (const bf16*)(ARGWS() + WS_PROJ); bf16* y = (bf16*)(ARGWS() + WS_Y); const float* ypre = (const float*)(ARGWS() + WS_ST);
    const float* nw = ARGF(12) + (size_t)l * 512;
    const int gw = F.vcu * NWAVES + F.wave, NGW = F.G * NWAVES, lane = F.lane;
    for (int row = gw; row < M; row += NGW) {
        const f32x4 y0 = *(const f32x4*)(ypre + (size_t)row * 512 + lane * 8), y1 = *(const f32x4*)(ypre + (size_t)row * 512 + lane * 8 + 4);
        const v4u zu = *(const v4u*)(proj + (size_t)row * NPROJ + OFF_Z + lane * 8);
        float v[8] = {y0.x, y0.y, y0.z, y0.w, y1.x, y1.y, y1.z, y1.w};
        const float z[8] = {blo(zu.x), bhi(zu.x), blo(zu.y), bhi(zu.y), blo(zu.z), bhi(zu.z), blo(zu.w), bhi(zu.w)};
        float ss = 0.f;
#pragma unroll
        for (int e = 0; e < 8; ++e) { v[e] = v[e] * (z[e] / (1.0f + expf(-z[e]))); ss += v[e] * v[e]; }
#pragma unroll
        for (int o = 1; o < 32; o <<= 1) ss += __shfl_xor(ss, o);
        const float r = 1.0f / sqrtf(ss * (1.0f / 256.0f) + EPS);
        const f32x4 w0 = *(const f32x4*)(nw + lane * 8), w1 = *(const f32x4*)(nw + lane * 8 + 4);
        v4u o; o.x = pk2(v[0] * r * w0.x, v[1] * r * w0.y); o.y = pk2(v[2] * r * w0.z, v[3] * r * w0.w); o.z = pk2(v[4] * r * w1.x, v[5] * r * w1.y); o.w = pk2(v[6] * r * w1.z, v[7] * r * w1.w);
        *(v4u*)(y + (size_t)row * DM + 256 + lane * 8) = o;
    }
}

struct Args { const float* in[17]; float* out; unsigned char* ws; int ph_lo, ph_hi; };
constexpr int PH_PER_LAYER = 8, N_PHASES = 1 + DEPTH * PH_PER_LAYER;
__global__ void __launch_bounds__(NWAVES * 64, 2) mk_fwd(Args args) {
    extern __shared__ __attribute__((aligned(16))) unsigned char lds[];
    Frame F;
    F.lds = (LAS unsigned char*)lds;
    F.MISC = (volatile LAS unsigned*)(F.lds + MISC_OFF);
    F.tid = threadIdx.x; F.lane = F.tid & 63; F.wave = __builtin_amdgcn_readfirstlane(F.tid >> 6);
    F.G = gridDim.x; { const int bx = blockIdx.x; F.vcu = (F.G % 8 == 0) ? (bx % 8) * (F.G / 8) + bx / 8 : bx; }
    for (int u = F.tid; u < (LDS_BYTES - LDSCTL_OFF) / 4; u += NWAVES * 64) ((LAS unsigned*)(F.lds + LDSCTL_OFF))[u] = 0u;
    __syncthreads();
    const int lo = args.ph_lo, hi = args.ph_hi;
    XcdBarrier bar; bar.bar = (unsigned*)(ARGWS() + WS_CTL) + CW_BAR; bar.x = 0; bar.st = nullptr;
    if (hi - lo > 1) bar = xcd_barrier_post((unsigned*)(ARGWS() + WS_CTL) + CW_BAR, F.MISC + 8);
#define IN(k) (lo <= (k) && (k) < hi)
#define FRESH() do { asm volatile("" : "+v"(F.tid), "+s"(F.vcu), "+s"(F.G)); F.lane = F.tid & 63; F.wave = __builtin_amdgcn_readfirstlane(F.tid >> 6); bx = (int)blockIdx.x; asm volatile("" : "+s"(bx)); } while (0)
    int bx;
#define SEAM(k) do { if (IN(k) && IN((k) + 1)) xcd_barrier(bar); } while (0)
    if (IN(0)) { FRESH(); p0_weights(F); __syncthreads(); pre_rows(F, ARGF(0), 0); }
    SEAM(0);
    for (int l = 0; l < DEPTH; ++l) {
        const int pb = 1 + l * PH_PER_LAYER;
        if (IN(pb + 0)) { FRESH();
            unsigned char* ws = ARGWS(); unsigned char* wb = ws + WS_W + (size_t)l * W_LAYER;
            pg8::Gemm g{(const bf16*)(ws + WS_XB), (const bf16*)(wb + W_IN), M, NPROJ, DM}; pg8::StaticOrder S; S.init(M, NPROJ, F.G, bx);
            pg8::EpiProj E{(bf16*)(ws + WS_PROJ), (const float*)(ws + WS_RSTD), ARGF(3) + l * 64, ARGF(4) + l * 64, ARGF(5) + l * 64, ARGF(6) + l * 64};
            pg8::gemm_phase<pg8::EpiProj, pg8::StaticOrder, true, true>(F.lds + RING_OFF, g, S, E);
        }
        SEAM(pb + 0);
        if (IN(pb + 1)) { FRESH(); conv_naive(F, l); kmean_naive(F); mixA_naive(F); }
        SEAM(pb + 1);
        if (IN(pb + 2)) { FRESH(); scan_naive(F, l); mixC_naive(F); }
        SEAM(pb + 2);
        if (IN(pb + 3)) { FRESH(); gate_norm_naive(F, l); }
        SEAM(pb + 3);
        if (IN(pb + 4)) { FRESH();
            unsigned char* ws = ARGWS(); unsigned char* wb = ws + WS_W + (size_t)l * W_LAYER; float* out = ARGOUT();
            pg8::Gemm g{(const bf16*)(ws + WS_Y), (const bf16*)(wb + W_OUT), M, DM, DM}; pg8::StaticOrder S; S.init(M, DM, F.G, bx);
            pg8::EpiRes1 E{l == 0 ? ARGF(0) : (const float*)out, out, (bf16*)(ws + WS_XB), (float*)(ws + WS_SSQ) + (size_t)l * M};
            pg8::gemm_phase<pg8::EpiRes1, pg8::StaticOrder, false, true>(F.lds + RING_OFF, g, S, E);
        }
        SEAM(pb + 4);
        if (IN(pb + 5)) { FRESH();
            unsigned char* ws = ARGWS(); unsigned char* wb = ws + WS_W + (size_t)l * W_LAYER;
            pg8::Gemm g{(const bf16*)(ws + WS_XB), (const bf16*)(wb + W_1), M, FF, DM}; pg8::StaticOrder S; S.init(M, FF, F.G, bx);
            pg8::EpiRelu2 E{(bf16*)(ws + WS_H), (const float*)(ws + WS_SSQ) + (size_t)l * M};
            pg8::gemm_phase<pg8::EpiRelu2, pg8::StaticOrder, true, true>(F.lds + RING_OFF, g, S, E);
        }
        SEAM(pb + 5);
        if (IN(pb + 6)) { FRESH();
            unsigned char* ws = ARGWS(); unsigned char* wb = ws + WS_W + (size_t)l * W_LAYER;
            pg8::Gemm g{(const bf16*)(ws + WS_H), (const bf16*)(wb + W_2), M, DM, FF}; pg8::StaticOrder S; S.init(M, DM, F.G, bx);
            pg8::EpiRes2 E{ARGOUT()};
            pg8::gemm_phase<pg8::EpiRes2, pg8::StaticOrder, false, true>(F.lds + RING_OFF, g, S, E);
        }
        SEAM(pb + 6);
        if (IN(pb + 7)) { FRESH(); if (l + 1 < DEPTH) pre_rows(F, ARGOUT(), l + 1); }
        SEAM(pb + 7);
    }
#undef IN
#undef SEAM
}

#ifndef MK_N_LAUNCHES
#define MK_N_LAUNCHES 1
#endif
extern "C" void kernel_launch(void* const* d_in, const int* in_sizes, int n_in, void* d_out, int out_size, void* d_ws, size_t ws_size, hipStream_t stream) {
    static int grid = 0;
    if (grid == 0) {
        if (n_in != 17 || in_sizes[0] != M * DM || out_size != M * DM || ws_size < WS_END) { fprintf(stderr, "kernel_launch: unexpected shapes (n_in %d, in0 %d, out %d, ws %zu)\n", n_in, n_in > 0 ? in_sizes[0] : -1, out_size, ws_size); grid = -1; return; }
        int dev = 0, cus = 0, per_cu = 0;
        if (hipGetDevice(&dev) != hipSuccess || hipDeviceGetAttribute(&cus, hipDeviceAttributeMultiprocessorCount, dev) != hipSuccess) { grid = -1; return; }
        if (hipFuncSetAttribute((const void*)mk_fwd, hipFuncAttributeMaxDynamicSharedMemorySize, LDS_BYTES) != hipSuccess) { fprintf(stderr, "kernel_launch: hipFuncSetAttribute failed\n"); grid = -1; return; }
        if (hipOccupancyMaxActiveBlocksPerMultiprocessor(&per_cu, (const void*)mk_fwd, NWAVES * 64, LDS_BYTES) != hipSuccess || per_cu < 1) { fprintf(stderr, "kernel_launch: occupancy query says %d blocks per CU\n", per_cu); }
        (void)hipGetLastError();
        grid = cus;
    }
    if (grid < 0) return;
    if (hipMemsetAsync((char*)d_ws + WS_CTL, 0, CTL_ZERO_BYTES, stream) != hipSuccess) { fprintf(stderr, "kernel_launch: memset failed\n"); return; }
    Args a{};
    for (int i = 0; i < 17; ++i) a.in[i] = (const float*)d_in[i];
    a.out = (float*)d_out; a.ws = (unsigned char*)d_ws;
    const int NL = MK_N_LAUNCHES;
    if (NL == 1) { a.ph_lo = 0; a.ph_hi = N_PHASES; hipLaunchKernelGGL(mk_fwd, dim3(grid), dim3(NWAVES * 64), LDS_BYTES, stream, a); }
    else { for (int p = 0; p < N_PHASES; ++p) { a.ph_lo = p; a.ph_hi = p + 1; hipLaunchKernelGGL(mk_fwd, dim3(grid), dim3(NWAVES * 64), LDS_BYTES, stream, a); } }
    const hipError_t le = hipPeekAtLastError();
    if (le != hipSuccess) fprintf(stderr, "kernel_launch: launch failed: %s\n", hipGetErrorName(le));
}
```

```cpp
#include <hip/hip_runtime.h>
#include <cstdio>
#include <cstdint>
#include <cmath>
__device__ __forceinline__ int lane_id() { return (int)__builtin_amdgcn_mbcnt_hi(~0u, __builtin_amdgcn_mbcnt_lo(~0u, 0u)); }
namespace pg8 {
#define PG8_LAS __attribute__((address_space(3)))
typedef unsigned short bf16_t;
typedef short bf16x8 __attribute__((ext_vector_type(8)));
typedef float f32x4 __attribute__((ext_vector_type(4)));
typedef unsigned u32x4 __attribute__((ext_vector_type(4)));
constexpr int BM = 256, BK = 64, HALF = 128, HTB = HALF * BK * 2  , STAGE_BYTES = 8 * HTB, NXCD = 8, WGM = 4;

__host__ __device__ __forceinline__ int lds_byte(int r, int c) { const int st = (r >> 4) * 2 + (c >> 5), rr = r & 15, cc = c & 31, ob = rr * 64 + cc * 2; return st * 1024 + (ob ^ (((ob >> 9) & 1) << 5)); }
__host__ __device__ __forceinline__ void stage_rc(int b, int& R, int& C) { const int st = b / 1024, sb = b % 1024, swz = sb ^ (((sb >> 9) & 1) << 5); R = (st >> 1) * 16 + swz / 64; C = (st & 1) * 32 + (swz % 64) / 2; }
__host__ __device__ __forceinline__ int perm32(int rho) { const int n = rho >> 4, i = rho & 15; return 8 * (i >> 2) + 4 * n + (i & 3); }

struct Unit { int pm, pn; };
struct Gemm { const bf16_t* A; const bf16_t* Bt; int M, N, K; };

struct StaticOrder {
    int nM, nN, nwg, G, c;
    __host__ __device__ void init(int M, int N, int G_, int c_) { nM = M / BM; nN = N / BM; nwg = nM * nN; G = G_; c = c_; }
    __host__ __device__ bool next(int i, Unit& u) const {
        const long L = (long)i * G + c; if (L >= nwg) return false;
        int wgid = (int)L; { const int q = nwg / NXCD, r = nwg % NXCD, xcd = wgid % NXCD, off = wgid / NXCD; wgid = (xcd < r ? xcd * (q + 1) : r * (q + 1) + (xcd - r) * q) + off; }
        const int nig = WGM * nN, gid = wgid / nig, fm = gid * WGM, gsz = (nM - fm) < WGM ? (nM - fm) : WGM;
        u.pm = fm + ((wgid % nig) % gsz); u.pn = (wgid % nig) / gsz; return true;
    }
    __device__ __forceinline__ void a_ready(const Unit&) const {}
    __device__ __forceinline__ void done(const Unit&) const {}
};

__device__ __forceinline__ unsigned cvt_pk_bf16(float lo, float hi) { unsigned r; asm volatile("v_cvt_pk_bf16_f32 %0, %1, %2" : "=v"(r) : "v"(lo), "v"(hi)); return r; }
typedef float f32x2 __attribute__((ext_vector_type(2)));
typedef unsigned u32x2 __attribute__((ext_vector_type(2)));
struct EpiProj {
    static constexpr bool PERM = true, AFTER_DRAIN = false;
    bf16_t* P; const float* rss; const float *g0, *g1, *g2, *g3;
    float* kms;
    __device__ __forceinline__ void operator()(const f32x4 (&acc)[2][2][4][2], const Unit& u, int wr, int wc, int fr, int fq) const {
        const int pn = u.pn; const int nsel = (pn == 0) ? 0 : (pn == 1) ? 1 : (pn == 3) ? 2 : (pn == 4) ? 3 : -1;
        const int row0 = u.pm * BM + wr * 64 + fr;
        const float* nw = (nsel == 0) ? g0 : (nsel == 1) ? g1 : (nsel == 2) ? g2 : g3;
        f32x4 g[2][2];
#pragma unroll
        for (int bj = 0; bj < 2; ++bj)
#pragma unroll
            for (int n = 0; n < 2; ++n) g[bj][n] = (nsel >= 0) ? *(const f32x4*)(nw + 32 * bj + 8 * fq + 4 * n) : (f32x4){1.f, 1.f, 1.f, 1.f};
        f32x4 cs[2][2];
#pragma unroll
        for (int bj = 0; bj < 2; ++bj)
#pragma unroll
            for (int n = 0; n < 2; ++n) cs[bj][n] = (f32x4){0.f, 0.f, 0.f, 0.f};
#pragma unroll
        for (int ai = 0; ai < 2; ++ai)
#pragma unroll
            for (int m = 0; m < 4; ++m) {
                const int row = row0 + ai * HALF + m * 16; const float r = 1.0f / sqrtf(rss[row] * (1.0f / 1024.0f) + 1e-6f);
                f32x4 v[2][2]; float ss = 0.f;
#pragma unroll
                for (int bj = 0; bj < 2; ++bj)
#pragma unroll
                    for (int n = 0; n < 2; ++n) { v[bj][n] = acc[ai][bj][m][n] * r; const f32x4 x = v[bj][n]; ss += (x[0] * x[0] + x[1] * x[1]) + (x[2] * x[2] + x[3] * x[3]); }
                if (nsel >= 0) {
                    ss += __shfl_xor(ss, 16); ss += __shfl_xor(ss, 32);
                    const float hr = 1.0f / sqrtf(ss * (1.0f / 64.0f) + 1e-6f);
#pragma unroll
                    for (int bj = 0; bj < 2; ++bj)
#pragma unroll
                        for (int n = 0; n < 2; ++n) { v[bj][n] = v[bj][n] * hr * g[bj][n]; cs[bj][n] += v[bj][n]; }
                }
                bf16_t* rowp = P + (size_t)row * 3072 + pn * BM + wc * 64 + 8 * fq;
#pragma unroll
                for (int bj = 0; bj < 2; ++bj) { u32x4 w; w.x = cvt_pk_bf16(v[bj][0][0], v[bj][0][1]); w.y = cvt_pk_bf16(v[bj][0][2], v[bj][0][3]); w.z = cvt_pk_bf16(v[bj][1][0], v[bj][1][1]); w.w = cvt_pk_bf16(v[bj][1][2], v[bj][1][3]);
                    *(u32x4*)(rowp + 32 * bj) = w; }
            }
        if (nsel == 3) {
            float* dst = kms + ((size_t)(u.pm * 4 + wc)) * 64 + 8 * fq;
#pragma unroll
            for (int bj = 0; bj < 2; ++bj)
#pragma unroll
                for (int n = 0; n < 2; ++n)
#pragma unroll
                    for (int e = 0; e < 4; ++e) { float s = cs[bj][n][e]; s += __shfl_xor(s, 1); s += __shfl_xor(s, 2); s += __shfl_xor(s, 4); s += __shfl_xor(s, 8);
                        if (fr == 0) atomicAdd(dst + 32 * bj + 4 * n + e, s); }
        }
    }
};
struct EpiRes1 {
    static constexpr bool PERM = true, AFTER_DRAIN = false;
    const bf16_t* baseb; bf16_t* xb; float* ssq;
    __device__ __forceinline__ void operator()(const f32x4 (&acc)[2][2][4][2], const Unit& u, int wr, int wc, int fr, int fq) const {
        const int col0 = u.pn * BM + wc * 32 + 8 * fq;
#pragma unroll
        for (int ai = 0; ai < 2; ++ai)
#pragma unroll
            for (int m = 0; m < 4; ++m) {
                const int row = u.pm * BM + ai * HALF + wr * 64 + m * 16 + fr; const size_t off = (size_t)row * 1024 + col0; float ss = 0.f;
#pragma unroll
                for (int bj = 0; bj < 2; ++bj) { const size_t o2 = off + bj * HALF;
                    const u32x4 h = *(const u32x4*)(baseb + o2);
                    f32x4 o0, o1;
                    o0[0] = __uint_as_float(h.x << 16); o0[1] = __uint_as_float(h.x & 0xffff0000u); o0[2] = __uint_as_float(h.y << 16); o0[3] = __uint_as_float(h.y & 0xffff0000u);
                    o1[0] = __uint_as_float(h.z << 16); o1[1] = __uint_as_float(h.z & 0xffff0000u); o1[2] = __uint_as_float(h.w << 16); o1[3] = __uint_as_float(h.w & 0xffff0000u);
                    o0 = o0 + acc[ai][bj][m][0]; o1 = o1 + acc[ai][bj][m][1];
                    u32x4 w; w.x = cvt_pk_bf16(o0[0], o0[1]); w.y = cvt_pk_bf16(o0[2], o0[3]); w.z = cvt_pk_bf16(o1[0], o1[1]); w.w = cvt_pk_bf16(o1[2], o1[3]); *(u32x4*)(xb + o2) = w;
                    ss += ((o0[0] * o0[0] + o0[1] * o0[1]) + (o0[2] * o0[2] + o0[3] * o0[3])) + ((o1[0] * o1[0] + o1[1] * o1[1]) + (o1[2] * o1[2] + o1[3] * o1[3])); }
                ss += __shfl_xor(ss, 16); ss += __shfl_xor(ss, 32);
                if (fq == 0) atomicAdd(ssq + row, ss);
            }
    }
};
struct EpiRelu2 {
    static constexpr bool PERM = true, AFTER_DRAIN = false;
    bf16_t* H; const float* ssq;
    __device__ __forceinline__ void operator()(const f32x4 (&acc)[2][2][4][2], const Unit& u, int wr, int wc, int fr, int fq) const {
        const int col0 = u.pn * BM + wc * 32 + 8 * fq;
#pragma unroll
        for (int ai = 0; ai < 2; ++ai)
#pragma unroll
            for (int m = 0; m < 4; ++m) {
                const int row = u.pm * BM + ai * HALF + wr * 64 + m * 16 + fr; const float r = 1.0f / sqrtf(ssq[row] * (1.0f / 1024.0f) + 1e-6f);
                bf16_t* rowp = H + (size_t)row * 4096 + col0;
#pragma unroll
                for (int bj = 0; bj < 2; ++bj) { f32x4 v0 = acc[ai][bj][m][0] * r, v1 = acc[ai][bj][m][1] * r;
#pragma unroll
                    for (int e = 0; e < 4; ++e) { const float a = fmaxf(v0[e], 0.f), b = fmaxf(v1[e], 0.f); v0[e] = a * a; v1[e] = b * b; }
                    u32x4 w; w.x = cvt_pk_bf16(v0[0], v0[1]); w.y = cvt_pk_bf16(v0[2], v0[3]); w.z = cvt_pk_bf16(v1[0], v1[1]); w.w = cvt_pk_bf16(v1[2], v1[3]);
                    *(u32x4*)(rowp + bj * HALF) = w; }
            }
    }
};
struct EpiRes2 {
    static constexpr bool PERM = true, AFTER_DRAIN = false;
    float* out; const bf16_t* xhi; bf16_t* xnb; float* ssqn;
    __device__ __forceinline__ void operator()(const f32x4 (&acc)[2][2][4][2], const Unit& u, int wr, int wc, int fr, int fq) const {
        const int col0 = u.pn * BM + wc * 32 + 8 * fq;
#pragma unroll
        for (int ai = 0; ai < 2; ++ai)
#pragma unroll
            for (int m = 0; m < 4; ++m) {
                const int row = u.pm * BM + ai * HALF + wr * 64 + m * 16 + fr; const size_t off = (size_t)row * 1024 + col0; float ss = 0.f;
#pragma unroll
                for (int bj = 0; bj < 2; ++bj) { const size_t o2 = off + bj * HALF;
                    const u32x4 h = *(const u32x4*)(xhi + o2);
                    f32x4 o0, o1;
                    o0[0] = __uint_as_float(h.x << 16); o0[1] = __uint_as_float(h.x & 0xffff0000u); o0[2] = __uint_as_float(h.y << 16); o0[3] = __uint_as_float(h.y & 0xffff0000u);
                    o1[0] = __uint_as_float(h.z << 16); o1[1] = __uint_as_float(h.z & 0xffff0000u); o1[2] = __uint_as_float(h.w << 16); o1[3] = __uint_as_float(h.w & 0xffff0000u);
                    o0 = o0 + acc[ai][bj][m][0]; o1 = o1 + acc[ai][bj][m][1];
                    if (xnb) { u32x4 w; w.x = cvt_pk_bf16(o0[0], o0[1]); w.y = cvt_pk_bf16(o0[2], o0[3]); w.z = cvt_pk_bf16(o1[0], o1[1]); w.w = cvt_pk_bf16(o1[2], o1[3]); *(u32x4*)(xnb + o2) = w;
                        ss += ((o0[0] * o0[0] + o0[1] * o0[1]) + (o0[2] * o0[2] + o0[3] * o0[3])) + ((o1[0] * o1[0] + o1[1] * o1[1]) + (o1[2] * o1[2] + o1[3] * o1[3])); }
                    else { *(f32x4*)(out + o2) = o0; *(f32x4*)(out + o2 + 4) = o1; } }
                if (xnb) { ss += __shfl_xor(ss, 16); ss += __shfl_xor(ss, 32); if (fq == 0) atomicAdd(ssqn + row, ss); }
            }
    }
};
template <class Epi, class Sched, bool ALIGN_EPI = false, bool SP2 = false>
__device__ __forceinline__ void gemm_phase(PG8_LAS unsigned char* lds, const Gemm g, const Sched& S, const Epi& E, const int wave_in) {
    int tid_ = wave_in * 64 + lane_id(); asm volatile("" : "+v"(tid_));
    const int tid = tid_, wid = __builtin_amdgcn_readfirstlane(tid >> 6), lane = tid & 63, wr = wid >> 2, wc = wid & 3, fr = lane & 15, fq = lane >> 4;
    const int K = g.K, nt = K / BK;
    unsigned voffA[2], voffB[2];
#pragma unroll
    for (int i = 0; i < 2; ++i) { int R, C; stage_rc(tid * 16 + i * 8192, R, C); const int Rb = Epi::PERM ? ((R & ~31) + perm32(R & 31)) : R;
        voffA[i] = (unsigned)(R * K + C) * 2u; voffB[i] = (unsigned)(Rb * K + C) * 2u; }
    const size_t kstep = (size_t)(BK * 2);
    const size_t hstep = (size_t)HALF * K * 2;
    const size_t tstep = 2 * hstep;
    const unsigned ldsw = (unsigned)wid * 1024u;
    const int aoff = lds_byte(wr * 64 + fr, fq * 8), boff = lds_byte(wc * 32 + fr, fq * 8);
#define PG8_SA(b, h) (((b) * 2 + (h)) * HTB)
#define PG8_SB(b, h) ((4 + (b) * 2 + (h)) * HTB)
#define PG8_STAGE(bufoff, gbase, voff) do { _Pragma("unroll") for (int _i = 0; _i < 2; ++_i) \
        __builtin_amdgcn_global_load_lds((const unsigned*)((const char*)(gbase) + (voff)[_i]), (PG8_LAS unsigned*)(lds + (bufoff) + ldsw + _i * 8192), 16, 0, 0); } while (0)
#define PG8_LDA(dst, b, h) do { _Pragma("unroll") for (int m = 0; m < 4; ++m) _Pragma("unroll") for (int k = 0; k < 2; ++k) dst[m][k] = *(const PG8_LAS bf16x8*)(lds + PG8_SA(b, h) + aoff + m * 2048 + k * 1024); } while (0)
#define PG8_LDB(dst, b, h) do { _Pragma("unroll") for (int n = 0; n < 2; ++n) _Pragma("unroll") for (int k = 0; k < 2; ++k) dst[n][k] = *(const PG8_LAS bf16x8*)(lds + PG8_SB(b, h) + boff + n * 2048 + k * 1024); } while (0)
#define PG8_MMA(ai, bj, At, Bt) do { __builtin_amdgcn_s_setprio(1); _Pragma("unroll") for (int m = 0; m < 4; ++m) _Pragma("unroll") for (int n = 0; n < 2; ++n) _Pragma("unroll") for (int k = 0; k < 2; ++k) \
        acc[ai][bj][m][n] = __builtin_amdgcn_mfma_f32_16x16x32_bf16(Bt[n][k], At[m][k], acc[ai][bj][m][n], 0, 0, 0); __builtin_amdgcn_s_setprio(0); } while (0)
#define PG8_WAIT_V(n) asm volatile("s_waitcnt vmcnt(" #n ")" ::: "memory")
#define PG8_WAIT_L(n) asm volatile("s_waitcnt lgkmcnt(" #n ")" ::: "memory")
#define PG8_BAR __builtin_amdgcn_s_barrier()
#define PG8_SCHED __builtin_amdgcn_sched_barrier(0)
    Unit cur, nxt; int ui = 0;
    if (!S.next(0, cur)) return;
    f32x4 acc[2][2][4][2];
#pragma unroll
    for (int a = 0; a < 2; ++a)
#pragma unroll
        for (int b = 0; b < 2; ++b)
#pragma unroll
            for (int m = 0; m < 4; ++m)
#pragma unroll
                for (int n = 0; n < 2; ++n) acc[a][b][m][n] = (f32x4){0.f, 0.f, 0.f, 0.f};
    bf16x8 At[4][2], B0[2][2], B1[2][2];
    const char* cA = (const char*)g.A + (size_t)cur.pm * tstep; const char* cB = (const char*)g.Bt + (size_t)cur.pn * tstep;
    S.a_ready(cur);
    if constexpr (SP2) {
        PG8_STAGE(PG8_SB(0, 0), cB, voffB); PG8_STAGE(PG8_SB(0, 1), cB + hstep, voffB); PG8_STAGE(PG8_SA(0, 0), cA, voffA); PG8_STAGE(PG8_SA(0, 1), cA + hstep, voffA);
        if (wr == 1) PG8_BAR;
        PG8_WAIT_V(2); PG8_BAR;
        PG8_STAGE(PG8_SB(1, 0), cB + kstep, voffB); PG8_STAGE(PG8_SA(1, 0), cA + kstep, voffA); PG8_STAGE(PG8_SB(1, 1), cB + hstep + kstep, voffB);
        PG8_WAIT_V(6); PG8_BAR;
    } else {
        PG8_STAGE(PG8_SB(0, 0), cB, voffB); PG8_STAGE(PG8_SA(0, 0), cA, voffA); PG8_STAGE(PG8_SB(0, 1), cB + hstep, voffB); PG8_STAGE(PG8_SA(0, 1), cA + hstep, voffA);
        if (wr == 1) PG8_BAR;
        PG8_WAIT_V(4); PG8_BAR;
        PG8_STAGE(PG8_SB(1, 0), cB + kstep, voffB); PG8_STAGE(PG8_SA(1, 0), cA + kstep, voffA); PG8_STAGE(PG8_SB(1, 1), cB + hstep + kstep, voffB);
        PG8_WAIT_V(6); PG8_BAR;
    }
    for (;;) {
        const bool has_next = S.next(ui + 1, nxt);
        const char* nA = has_next ? (const char*)g.A + (size_t)nxt.pm * tstep : cA; const char* nB = has_next ? (const char*)g.Bt + (size_t)nxt.pn * tstep : cB;
        for (int t = 0; t < nt; t += 2) {
            const bool last = (t == nt - 2);
            const char* a1 = cA + (size_t)(t + 1) * kstep;
            const char* a2 = last ? nA : cA + (size_t)(t + 2) * kstep; const char* b2 = last ? nB : cB + (size_t)(t + 2) * kstep;
            const char* a3 = a2 + kstep; const char* b3 = b2 + kstep;
            if (last && has_next) S.a_ready(nxt);
            if constexpr (SP2) {
            PG8_LDB(B0, 0, 0); PG8_LDB(B1, 0, 1); PG8_SCHED; PG8_LDA(At, 0, 0); PG8_STAGE(PG8_SA(1, 1), a1 + hstep, voffA);
            PG8_WAIT_V(8); PG8_WAIT_L(0); PG8_BAR; PG8_MMA(0, 0, At, B0); PG8_MMA(0, 1, At, B1); PG8_BAR; PG8_SCHED;
            PG8_LDA(At, 0, 1); PG8_STAGE(PG8_SB(0, 0), b2, voffB); PG8_STAGE(PG8_SB(0, 1), b2 + hstep, voffB); PG8_STAGE(PG8_SA(0, 0), a2, voffA);
            PG8_WAIT_V(8); PG8_WAIT_L(0); PG8_BAR; PG8_MMA(1, 0, At, B0); PG8_MMA(1, 1, At, B1); PG8_BAR; PG8_SCHED;
            PG8_LDB(B0, 1, 0); PG8_LDB(B1, 1, 1); PG8_SCHED; PG8_LDA(At, 1, 0); PG8_STAGE(PG8_SA(0, 1), a2 + hstep, voffA);
            PG8_WAIT_V(8); PG8_WAIT_L(0); PG8_BAR; PG8_MMA(0, 0, At, B0); PG8_MMA(0, 1, At, B1); PG8_BAR; PG8_SCHED;
            PG8_LDA(At, 1, 1); PG8_STAGE(PG8_SB(1, 0), b3, voffB); PG8_STAGE(PG8_SB(1, 1), b3 + hstep, voffB); PG8_STAGE(PG8_SA(1, 0), a3, voffA);
            PG8_WAIT_V(8); PG8_WAIT_L(0); PG8_BAR; PG8_MMA(1, 0, At, B0); PG8_MMA(1, 1, At, B1); PG8_BAR; PG8_SCHED;
            } else {
            PG8_LDB(B0, 0, 0); PG8_SCHED; PG8_LDA(At, 0, 0); PG8_STAGE(PG8_SA(1, 1), a1 + hstep, voffA);
            PG8_WAIT_L(8); PG8_BAR; PG8_WAIT_L(0); PG8_MMA(0, 0, At, B0); PG8_BAR; PG8_SCHED;
            PG8_LDB(B1, 0, 1); PG8_STAGE(PG8_SB(0, 0), b2, voffB);
            PG8_BAR; PG8_WAIT_L(0); PG8_MMA(0, 1, At, B1); PG8_BAR;
            PG8_LDA(At, 0, 1); PG8_STAGE(PG8_SA(0, 0), a2, voffA);
            PG8_BAR; PG8_WAIT_L(0); PG8_MMA(1, 0, At, B0); PG8_BAR; PG8_SCHED;
            PG8_STAGE(PG8_SB(0, 1), b2 + hstep, voffB);
            PG8_WAIT_V(6); PG8_BAR; PG8_MMA(1, 1, At, B1); PG8_BAR;
            PG8_LDB(B0, 1, 0); PG8_SCHED; PG8_LDA(At, 1, 0); PG8_STAGE(PG8_SA(0, 1), a2 + hstep, voffA);
            PG8_WAIT_L(8); PG8_BAR; PG8_WAIT_L(0); PG8_MMA(0, 0, At, B0); PG8_BAR; PG8_SCHED;
            PG8_LDB(B1, 1, 1); PG8_STAGE(PG8_SB(1, 0), b3, voffB);
            PG8_BAR; PG8_WAIT_L(0); PG8_MMA(0, 1, At, B1); PG8_BAR;
            PG8_LDA(At, 1, 1); PG8_STAGE(PG8_SA(1, 0), a3, voffA);
            PG8_BAR; PG8_WAIT_L(0); PG8_MMA(1, 0, At, B0); PG8_BAR; PG8_SCHED;
            PG8_STAGE(PG8_SB(1, 1), b3 + hstep, voffB);
            PG8_WAIT_V(6); PG8_BAR; PG8_MMA(1, 1, At, B1); PG8_BAR;
            }
        }
        if constexpr (ALIGN_EPI) { if (wr == 0) PG8_BAR; }
        if constexpr (!Epi::AFTER_DRAIN) { E(acc, cur, wr, wc, fr, fq); S.done(cur); }
        if (!has_next) break;
#pragma unroll
        for (int a = 0; a < 2; ++a)
#pragma unroll
            for (int b = 0; b < 2; ++b)
#pragma unroll
                for (int m = 0; m < 4; ++m)
#pragma unroll
                    for (int n = 0; n < 2; ++n) acc[a][b][m][n] = (f32x4){0.f, 0.f, 0.f, 0.f};
        cur = nxt; cA = nA; cB = nB; ++ui;
        if constexpr (ALIGN_EPI) { if (wr == 1) PG8_BAR; }
    }
    PG8_WAIT_V(0);
    if constexpr (!ALIGN_EPI) { if (wr == 0) PG8_BAR; }
    PG8_BAR;
    if constexpr (Epi::AFTER_DRAIN) { E.fused(acc, cur, wr, wc, fr, fq, lds, wid, lane); S.done(cur); }
#undef PG8_SA
#undef PG8_SB
#undef PG8_STAGE
#undef PG8_LDA
#undef PG8_LDB
#undef PG8_MMA
#undef PG8_WAIT_V
#undef PG8_WAIT_L
#undef PG8_BAR
#undef PG8_SCHED
}
}
#define GAS __attribute__((address_space(1)))
#define LAS __attribute__((address_space(3)))
typedef unsigned short bf16;
typedef unsigned v4u __attribute__((ext_vector_type(4)));
typedef float f32x4 __attribute__((ext_vector_type(4)));
typedef short bf16x8 __attribute__((ext_vector_type(8)));
typedef GAS unsigned gu32;
typedef GAS unsigned long long gu64;
#define RLX_AGENT __ATOMIC_RELAXED, __HIP_MEMORY_SCOPE_AGENT
#define LDS_WAIT() asm volatile("s_waitcnt lgkmcnt(0)" ::: "memory")
#define VM_WAIT() asm volatile("s_waitcnt vmcnt(0)" ::: "memory")
__device__ __forceinline__ unsigned long long rt() { return __builtin_amdgcn_s_memrealtime(); }
__device__ __forceinline__ unsigned f2bf(float f) { unsigned u = __builtin_bit_cast(unsigned, f); return (u + 0x7fffu + ((u >> 16) & 1u)) >> 16; }
__device__ __forceinline__ unsigned pk2(float lo, float hi) { typedef float f2_t __attribute__((ext_vector_type(2))); typedef __bf16 b2_t __attribute__((ext_vector_type(2))); const f2_t v = {lo, hi}; return __builtin_bit_cast(unsigned, __builtin_convertvector(v, b2_t)); }
#define XB_TMO      128
#define XB_XCNT(j)  (256  + 64 * (j))
#define XB_XSUB(j)  (1280 + 64 * (j))
#define XB_XGEN(j)  (2304 + 64 * (j))
#define XB_TOP      3328
#define XB_TOPGEN   3392
#define XCD_BAR_WORDS 3456
#define XB_SPIN_CAP (1u << 18)

__device__ __forceinline__ unsigned xb_ld(unsigned* p)              { return __hip_atomic_load(p, __ATOMIC_RELAXED, __HIP_MEMORY_SCOPE_AGENT); }
__device__ __forceinline__ unsigned xb_add(unsigned* p, unsigned v) { return __hip_atomic_fetch_add(p, v, __ATOMIC_RELAXED, __HIP_MEMORY_SCOPE_AGENT); }
__device__ __forceinline__ unsigned xb_xcc_id() { return (unsigned)__builtin_amdgcn_s_getreg((3 << 11) | 20) & 0xFu; }
#define XB_SPIN(cond, bar) do { unsigned _sp = 0; while (cond) { __builtin_amdgcn_s_sleep(1); \
    if ((++_sp & 255u) == 0u) { if (xb_ld(&(bar)[XB_TMO])) break; if (_sp > XB_SPIN_CAP) { atomicAdd(&(bar)[XB_TMO], 1u); break; } } } } while (0)

struct XcdBarrier {
    unsigned* bar; unsigned x;
    volatile LAS unsigned* st;
};

__device__ __forceinline__ XcdBarrier xcd_barrier_post(unsigned* bar, volatile LAS unsigned* st) {
    XcdBarrier b; b.bar = bar; b.x = xb_xcc_id(); b.st = st;
    if (threadIdx.x == 0) (void)xb_add(&bar[XB_XCNT(b.x)], 1u);
    return b;
}
__device__ __forceinline__ void xcd_barrier_complete(unsigned* bar, unsigned x, unsigned& nloc, unsigned& nx) {
    const unsigned G = gridDim.x * gridDim.y * gridDim.z;
    unsigned sum, cnt, mine, sp = 0u;
    for (;;) {
        sum = 0u; cnt = 0u; mine = 0u;
#pragma unroll
        for (unsigned j = 0; j < 16; ++j) { const unsigned c = xb_ld(&bar[XB_XCNT(j)]); sum += c; cnt += (c > 0u) ? 1u : 0u; mine = (j == x) ? c : mine; }
        if (sum == G) break;
        __builtin_amdgcn_s_sleep(1);
        if ((++sp & 255u) == 0u) { if (xb_ld(&bar[XB_TMO])) break; if (sp > XB_SPIN_CAP) { atomicAdd(&bar[XB_TMO], 1u); break; } }
    }
    nloc = mine > 0u ? mine : 1u; nx = cnt > 0u ? cnt : 1u;
}

__device__ __forceinline__ void xcd_barrier(const XcdBarrier& b, const bool leader  ) {
    asm volatile("s_waitcnt vmcnt(0)" ::: "memory");
    __syncthreads();
    unsigned zoff_ = 0u; asm volatile("s_mov_b32 %0, 0" : "=s"(zoff_)); unsigned* bar_ = b.bar + zoff_; const unsigned bx_ = b.x + zoff_;
    if (leader) {
        unsigned* bar = bar_;
        __builtin_amdgcn_s_waitcnt(0);
        unsigned nloc = b.st[0], nx = b.st[1];
        if (nloc == 0u) { xcd_barrier_complete(bar, bx_, nloc, nx); b.st[0] = nloc; b.st[1] = nx; }
        const unsigned old = xb_add(&bar[XB_XSUB(bx_)], 1u);
        const unsigned gen = old / nloc;
        if (old + 1u == (gen + 1u) * nloc) {
            __builtin_amdgcn_fence(__ATOMIC_RELEASE, "agent");
            asm volatile("s_waitcnt vmcnt(0)" ::: "memory");
            const unsigned og = xb_add(&bar[XB_TOP], 1u);
            const unsigned tg = og / nx;
            if (og + 1u == (tg + 1u) * nx) xb_add(&bar[XB_TOPGEN], 1u);
            else XB_SPIN(xb_ld(&bar[XB_TOPGEN]) == tg, bar);
            __builtin_amdgcn_fence(__ATOMIC_ACQUIRE, "agent");
            xb_add(&bar[XB_XGEN(bx_)], 1u);
            asm volatile("s_waitcnt vmcnt(0)" ::: "memory");
        } else {
            XB_SPIN(xb_ld(&bar[XB_XGEN(bx_)]) == gen, bar);
            __builtin_amdgcn_fence(__ATOMIC_ACQUIRE, "agent");
            asm volatile("s_waitcnt vmcnt(0)" ::: "memory");
        }
    }
    __syncthreads();
}
constexpr int NWAVES = 8;
constexpr int BATCH = 4, SEQ = 4096, DM = 1024, M = BATCH * SEQ, DIN = 3080, NPROJ = 3072, FF = 4096, DEPTH = 2;
constexpr int OFF_QA = 0, OFF_KA = 256, OFF_VA = 512, OFF_QC = 768, OFF_KC = 1024, OFF_VC = 1280, OFF_Z = 1536, OFF_XBC = 2048;
constexpr float EPS = 1e-6f;
constexpr size_t MiB = 1u << 20;
constexpr size_t WS_CTL = 0, CTL_ZERO_BYTES = 1 * MiB;
constexpr size_t WS_KMS = 512 * 1024;
constexpr size_t WS_SSQ2 = 384 * 1024;
constexpr size_t WS_SSQ = 256 * 1024;
constexpr size_t WS_W = 2 * MiB, W_LAYER = 24 * MiB, W_IN = 0, W_OUT = 6 * MiB, W_1 = 8 * MiB, W_2 = 16 * MiB;
constexpr size_t WS_RSTD = 50 * MiB, WS_DT = 51 * MiB, WS_KMEAN = 52 * MiB;
constexpr size_t WS_PROJ = 56 * MiB, WS_Y = 152 * MiB, WS_H = 56 * MiB, WS_XB = 184 * MiB, WS_ST = 216 * MiB, WS_END = 256 * MiB;
static_assert(WS_PROJ + (size_t)M * NPROJ * 2 <= WS_Y && WS_Y + (size_t)M * DM * 2 <= WS_XB && WS_H + (size_t)M * FF * 2 <= WS_XB && WS_XB + (size_t)M * DM * 2 <= WS_ST && WS_ST + 32 * MiB <= WS_END, "d_ws map");
constexpr int CW_BAR = 4096;
constexpr int RING_OFF = 0, RING_BYTES = 143360;
constexpr int LDSCTL_OFF = RING_BYTES, MISC_OFF = LDSCTL_OFF + 320;
constexpr int LDS_BYTES = 147456;

struct Frame {
    LAS unsigned char* lds; volatile LAS unsigned* MISC;
    int tid, lane, wave, vcu, G;
};
typedef const __attribute__((address_space(4))) unsigned char* kptr_t;
__device__ __forceinline__ kptr_t kargs() { kptr_t p = (kptr_t)__builtin_amdgcn_kernarg_segment_ptr(); asm volatile("" : "+s"(p)); return p; }
#define ARGF(i) (*(const float* const __attribute__((address_space(4)))*)(kargs() + 8 * (i)))
#define ARGOUT() (*(float* const __attribute__((address_space(4)))*)(kargs() + 8 * 17))
#define ARGWS() (*(unsigned char* const __attribute__((address_space(4)))*)(kargs() + 8 * 18))
__device__ __forceinline__ float wave_sum(float v) {
#pragma unroll
    for (int o = 1; o < 64; o <<= 1) v += __shfl_xor(v, o);
    return v;
}
__device__ __forceinline__ float wave_max(float v) {
#pragma unroll
    for (int o = 1; o < 64; o <<= 1) v = fmaxf(v, __shfl_xor(v, o));
    return v;
}
__device__ __forceinline__ float blo(unsigned w) { return __uint_as_float(w << 16); }
__device__ __forceinline__ float bhi(unsigned w) { return __uint_as_float(w & 0xffff0000u); }
__device__ __forceinline__ float bf2f(bf16 u) { return __uint_as_float((unsigned)u << 16); }

__device__ __forceinline__ void p0_transpose_item(const float* W, int ldw, int K, int nblk, bf16* WT, LAS float* scr, int item, int lane, const float* kscale, bool perm) {
    const int kb = item / nblk, nb = item % nblk, k0 = 64 * kb, n0 = 32 * nb;
#pragma unroll
    for (int i = 0; i < 8; ++i) { const int kk = 8 * i + (lane >> 3), c4 = 4 * (lane & 7); f32x4 v = *(const f32x4*)(W + (size_t)(k0 + kk) * ldw + n0 + c4);
        if (kscale) v = v * kscale[k0 + kk]; LAS float* d = scr + kk * 33 + c4; d[0] = v.x; d[1] = v.y; d[2] = v.z; d[3] = v.w; }
    LDS_WAIT(); asm volatile("" ::: "memory");
    const int c = lane & 7;
#pragma unroll
    for (int j = 0; j < 4; ++j) { const int n = (lane >> 3) + 8 * j; const LAS float* s = scr + (8 * c) * 33 + n;
        v4u o; o.x = pk2(s[0 * 33], s[1 * 33]); o.y = pk2(s[2 * 33], s[3 * 33]); o.z = pk2(s[4 * 33], s[5 * 33]); o.w = pk2(s[6 * 33], s[7 * 33]);
        int cc = n0 + n; if (perm) { const int cl = cc & 255; cc = (cc & ~255) + 128 * ((cl >> 5) & 1) + 32 * (cl >> 6) + (cl & 31); }
        *(GAS v4u*)(WT + (size_t)cc * K + k0 + 8 * c) = o; }
    LDS_WAIT(); asm volatile("" ::: "memory");
}
__device__ __forceinline__ void p0_weights(Frame& F) {
    LAS float* scr = (LAS float*)(F.lds + RING_OFF + F.wave * 16384);
    const int gw = F.vcu * NWAVES + F.wave, NGW = F.G * NWAVES;
    constexpr int I_IN = (DM / 64) * (NPROJ / 32), I_O = (DM / 64) * (DM / 32), I_1 = (DM / 64) * (FF / 32), I_2 = (FF / 64) * (DM / 32);
    constexpr int PER_L = I_IN + I_O + I_1 + I_2;
    for (int it = gw; it < DEPTH * PER_L; it += NGW) {
        const int l = it / PER_L; int r = it % PER_L;
        unsigned char* wb = ARGWS() + WS_W + (size_t)l * W_LAYER;
        if (r < I_IN) { p0_transpose_item(ARGF(2) + (size_t)l * DM * DIN, DIN, DM, NPROJ / 32, (bf16*)(wb + W_IN), scr, r, F.lane, ARGF(1) + l * DM, true); continue; } r -= I_IN;
        if (r < I_O) { p0_transpose_item(ARGF(13) + (size_t)l * DM * DM, DM, DM, DM / 32, (bf16*)(wb + W_OUT), scr, r, F.lane, nullptr, false); continue; } r -= I_O;
        if (r < I_1) { p0_transpose_item(ARGF(15) + (size_t)l * DM * FF, FF, DM, FF / 32, (bf16*)(wb + W_1), scr, r, F.lane, ARGF(14) + l * DM, false); continue; } r -= I_1;
        p0_transpose_item(ARGF(16) + (size_t)l * FF * DM, DM, FF, DM / 32, (bf16*)(wb + W_2), scr, r, F.lane, nullptr, false);
    }
}
__device__ __forceinline__ void pre_rows(Frame& F, const float* xs, int l) {
    LAS float* wdt = (LAS float*)(F.lds + RING_OFF);
    const float* win = ARGF(2) + (size_t)l * DM * DIN; const float* nw = ARGF(1) + l * DM;
#pragma unroll
    for (int m = 0; m < 2; ++m) { const int k = F.tid + 512 * m; const float g = nw[k];
        const f32x4 a = *(const f32x4*)(win + (size_t)k * DIN + NPROJ), b = *(const f32x4*)(win + (size_t)k * DIN + NPROJ + 4);
        wdt[0 * DM + k] = g * a.x; wdt[1 * DM + k] = g * a.y; wdt[2 * DM + k] = g * a.z; wdt[3 * DM + k] = g * a.w; wdt[4 * DM + k] = g * b.x; wdt[5 * DM + k] = g * b.y; wdt[6 * DM + k] = g * b.z; wdt[7 * DM + k] = g * b.w; }
    __syncthreads();
    const int gw = F.vcu * NWAVES + F.wave, NGW = F.G * NWAVES;
    bf16* xb = (bf16*)(ARGWS() + WS_XB); float* rstd1 = (float*)(ARGWS() + WS_RSTD); float* dt = (float*)(ARGWS() + WS_DT);
    const float bias = (F.lane < 8) ? ARGF(9)[l * 8 + F.lane] : 0.f;
    for (int row0 = gw; row0 < M; row0 += 2 * NGW) {
        f32x4 v[2][4]; float ss[2] = {0.f, 0.f};
#pragma unroll
        for (int q = 0; q < 2; ++q) { const f32x4* xr = (const f32x4*)(xs + (size_t)(row0 + q * NGW) * DM) + F.lane;
#pragma unroll
            for (int j = 0; j < 4; ++j) v[q][j] = xr[64 * j]; }
#pragma unroll
        for (int q = 0; q < 2; ++q) {
            const int row = row0 + q * NGW;
#pragma unroll
            for (int j = 0; j < 4; ++j) ss[q] += (v[q][j].x * v[q][j].x + v[q][j].y * v[q][j].y) + (v[q][j].z * v[q][j].z + v[q][j].w * v[q][j].w);
            const float ssw = wave_sum(ss[q]); const float rstd = 1.0f / sqrtf(ssw * (1.0f / DM) + EPS);
            unsigned long long* o8 = (unsigned long long*)(xb + (size_t)row * DM) + F.lane;
#pragma unroll
            for (int j = 0; j < 4; ++j) o8[64 * j] = (unsigned long long)pk2(v[q][j].x, v[q][j].y) | ((unsigned long long)pk2(v[q][j].z, v[q][j].w) << 32);
            float mine = 0.f;
#pragma unroll
            for (int jj = 0; jj < 8; ++jj) { float d = 0.f;
#pragma unroll
                for (int j = 0; j < 4; ++j) { const f32x4 w = *(const LAS f32x4*)(wdt + jj * DM + 256 * j + 4 * F.lane); d += (v[q][j].x * w.x + v[q][j].y * w.y) + (v[q][j].z * w.z + v[q][j].w * w.w); }
                d = wave_sum(d); if (F.lane == jj) mine = d; }
            if (F.lane < 8) { const float r = mine * rstd + bias; dt[(size_t)row * 8 + F.lane] = fmaxf(r, 0.f) + log1pf(expf(-fabsf(r))); }
            if (F.lane == 0) rstd1[row] = ssw;
        }
    }
    __syncthreads();
}

__device__ __forceinline__ void dt_rows_b(Frame& F, const bf16* xs, int l) {
    LAS float* wdt = (LAS float*)(F.lds + RING_OFF);
    const int gw = F.vcu * NWAVES + F.wave, NGW = F.G * NWAVES;
    static_assert(M == 8 * 256 * NWAVES, "dt_rows_b: 8 rows per wave on 256 workgroups");
    unsigned long long raw[8][4];
#pragma unroll
    for (int q = 0; q < 8; ++q)
#pragma unroll
        for (int j = 0; j < 4; ++j) raw[q][j] = *((const unsigned long long*)(xs + (size_t)(gw + q * NGW) * DM) + F.lane + 64 * j);
    const float* win = ARGF(2) + (size_t)l * DM * DIN; const float* nw = ARGF(1) + l * DM;
#pragma unroll
    for (int m = 0; m < 2; ++m) { const int k = F.tid + 512 * m; const float g = nw[k];
        const f32x4 a = *(const f32x4*)(win + (size_t)k * DIN + NPROJ), b = *(const f32x4*)(win + (size_t)k * DIN + NPROJ + 4);
        wdt[0 * DM + k] = g * a.x; wdt[1 * DM + k] = g * a.y; wdt[2 * DM + k] = g * a.z; wdt[3 * DM + k] = g * a.w; wdt[4 * DM + k] = g * b.x; wdt[5 * DM + k] = g * b.y; wdt[6 * DM + k] = g * b.z; wdt[7 * DM + k] = g * b.w; }
    float* dt = (float*)(ARGWS() + WS_DT);
    const float bias = (F.lane < 8) ? ARGF(9)[l * 8 + F.lane] : 0.f;
    __syncthreads();
#pragma unroll
    for (int q = 0; q < 8; ++q) {
        const int row = gw + q * NGW; f32x4 v[4]; float ss = 0.f;
#pragma unroll
        for (int j = 0; j < 4; ++j) { v[j].x = blo((unsigned)raw[q][j]); v[j].y = bhi((unsigned)raw[q][j]); v[j].z = blo((unsigned)(raw[q][j] >> 32)); v[j].w = bhi((unsigned)(raw[q][j] >> 32));
            ss += (v[j].x * v[j].x + v[j].y * v[j].y) + (v[j].z * v[j].z + v[j].w * v[j].w); }
        const float rstd = 1.0f / sqrtf(wave_sum(ss) * (1.0f / DM) + EPS);
        float mine = 0.f;
#pragma unroll
        for (int jj = 0; jj < 8; ++jj) { float d = 0.f;
#pragma unroll
            for (int j = 0; j < 4; ++j) { const f32x4 w = *(const LAS f32x4*)(wdt + jj * DM + 256 * j + 4 * F.lane); d += (v[j].x * w.x + v[j].y * w.y) + (v[j].z * w.z + v[j].w * w.w); }
            d = wave_sum(d); if (F.lane == jj) mine = d; }
        if (F.lane < 8) { const float r = mine * rstd + bias; dt[(size_t)row * 8 + F.lane] = fmaxf(r, 0.f) + log1pf(expf(-fabsf(r))); }
    }
    __syncthreads();
}
namespace att {
typedef float f32x16 __attribute__((ext_vector_type(16)));
typedef short v4i16_t __attribute__((ext_vector_type(4)));
typedef __bf16 bf16x2_t __attribute__((ext_vector_type(2)));
typedef float f32x2_t __attribute__((ext_vector_type(2)));
constexpr float C2 = 0.125f * 1.4426950408889634f;
constexpr int VROW = 192, VT_BYTES = 64 * VROW;
constexpr int BIGD = 1 << 28;
#define ATT_MFMA(a, b, c) __builtin_amdgcn_mfma_f32_32x32x16_bf16((a), (b), (c), 0, 0, 0)
__device__ __forceinline__ unsigned cvtpk(float lo, float hi) { f32x2_t v = {lo, hi}; return __builtin_bit_cast(unsigned, __builtin_convertvector(v, bf16x2_t)); }
__device__ __forceinline__ int clampt(int t) { return t < 0 ? 0 : (t > SEQ - 1 ? SEQ - 1 : t); }
__device__ __forceinline__ float half_max(float v) { auto rr = __builtin_amdgcn_permlane32_swap(__float_as_uint(v), __float_as_uint(v), false, false); return fmaxf(__uint_as_float(rr[0]), __uint_as_float(rr[1])); }
__device__ __forceinline__ float half_sum(float v) { auto rr = __builtin_amdgcn_permlane32_swap(__float_as_uint(v), __float_as_uint(v), false, false); return __uint_as_float(rr[0]) + __uint_as_float(rr[1]); }
struct St { f32x16 o0, o1; float m, l; };
template <int D> __device__ __forceinline__ void bias_vecs(f32x16& b0, f32x16& b1, float ns) {
#pragma unroll
    for (int r = 0; r < 16; ++r) { const int e0 = (r & 3) + 8 * (r >> 2); b0[r] = ns * (float)(D * e0); b1[r] = ns * (float)(D * (e0 + 32)); }
}
template <int MODE, int D, int VR>
__device__ __forceinline__ void tile_core(St& st, f32x16& u0, f32x16& u1, float zoff, bool okl, int D0, int maxd, LAS unsigned char* vrd) {
    if (MODE == 1) {
#pragma unroll
        for (int r = 0; r < 16; ++r) { const int e0 = (r & 3) + 8 * (r >> 2);
            u0[r] = ((unsigned)(D0 - D * e0) <= (unsigned)maxd) ? u0[r] : -INFINITY; u1[r] = ((unsigned)(D0 - D * (e0 + 32)) <= (unsigned)maxd) ? u1[r] : -INFINITY; }
    }
    float tmax = fmaxf(u0[0], u1[0]);
#pragma unroll
    for (int r = 1; r < 16; ++r) tmax = fmaxf(tmax, fmaxf(u0[r], u1[r]));
    tmax = (MODE == 0 && !okl) ? -INFINITY : tmax + zoff;
    tmax = half_max(tmax);
    if (__any(tmax > st.m)) { const float mn = fmaxf(st.m, tmax), al = __builtin_amdgcn_exp2f(C2 * (st.m - mn));
#pragma unroll
        for (int r = 0; r < 16; ++r) { st.o0[r] *= al; st.o1[r] *= al; }
        st.l *= al; st.m = mn; }
    const float off = (MODE == 0 && !okl) ? -INFINITY : C2 * (zoff - st.m);
    float ps = 0.f;
#pragma unroll
    for (int r = 0; r < 16; ++r) { u0[r] = __builtin_amdgcn_exp2f(fmaf(u0[r], C2, off)); u1[r] = __builtin_amdgcn_exp2f(fmaf(u1[r], C2, off)); ps += u0[r] + u1[r]; }
    st.l += ps;
#pragma unroll
    for (int sub = 0; sub < 2; ++sub)
#pragma unroll
        for (int s = 0; s < 2; ++s) {
            v4u pw;
            if (sub == 0) { pw.x = cvtpk(u0[8 * s], u0[8 * s + 1]); pw.y = cvtpk(u0[8 * s + 2], u0[8 * s + 3]); pw.z = cvtpk(u0[8 * s + 4], u0[8 * s + 5]); pw.w = cvtpk(u0[8 * s + 6], u0[8 * s + 7]); }
            else { pw.x = cvtpk(u1[8 * s], u1[8 * s + 1]); pw.y = cvtpk(u1[8 * s + 2], u1[8 * s + 3]); pw.z = cvtpk(u1[8 * s + 4], u1[8 * s + 5]); pw.w = cvtpk(u1[8 * s + 6], u1[8 * s + 7]); }
            const bf16x8 pb = __builtin_bit_cast(bf16x8, pw);
#pragma unroll
            for (int dblk = 0; dblk < 2; ++dblk) {
                const v4i16_t lo = __builtin_amdgcn_ds_read_tr16_b64_v4i16((LAS v4i16_t*)(vrd + (32 * sub + 16 * s) * VR + 64 * dblk));
                const v4i16_t hh = __builtin_amdgcn_ds_read_tr16_b64_v4i16((LAS v4i16_t*)(vrd + (32 * sub + 16 * s + 8) * VR + 64 * dblk));
                const bf16x8 va = __builtin_shufflevector(lo, hh, 0, 1, 2, 3, 4, 5, 6, 7);
                if (dblk == 0) st.o0 = ATT_MFMA(va, pb, st.o0); else st.o1 = ATT_MFMA(va, pb, st.o1);
            }
        }
}
template <int D>
__device__ __forceinline__ void run(St& st, const bf16x8 (&qf)[4], const unsigned char* Kb, const unsigned char* Vb, int tkb, int ntiles,
                                    int tq, int maxd, float ns, LAS unsigned char* vl, int lane) {
    const int r32 = lane & 31, hi = lane >> 5;
    LAS unsigned char* vrd = vl + (4 * hi + ((lane & 15) >> 2)) * VROW + (((lane >> 4) & 1) * 16 + (lane & 3) * 4) * 2;
    LAS unsigned char* vwr = vl + (lane >> 3) * VROW + 16 * (lane & 7);
    f32x16 b0, b1; bias_vecs<D>(b0, b1, ns);
    bf16x8 kf[2][4]; v4u vr[8];
#define ATT_LOADK(t) do { _Pragma("unroll") for (int sub = 0; sub < 2; ++sub) { const unsigned o_ = (unsigned)clampt(tkb + D * (64 * (t) + 32 * sub + r32)) * (unsigned)(NPROJ * 2) + 16u * hi; \
        _Pragma("unroll") for (int d0 = 0; d0 < 4; ++d0) kf[sub][d0] = *(const bf16x8*)(Kb + o_ + 32 * d0); } } while (0)
#define ATT_LOADV(t) do { _Pragma("unroll") for (int i2 = 0; i2 < 8; ++i2) { const unsigned o_ = (unsigned)clampt(tkb + D * (64 * (t) + (lane >> 3) + 8 * i2)) * (unsigned)(NPROJ * 2) + 16u * (lane & 7); \
        vr[i2] = *(const v4u*)(Vb + o_); } } while (0)
    ATT_LOADK(ntiles - 1); ATT_LOADV(ntiles - 1);
    for (int t = ntiles - 1; t >= 0; --t) {
#pragma unroll
        for (int i2 = 0; i2 < 8; ++i2) *(LAS v4u*)(vwr + 8 * i2 * VROW) = vr[i2];
        const int tn = (t > 0) ? t - 1 : 0;
        ATT_LOADV(tn);
        f32x16 s0 = b0, s1 = b1;
#pragma unroll
        for (int d0 = 0; d0 < 4; ++d0) { s0 = ATT_MFMA(kf[0][d0], qf[d0], s0); s1 = ATT_MFMA(kf[1][d0], qf[d0], s1); }
        ATT_LOADK(tn);
        const int tk0 = tkb + D * (64 * t + 4 * hi);
        tile_core<1, D, VROW>(st, s0, s1, ns * (float)tk0, true, tq - tk0, maxd, vrd);
    }
#undef ATT_LOADK
#undef ATT_LOADV
}
__device__ __forceinline__ void st_init(St& st) {
#pragma unroll
    for (int r = 0; r < 16; ++r) { st.o0[r] = 0.f; st.o1[r] = 0.f; }
    st.m = -1e30f; st.l = 0.f;
}
__device__ __forceinline__ void load_q(bf16x8 (&qf)[4], const bf16* qrow, int hi) {
#pragma unroll
    for (int d0 = 0; d0 < 4; ++d0) qf[d0] = *(const bf16x8*)(qrow + 16 * d0 + 8 * hi);
}
__device__ __forceinline__ void st_store(St& st, bf16* yrow, int hi) {
    const float lt = half_sum(st.l), inv = 1.0f / lt;
#pragma unroll
    for (int g = 0; g < 4; ++g) {
        unsigned long long w0 = (unsigned long long)cvtpk(st.o0[4 * g] * inv, st.o0[4 * g + 1] * inv) | ((unsigned long long)cvtpk(st.o0[4 * g + 2] * inv, st.o0[4 * g + 3] * inv) << 32);
        unsigned long long w1 = (unsigned long long)cvtpk(st.o1[4 * g] * inv, st.o1[4 * g + 1] * inv) | ((unsigned long long)cvtpk(st.o1[4 * g + 2] * inv, st.o1[4 * g + 3] * inv) << 32);
        *(unsigned long long*)(yrow + 8 * g + 4 * hi) = w0; *(unsigned long long*)(yrow + 32 + 8 * g + 4 * hi) = w1; }
}
__device__ __forceinline__ unsigned moba_select(const bf16x8 (&qf)[4], const float* kms, int b, int h, int blk, int r32, int hi, unsigned& picks) {
    f32x16 gt;
#pragma unroll
    for (int r = 0; r < 16; ++r) gt[r] = 0.f;
    { const float* kp = kms + ((size_t)((b * 16 + (r32 & 15)) * 4 + h)) * 64 + 8 * hi;
#pragma unroll
      for (int d0 = 0; d0 < 4; ++d0) { const f32x4 a = *(const f32x4*)(kp + 16 * d0) * (1.0f / 256.0f), c = *(const f32x4*)(kp + 16 * d0 + 4) * (1.0f / 256.0f);
          v4u hw, lw; hw.x = cvtpk(a.x, a.y); hw.y = cvtpk(a.z, a.w); hw.z = cvtpk(c.x, c.y); hw.w = cvtpk(c.z, c.w);
          lw.x = cvtpk(a.x - blo(hw.x), a.y - bhi(hw.x)); lw.y = cvtpk(a.z - blo(hw.y), a.w - bhi(hw.y)); lw.z = cvtpk(c.x - blo(hw.z), c.y - bhi(hw.z)); lw.w = cvtpk(c.z - blo(hw.w), c.w - bhi(hw.w));
          gt = ATT_MFMA(__builtin_bit_cast(bf16x8, hw), qf[d0], gt); gt = ATT_MFMA(__builtin_bit_cast(bf16x8, lw), qf[d0], gt); } }
    float og[8];
#pragma unroll
    for (int r = 0; r < 8; ++r) og[r] = __shfl_xor(gt[r], 32);
    float G[16];
#pragma unroll
    for (int n = 0; n < 16; ++n) { const int rn = (n & 3) + 4 * (n >> 3); G[n] = (((n >> 2) & 1) == hi) ? gt[rn] : og[rn]; }
    unsigned selmask = 0u; picks = 0xfffu;
#pragma unroll
    for (int s = 0; s < 3; ++s) { float bv = -INFINITY; int best = -1;
#pragma unroll
        for (int n = 0; n < 16; ++n) { if (n < blk && !((selmask >> n) & 1u) && G[n] > bv) { bv = G[n]; best = n; } }
        if (best >= 0) { selmask |= 1u << best; picks = (picks & ~(15u << (4 * s))) | ((unsigned)best << (4 * s)); } }
    return selmask;
}
}

constexpr size_t WS_PAO = 248 * MiB, WS_PAM = 54 * MiB, WS_PAL = 54 * MiB + 256 * 1024;
namespace attc {
constexpr int KROW = 144, VROWC = 192;
constexpr int KT_BYTES = 128 * KROW, VT_BYTES_C = 128 * VROWC, STAGE = KT_BYTES + VT_BYTES_C;
}
__device__ __forceinline__ void mixA1_coop(Frame& F) {
    using namespace att;
    unsigned char* ws = ARGWS();
    const bf16* proj = (const bf16*)(ws + WS_PROJ); bf16* pao = (bf16*)(ws + WS_PAO); float* pam = (float*)(ws + WS_PAM); float* pal = (float*)(ws + WS_PAL);
    const int lane = F.lane, r32 = lane & 31, hi = lane >> 5, w = F.wave, tid = F.tid;
    LAS unsigned char* L0 = F.lds + RING_OFF;
    const int bh = F.vcu >> 4, qb = F.vcu & 15, b = bh >> 2, h = bh & 3, rowb = b * SEQ, t0 = 256 * qb, tq = t0 + 32 * w + r32;
    const float ns = 8.0f * exp2f(-(float)(2 * h + 1));
    const bf16* Kg = proj + (size_t)rowb * NPROJ + OFF_KA + h * 64; const bf16* Vg = proj + (size_t)rowb * NPROJ + OFF_VA + h * 64;
    const int lrow0 = tid >> 3, lch = tid & 7;
    const int koff = lrow0 * attc::KROW + 16 * lch, voff = attc::KT_BYTES + lrow0 * attc::VROWC + 16 * lch;
    const int kfo = r32 * attc::KROW + 16 * hi;
    const int vfo = attc::KT_BYTES + (4 * hi + ((lane & 15) >> 2)) * attc::VROWC + (((lane >> 4) & 1) * 16 + (lane & 3) * 4) * 2;
    f32x16 b0, b1; bias_vecs<1>(b0, b1, ns);
    bf16x8 qf[4]; load_q(qf, proj + (size_t)(rowb + tq) * NPROJ + OFF_QA + h * 64, hi);
    St st; st_init(st);
    const int s_lo = (qb == 0) ? 1 : 0;
    v4u kr[2], vr[2];
#define MA_LOAD(s) do { _Pragma("unroll") for (int j = 0; j < 2; ++j) { const size_t o_ = (size_t)(t0 - 128 + 128 * (s) + 64 * j + lrow0) * NPROJ + 8 * lch; kr[j] = *(const v4u*)(Kg + o_); vr[j] = *(const v4u*)(Vg + o_); } } while (0)
#define MA_STORE(buf) do { LAS unsigned char* sb_ = L0 + (buf) * attc::STAGE; _Pragma("unroll") for (int j = 0; j < 2; ++j) { *(LAS v4u*)(sb_ + koff + 64 * j * attc::KROW) = kr[j]; *(LAS v4u*)(sb_ + voff + 64 * j * attc::VROWC) = vr[j]; } } while (0)
    __syncthreads();
    MA_LOAD(2); MA_STORE(0); MA_LOAD(1);
#pragma unroll 1
    for (int i = 0; i < 3 - s_lo; ++i) {
        const int s = 2 - i;
        __syncthreads();
        if (s - 1 >= s_lo) { MA_STORE((i + 1) & 1); if (s - 2 >= s_lo) MA_LOAD(s - 2); }
        LAS unsigned char* sb = L0 + (i & 1) * attc::STAGE;
#pragma unroll
        for (int u = 1; u >= 0; --u) {
            const int ta = t0 - 128 + 128 * s + 64 * u;
            if (ta <= t0 + 32 * w + 31 && ta + 63 >= t0 + 32 * w - 128) {
                bf16x8 kf[2][4];
#pragma unroll
                for (int sub = 0; sub < 2; ++sub)
#pragma unroll
                    for (int d0 = 0; d0 < 4; ++d0) kf[sub][d0] = *(const LAS bf16x8*)(sb + kfo + (64 * u + 32 * sub) * attc::KROW + 32 * d0);
                f32x16 s0 = b0, s1 = b1;
#pragma unroll
                for (int d0 = 0; d0 < 4; ++d0) { s0 = ATT_MFMA(kf[0][d0], qf[d0], s0); s1 = ATT_MFMA(kf[1][d0], qf[d0], s1); }
                const int tk0 = ta + 4 * hi;
                tile_core<1, 1, attc::VROWC>(st, s0, s1, ns * (float)tk0, true, tq - tk0, tq < 128 ? tq : 128, sb + vfo + 64 * u * attc::VROWC);
            }
        }
    }
#undef MA_LOAD
#undef MA_STORE
    const float lt = half_sum(st.l), inv = 1.0f / lt;
    bf16* orow = pao + ((size_t)(rowb + tq) * 4 + h) * 64;
#pragma unroll
    for (int g = 0; g < 4; ++g) {
        unsigned long long w0 = (unsigned long long)cvtpk(st.o0[4 * g] * inv, st.o0[4 * g + 1] * inv) | ((unsigned long long)cvtpk(st.o0[4 * g + 2] * inv, st.o0[4 * g + 3] * inv) << 32);
        unsigned long long w1 = (unsigned long long)cvtpk(st.o1[4 * g] * inv, st.o1[4 * g + 1] * inv) | ((unsigned long long)cvtpk(st.o1[4 * g + 2] * inv, st.o1[4 * g + 3] * inv) << 32);
        *(unsigned long long*)(orow + 8 * g + 4 * hi) = w0; *(unsigned long long*)(orow + 32 + 8 * g + 4 * hi) = w1; }
    if (hi == 0) { pam[(size_t)(rowb + tq) * 4 + h] = st.m; pal[(size_t)(rowb + tq) * 4 + h] = lt; }
    __syncthreads();
}
__device__ __forceinline__ void mixA23_mfma(Frame& F) {
    unsigned char* ws = ARGWS();
    const bf16* proj = (const bf16*)(ws + WS_PROJ); bf16* y = (bf16*)(ws + WS_Y);
    const bf16* pao = (const bf16*)(ws + WS_PAO); const float* pam = (const float*)(ws + WS_PAM); const float* pal = (const float*)(ws + WS_PAL);
    const int lane = F.lane, r32 = lane & 31, hi = lane >> 5, w = F.wave;
    LAS unsigned char* vl = F.lds + RING_OFF + w * att::VT_BYTES;
    const int gw = F.vcu * NWAVES + w;
    const int bh = gw >> 7, r16 = (gw >> 3) & 15, ig = gw & 7;
    const int b = bh >> 2, h = bh & 3, rowb = b * SEQ, tq0 = r16 + 512 * ig, tq = tq0 + 16 * r32;
    bf16x8 qf[4]; att::load_q(qf, proj + (size_t)(rowb + tq) * NPROJ + OFF_QA + h * 64, hi);
    att::St st; att::st_init(st);
    const float ns = 8.0f * exp2f(-(float)(2 * h + 1));
    const unsigned char* Kb = (const unsigned char*)(proj + (size_t)rowb * NPROJ + OFF_KA + h * 64); const unsigned char* Vb = (const unsigned char*)(proj + (size_t)rowb * NPROJ + OFF_VA + h * 64);
    att::run<4>(st, qf, Kb, Vb, tq0 - 512, 4, tq, tq < 512 ? tq : 512, ns, vl, lane);
    att::run<16>(st, qf, Kb, Vb, tq0 - 2048, 3, tq, tq < 2048 ? tq : 2048, ns, vl, lane);
    const size_t pidx = (size_t)(rowb + tq) * 4 + h;
    const float m1 = pam[pidx], l1 = pal[pidx], l2 = att::half_sum(st.l), mm = fmaxf(st.m, m1);
    const float a2 = __builtin_amdgcn_exp2f(att::C2 * (st.m - mm)), a1 = __builtin_amdgcn_exp2f(att::C2 * (m1 - mm)) * l1;
    const float inv = 1.0f / (l2 * a2 + a1);
    const bf16* orow = pao + pidx * 64; bf16* yrow = y + (size_t)(rowb + tq) * DM + h * 64;
#pragma unroll
    for (int g = 0; g < 4; ++g) {
        const unsigned long long p0 = *(const unsigned long long*)(orow + 8 * g + 4 * hi), p1 = *(const unsigned long long*)(orow + 32 + 8 * g + 4 * hi);
        const float q0[4] = {blo((unsigned)p0), bhi((unsigned)p0), blo((unsigned)(p0 >> 32)), bhi((unsigned)(p0 >> 32))};
        const float q1[4] = {blo((unsigned)p1), bhi((unsigned)p1), blo((unsigned)(p1 >> 32)), bhi((unsigned)(p1 >> 32))};
        float r0[4], r1[4];
#pragma unroll
        for (int e = 0; e < 4; ++e) { r0[e] = (st.o0[4 * g + e] * a2 + q0[e] * a1) * inv; r1[e] = (st.o1[4 * g + e] * a2 + q1[e] * a1) * inv; }
        *(unsigned long long*)(yrow + 8 * g + 4 * hi) = (unsigned long long)att::cvtpk(r0[0], r0[1]) | ((unsigned long long)att::cvtpk(r0[2], r0[3]) << 32);
        *(unsigned long long*)(yrow + 32 + 8 * g + 4 * hi) = (unsigned long long)att::cvtpk(r1[0], r1[1]) | ((unsigned long long)att::cvtpk(r1[2], r1[3]) << 32); }
}
constexpr size_t WS_MCNT = 768 * 1024;
constexpr size_t WS_MLIST = 51 * MiB + 512 * 1024;
constexpr size_t WS_MPM = 52 * MiB + 512 * 1024, WS_MPL = 53 * MiB + 256 * 1024;
__device__ __forceinline__ int moba_list_base(int b, int h, int j) { return (b * 4 + h) * 30720 + 256 * (15 * j - ((j * (j - 1)) >> 1)); }
__device__ __forceinline__ void moba_build(Frame& F, int l) {
    using namespace att;
    unsigned char* ws = ARGWS();
    const bf16* proj = (const bf16*)(ws + WS_PROJ); const float* kms = (const float*)(ws + WS_KMS) + (size_t)l * (BATCH * 16 * 4 * 64);
    unsigned* cnt = (unsigned*)(ws + WS_MCNT) + l * 256; unsigned short* list = (unsigned short*)(ws + WS_MLIST);
    const int lane = F.lane, r32 = lane & 31, hi = lane >> 5, w = F.wave;
    const int bh = F.vcu >> 4, blk = F.vcu & 15, b = bh >> 2, h = bh & 3, rowb = b * SEQ, tq = 256 * blk + 32 * w + r32;
    if (blk == 0) return;
    bf16x8 qf[4]; load_q(qf, proj + (size_t)(rowb + tq) * NPROJ + OFF_QC + h * 64, hi);
    unsigned picks; (void)moba_select(qf, kms, b, h, blk, r32, hi, picks);
    const int p0 = picks & 15, p1 = (picks >> 4) & 15, p2 = (picks >> 8) & 15;
    unsigned cntv = 0u;
#pragma unroll 1
    for (int j = 0; j < blk; ++j) { const bool pr = (hi == 0) && (p0 == j || p1 == j || p2 == j); const unsigned long long bal = __ballot(pr); if (lane == j) cntv = (unsigned)__popcll(bal); }
    unsigned basev = 0u;
    if (lane < 15 && cntv > 0u) basev = atomicAdd(cnt + (b * 4 + h) * 16 + lane, cntv);
#pragma unroll 1
    for (int j = 0; j < blk; ++j) { {
        const bool pr = (hi == 0) && (p0 == j || p1 == j || p2 == j); const unsigned long long bal = __ballot(pr);
        if (bal) { const unsigned bj = (unsigned)__shfl((int)basev, j);
            if (pr) { const unsigned pos = bj + (unsigned)__popcll(bal & ((1ull << lane) - 1ull)); const unsigned slot = (p0 == j) ? 0u : (p1 == j) ? 1u : 2u;
                list[moba_list_base(b, h, j) + pos] = (unsigned short)((unsigned)tq | (slot << 12)); } } } }
}
__device__ __forceinline__ void moba_lists(Frame& F, int l) {
    using namespace att;
    unsigned char* ws = ARGWS();
    const bf16* proj = (const bf16*)(ws + WS_PROJ);
    const unsigned* cnt = (const unsigned*)(ws + WS_MCNT) + l * 256; const unsigned short* list = (const unsigned short*)(ws + WS_MLIST);
    unsigned char* PB = (l == 0) ? (unsigned char*)ARGOUT() : ws + WS_W;
    float* pm = (float*)(ws + WS_MPM); float* pl = (float*)(ws + WS_MPL);
    asm volatile("" : "+v"(pm), "+v"(pl), "+v"(PB));
    const int lane = F.lane, r32 = lane & 31, hi = lane >> 5, w = F.wave, tid = F.tid;
    LAS unsigned char* L0 = F.lds + RING_OFF;
    constexpr int KB_BYTES = 256 * attc::KROW, VB_BYTES = 256 * attc::VROWC;
    LAS unsigned* cin = (LAS unsigned*)(L0 + KB_BYTES + VB_BYTES); LAS unsigned* pre = cin + 256;
    __syncthreads();
    unsigned cmine = 0u, cinc = 0u;
    constexpr unsigned SEGW = 256u;
    if (tid < 256) { cmine = cnt[tid]; cmine = cmine ? cmine + SEGW : 0u; cinc = cmine;
#pragma unroll
        for (int o = 1; o < 64; o <<= 1) { const unsigned t_ = (unsigned)__shfl_up((int)cinc, o); if (lane >= o) cinc += t_; }
        if (lane == 63) cin[w] = cinc; }
    __syncthreads();
    if (tid < 256) { unsigned off = 0u;
#pragma unroll
        for (int i = 0; i < 3; ++i) if (i < w) off += cin[i];
        pre[tid] = off + cinc - cmine; if (tid == 255) pre[256] = off + cinc; }
    __syncthreads();
    const unsigned T = pre[256];
    const unsigned lo = (unsigned)(((unsigned long long)T * (unsigned)F.vcu) >> 8), hi_ = (unsigned)(((unsigned long long)T * (unsigned)(F.vcu + 1)) >> 8);
    LAS unsigned* lrng = pre + 260;
    if (tid == 0) { lrng[0] = 256u; lrng[1] = 0u; }
    __syncthreads();
    if (tid < 256) { const unsigned sL = pre[tid] + SEGW, eL = pre[tid + 1]; if (eL > sL && sL < hi_ && eL > lo) { atomicMin((unsigned*)lrng, (unsigned)tid); atomicMax((unsigned*)lrng + 1, (unsigned)tid); } }
    __syncthreads();
    const int Lfirst = (int)lrng[0], Llast = (int)lrng[1];
    const int kfo = r32 * attc::KROW + 16 * hi;
    const int vfo = KB_BYTES + (4 * hi + ((lane & 15) >> 2)) * attc::VROWC + (((lane >> 4) & 1) * 16 + (lane & 3) * 4) * 2;
#pragma unroll 1
    for (int L = Lfirst; L <= Llast; ++L) {
        const unsigned sL = pre[L] + SEGW, eL = pre[L + 1]; const unsigned a = lo > sL ? lo : sL, e = hi_ < eL ? hi_ : eL;
        if (a >= e) continue;
        const int bh = L >> 4, j = L & 15, b = bh >> 2, h = bh & 3, rowb = b * SEQ;
        const float ns = 8.0f * exp2f(-(float)(2 * h + 2));
        const int lb = moba_list_base(b, h, j) - (int)sL;
        const int nt = (int)((e - a + 31u) >> 5);
        unsigned ent_n = 0u;
        if (w < nt) { const unsigned idx0 = a + 32u * (unsigned)w + (unsigned)r32; ent_n = list[lb + (int)(idx0 < e ? idx0 : a)]; }
        __syncthreads();
        { const bf16* Kg = proj + (size_t)(rowb + 256 * j) * NPROJ + OFF_KC + h * 64; const bf16* Vg = proj + (size_t)(rowb + 256 * j) * NPROJ + OFF_VC + h * 64;
          v4u kr[4], vr[4];
#pragma unroll
          for (int i = 0; i < 4; ++i) { const int c = tid + 512 * i, row = c >> 3, ch = c & 7; kr[i] = *(const v4u*)(Kg + (size_t)row * NPROJ + 8 * ch); vr[i] = *(const v4u*)(Vg + (size_t)row * NPROJ + 8 * ch); }
#pragma unroll
          for (int i = 0; i < 4; ++i) { const int c = tid + 512 * i, row = c >> 3, ch = c & 7; *(LAS v4u*)(L0 + row * attc::KROW + 16 * ch) = kr[i]; *(LAS v4u*)(L0 + KB_BYTES + row * attc::VROWC + 16 * ch) = vr[i]; } }
        __syncthreads();
#pragma unroll 1
        for (int t = w; t < nt; t += NWAVES) {
            const unsigned idx = a + 32u * (unsigned)t + (unsigned)r32; const bool valid = idx < e;
            const unsigned ent = ent_n; const int tq = (int)(ent & 4095u); const unsigned slot = ent >> 12;
            bf16x8 qf[4]; load_q(qf, proj + (size_t)(rowb + tq) * NPROJ + OFF_QC + h * 64, hi);
            if (t + NWAVES < nt) { const unsigned idx1 = idx + 32u * NWAVES; ent_n = list[lb + (int)(idx1 < e ? idx1 : a)]; }
            St st; st_init(st);
#pragma unroll 1
            for (int kt = 3; kt >= 0; --kt) {
                bf16x8 kf[2][4];
#pragma unroll
                for (int sub = 0; sub < 2; ++sub)
#pragma unroll
                    for (int d0 = 0; d0 < 4; ++d0) kf[sub][d0] = *(const LAS bf16x8*)(L0 + kfo + (64 * kt + 32 * sub) * attc::KROW + 32 * d0);
                f32x16 s0, s1; bias_vecs<1>(s0, s1, ns);
#pragma unroll
                for (int d0 = 0; d0 < 4; ++d0) { s0 = ATT_MFMA(kf[0][d0], qf[d0], s0); s1 = ATT_MFMA(kf[1][d0], qf[d0], s1); }
                tile_core<0, 1, attc::VROWC>(st, s0, s1, ns * (float)(256 * j + 64 * kt + 4 * hi), valid, 0, 0, L0 + vfo + 64 * kt * attc::VROWC);
            }
            const float lt = half_sum(st.l), inv = 1.0f / lt;
            if (valid) {
                const size_t pidx = (size_t)(rowb + tq) * 4 + h;
                bf16* orow = (bf16*)(PB + (size_t)slot * (8 * MiB)) + pidx * 64;
#pragma unroll
                for (int g = 0; g < 4; ++g) {
                    unsigned long long w0 = (unsigned long long)cvtpk(st.o0[4 * g] * inv, st.o0[4 * g + 1] * inv) | ((unsigned long long)cvtpk(st.o0[4 * g + 2] * inv, st.o0[4 * g + 3] * inv) << 32);
                    unsigned long long w1 = (unsigned long long)cvtpk(st.o1[4 * g] * inv, st.o1[4 * g + 1] * inv) | ((unsigned long long)cvtpk(st.o1[4 * g + 2] * inv, st.o1[4 * g + 3] * inv) << 32);
                    *(unsigned long long*)(orow + 8 * g + 4 * hi) = w0; *(unsigned long long*)(orow + 32 + 8 * g + 4 * hi) = w1; }
                if (hi == 0) { pm[(size_t)slot * (M * 4) + pidx] = st.m; pl[(size_t)slot * (M * 4) + pidx] = lt; }
            }
        }
    }
    __syncthreads();
}
__device__ __forceinline__ void moba_own256_merge(Frame& F, int l) {
    using namespace att;
    unsigned char* ws = ARGWS();
    const bf16* proj = (const bf16*)(ws + WS_PROJ); bf16* y = (bf16*)(ws + WS_Y);
    const unsigned char* PB = (l == 0) ? (const unsigned char*)ARGOUT() : ws + WS_W;
    const float* pm = (const float*)(ws + WS_MPM); const float* pl = (const float*)(ws + WS_MPL);
    const int lane = F.lane, r32 = lane & 31, hi = lane >> 5, w = F.wave, tid = F.tid;
    LAS unsigned char* L0 = F.lds + RING_OFF;
    constexpr int KB_BYTES = 256 * attc::KROW;
    const int bh = F.vcu >> 4, blk = F.vcu & 15, b = bh >> 2, h = bh & 3, rowb = b * SEQ, tq = 256 * blk + 32 * w + r32;
    const float ns = 8.0f * exp2f(-(float)(2 * h + 2));
    const int kfo = r32 * attc::KROW + 16 * hi;
    const int vfo = KB_BYTES + (4 * hi + ((lane & 15) >> 2)) * attc::VROWC + (((lane >> 4) & 1) * 16 + (lane & 3) * 4) * 2;
    bf16x8 qf[4]; load_q(qf, proj + (size_t)(rowb + tq) * NPROJ + OFF_QC + h * 64, hi);
    __syncthreads();
    { const bf16* Kg = proj + (size_t)(rowb + 256 * blk) * NPROJ + OFF_KC + h * 64; const bf16* Vg = proj + (size_t)(rowb + 256 * blk) * NPROJ + OFF_VC + h * 64;
      v4u kr[4], vr[4];
#pragma unroll
      for (int i = 0; i < 4; ++i) { const int c = tid + 512 * i, row = c >> 3, ch = c & 7; kr[i] = *(const v4u*)(Kg + (size_t)row * NPROJ + 8 * ch); vr[i] = *(const v4u*)(Vg + (size_t)row * NPROJ + 8 * ch); }
#pragma unroll
      for (int i = 0; i < 4; ++i) { const int c = tid + 512 * i, row = c >> 3, ch = c & 7; *(LAS v4u*)(L0 + row * attc::KROW + 16 * ch) = kr[i]; *(LAS v4u*)(L0 + KB_BYTES + row * attc::VROWC + 16 * ch) = vr[i]; } }
    const size_t pidx = (size_t)(rowb + tq) * 4 + h; const int nsel = blk < 3 ? blk : 3;
    float mp[3], lp[3];
#pragma unroll
    for (int s = 0; s < 3; ++s) { mp[s] = -1e30f; lp[s] = 0.f; if (s < nsel) { mp[s] = pm[(size_t)s * (M * 4) + pidx]; lp[s] = pl[(size_t)s * (M * 4) + pidx]; } }
    __syncthreads();
    St st; st_init(st);
    const int ktl = w >> 1;
#pragma unroll 1
    for (int kt = ktl; kt >= 0; --kt) {
        bf16x8 kf[2][4];
#pragma unroll
        for (int sub = 0; sub < 2; ++sub)
#pragma unroll
            for (int d0 = 0; d0 < 4; ++d0) kf[sub][d0] = *(const LAS bf16x8*)(L0 + kfo + (64 * kt + 32 * sub) * attc::KROW + 32 * d0);
        f32x16 s0, s1; bias_vecs<1>(s0, s1, ns);
#pragma unroll
        for (int d0 = 0; d0 < 4; ++d0) { s0 = ATT_MFMA(kf[0][d0], qf[d0], s0); s1 = ATT_MFMA(kf[1][d0], qf[d0], s1); }
        const int tk0 = 256 * blk + 64 * kt + 4 * hi;
        if (kt == ktl) tile_core<1, 1, attc::VROWC>(st, s0, s1, ns * (float)tk0, true, tq - tk0, BIGD, L0 + vfo + 64 * kt * attc::VROWC);
        else tile_core<0, 1, attc::VROWC>(st, s0, s1, ns * (float)tk0, true, 0, 0, L0 + vfo + 64 * kt * attc::VROWC);
    }
    float mm = st.m;
#pragma unroll
    for (int s = 0; s < 3; ++s) mm = fmaxf(mm, mp[s]);
    const float a1 = __builtin_amdgcn_exp2f(C2 * (st.m - mm));
    float ap[3];
#pragma unroll
    for (int s = 0; s < 3; ++s) ap[s] = __builtin_amdgcn_exp2f(C2 * (mp[s] - mm)) * lp[s];
    const float inv = 1.0f / (half_sum(st.l) * a1 + ap[0] + ap[1] + ap[2]);
    bf16* yrow = y + (size_t)(rowb + tq) * DM + 768 + h * 64;
#pragma unroll
    for (int g = 0; g < 4; ++g) {
        float r0[4], r1[4];
#pragma unroll
        for (int e = 0; e < 4; ++e) { r0[e] = st.o0[4 * g + e] * a1; r1[e] = st.o1[4 * g + e] * a1; }
#pragma unroll
        for (int s = 0; s < 3; ++s) { if (s < nsel) {
            const bf16* orow = (const bf16*)(PB + (size_t)s * (8 * MiB)) + pidx * 64;
            const unsigned long long p0 = *(const unsigned long long*)(orow + 8 * g + 4 * hi), p1 = *(const unsigned long long*)(orow + 32 + 8 * g + 4 * hi);
            r0[0] += blo((unsigned)p0) * ap[s]; r0[1] += bhi((unsigned)p0) * ap[s]; r0[2] += blo((unsigned)(p0 >> 32)) * ap[s]; r0[3] += bhi((unsigned)(p0 >> 32)) * ap[s];
            r1[0] += blo((unsigned)p1) * ap[s]; r1[1] += bhi((unsigned)p1) * ap[s]; r1[2] += blo((unsigned)(p1 >> 32)) * ap[s]; r1[3] += bhi((unsigned)(p1 >> 32)) * ap[s]; } }
        *(unsigned long long*)(yrow + 8 * g + 4 * hi) = (unsigned long long)cvtpk(r0[0] * inv, r0[1] * inv) | ((unsigned long long)cvtpk(r0[2] * inv, r0[3] * inv) << 32);
        *(unsigned long long*)(yrow + 32 + 8 * g + 4 * hi) = (unsigned long long)cvtpk(r1[0] * inv, r1[1] * inv) | ((unsigned long long)cvtpk(r1[2] * inv, r1[3] * inv) << 32); }
    __syncthreads();
}

namespace ssd {
typedef float f32x16 __attribute__((ext_vector_type(16)));
typedef short v4i16_t __attribute__((ext_vector_type(4)));
constexpr int RS_BTR = 320, RS_XTR = 576;
constexpr int RS_ROW = 272;
constexpr int RS_XH = 192;
#define SSD_MFMA(a, b, c) __builtin_amdgcn_mfma_f32_32x32x16_bf16((a), (b), (c), 0, 0, 0)
__device__ __forceinline__ bf16x8 trpair(LAS unsigned char* p, int rs4  ) {
    const v4i16_t lo = __builtin_amdgcn_ds_read_tr16_b64_v4i16((LAS v4i16_t*)p);
    const v4i16_t hh = __builtin_amdgcn_ds_read_tr16_b64_v4i16((LAS v4i16_t*)(p + rs4));
    return __builtin_shufflevector(lo, hh, 0, 1, 2, 3, 4, 5, 6, 7);
}
__device__ __forceinline__ float chunk_acs(float d0, float d1  , float A, LAS float* acs, LAS float* dts, int lane) {
    float s0 = d0 * A, s1 = d1 * A;
#pragma unroll
    for (int o = 1; o < 64; o <<= 1) { const float t0 = __shfl_up(s0, o), t1 = __shfl_up(s1, o); if (lane >= o) { s0 += t0; s1 += t1; } }
    const float tot0 = __shfl(s0, 63); s1 += tot0;
    acs[lane] = s0; acs[64 + lane] = s1; dts[lane] = d0; dts[64 + lane] = d1;
    return __shfl(s1, 63);
}
__device__ __forceinline__ void conv_load(v4u (&raw)[11], const bf16* proj, int rowg0, bool first_chunk, int rb, int c0) {
#pragma unroll
    for (int j = 0; j < 11; ++j) { const int rr = 8 * rb - 3 + j;
        if (first_chunk && rr < 0) raw[j] = (v4u){0u, 0u, 0u, 0u}; else raw[j] = *(const v4u*)(proj + (size_t)(rowg0 + rr) * NPROJ + OFF_XBC + c0); }
}
__device__ __forceinline__ void conv_compute(const v4u (&raw)[11], const float* cw, const float* cb, int rb, int c0, LAS unsigned char* dst, int rs, const LAS float* rowscale) {
    float w[4][8], bs[8];
#pragma unroll
    for (int j = 0; j < 4; ++j) { const f32x4 a = *(const f32x4*)(cw + j * 1024 + c0), b = *(const f32x4*)(cw + j * 1024 + c0 + 4);
        w[j][0] = a.x; w[j][1] = a.y; w[j][2] = a.z; w[j][3] = a.w; w[j][4] = b.x; w[j][5] = b.y; w[j][6] = b.z; w[j][7] = b.w; }
    { const f32x4 a = *(const f32x4*)(cb + c0), b = *(const f32x4*)(cb + c0 + 4); bs[0] = a.x; bs[1] = a.y; bs[2] = a.z; bs[3] = a.w; bs[4] = b.x; bs[5] = b.y; bs[6] = b.z; bs[7] = b.w; }
#pragma unroll
    for (int r = 0; r < 8; ++r) {
        float o[8];
#pragma unroll
        for (int e = 0; e < 8; ++e) o[e] = bs[e];
#pragma unroll
        for (int j = 0; j < 4; ++j) { const v4u u = raw[r + j];
            o[0] += w[j][0] * blo(u.x); o[1] += w[j][1] * bhi(u.x); o[2] += w[j][2] * blo(u.y); o[3] += w[j][3] * bhi(u.y);
            o[4] += w[j][4] * blo(u.z); o[5] += w[j][5] * bhi(u.z); o[6] += w[j][6] * blo(u.w); o[7] += w[j][7] * bhi(u.w); }
        const float sc = rowscale ? rowscale[8 * rb + r] : 1.0f;
#pragma unroll
        for (int e = 0; e < 8; ++e) o[e] = o[e] * __builtin_amdgcn_rcpf(1.0f + __builtin_amdgcn_exp2f(-1.4426950408889634f * o[e])) * sc;
        v4u q; q.x = pk2(o[0], o[1]); q.y = pk2(o[2], o[3]); q.z = pk2(o[4], o[5]); q.w = pk2(o[6], o[7]);
        *(LAS v4u*)(dst + (8 * rb + r) * rs) = q;
    }
}
}
constexpr size_t WS_CDEC = 50 * MiB + 512 * 1024;

__device__ __forceinline__ void ssd_states(Frame& F, int l) {
    unsigned char* ws = ARGWS();
    const bf16* proj = (const bf16*)(ws + WS_PROJ); const float* dt = (const float*)(ws + WS_DT); float* states = (float*)(ws + WS_ST); float* cdec = (float*)(ws + WS_CDEC);
    const float* cw = ARGF(7) + (size_t)l * 4 * 1024; const float* cb = ARGF(8) + (size_t)l * 1024; const float* alog = ARGF(10) + l * 8;
    const int lane = F.lane, w = F.wave, tid = F.tid, hi = lane >> 5;
    LAS float* acs = (LAS float*)(F.lds + RING_OFF);
    LAS float* wl = acs + 512;
    LAS unsigned char* Bt = F.lds + RING_OFF + 4096;
    LAS unsigned char* Xt = Bt + 128 * ssd::RS_BTR;
    for (int u = F.vcu; u < BATCH * 32 * 2; u += F.G) {
        const int b = u >> 6, c = (u >> 1) & 31, g = u & 1, rowg0 = b * SEQ + c * 128;
        v4u rawx[11], rawb[11];
        ssd::conv_load(rawx, proj, rowg0, c == 0, tid >> 5, g * 256 + 8 * (tid & 31));
        if (tid < 256) ssd::conv_load(rawb, proj, rowg0, c == 0, tid >> 4, 512 + g * 128 + 8 * (tid & 15));
        float dta = 0.f, dtb = 0.f, Ah = 0.f;
        if (w < 4) { dta = dt[(size_t)(rowg0 + lane) * 8 + 4 * g + w]; dtb = dt[(size_t)(rowg0 + 64 + lane) * 8 + 4 * g + w]; Ah = alog[4 * g + w]; }
        __syncthreads();
        if (w < 4) { const int hh = 4 * g + w; const float A = -__expf(Ah);
            const float last = ssd::chunk_acs(dta, dtb, A, acs + 128 * w, wl + 128 * w, lane);
            const float a0 = acs[128 * w + lane], a1 = acs[128 * w + 64 + lane];
            wl[128 * w + lane] = wl[128 * w + lane] * __expf(last - a0); wl[128 * w + 64 + lane] = wl[128 * w + 64 + lane] * __expf(last - a1);
            if (lane == 0) cdec[(size_t)(b * 32 + c) * 8 + hh] = __expf(last); }
        __syncthreads();
        { const int rb = tid >> 5, ch = tid & 31, c0 = g * 256 + 8 * ch;
          ssd::conv_compute(rawx, cw, cb, rb, c0, Xt + 16 * ch, ssd::RS_XTR, wl + 128 * (ch >> 3)); }
        if (tid < 256) { const int rb = tid >> 4, ch = tid & 15, c0 = 512 + g * 128 + 8 * ch;
          ssd::conv_compute(rawb, cw, cb, rb, c0, Bt + 16 * ch, ssd::RS_BTR, nullptr); }
        __syncthreads();
        { const int hl = w >> 1, ph = w & 1, hh = 4 * g + hl;
          LAS unsigned char* xa = Xt + (8 * hi + ((lane & 15) >> 2)) * ssd::RS_XTR + (hl * 64 + 32 * ph + 16 * ((lane >> 4) & 1) + 4 * (lane & 3)) * 2;
          LAS unsigned char* ba = Bt + (8 * hi + ((lane & 15) >> 2)) * ssd::RS_BTR + (16 * ((lane >> 4) & 1) + 4 * (lane & 3)) * 2;
          float* sp = states + ((size_t)((b * 32 + c) * 8 + hh)) * 8192 + (size_t)(32 * ph) * 128 + (lane & 31);
#pragma unroll
          for (int nt = 0; nt < 4; ++nt) {
              ssd::f32x16 acc;
#pragma unroll
              for (int r = 0; r < 16; ++r) acc[r] = 0.f;
#pragma unroll
              for (int kk = 0; kk < 8; ++kk) {
                  const bf16x8 af = ssd::trpair(xa + 16 * kk * ssd::RS_XTR, 4 * ssd::RS_XTR);
                  const bf16x8 bfr = ssd::trpair(ba + 16 * kk * ssd::RS_BTR + 64 * nt, 4 * ssd::RS_BTR);
                  acc = SSD_MFMA(af, bfr, acc); }
#pragma unroll
              for (int r = 0; r < 16; ++r) sp[(size_t)((r & 3) + 8 * (r >> 2) + 4 * hi) * 128 + 32 * nt] = acc[r];
          } }
    }
    __syncthreads();
}
__device__ __forceinline__ void ssd_scan(Frame& F) {
    unsigned char* ws = ARGWS();
    const float* states = (const float*)(ws + WS_ST); const float* cdec = (const float*)(ws + WS_CDEC); unsigned* stb = (unsigned*)((unsigned char*)ARGOUT() + 32 * MiB);
    const int gt = F.vcu * (NWAVES * 64) + F.tid;
    if (gt < BATCH * 8 * 4096) {
        const int b = gt >> 15, h = (gt >> 12) & 7, e = gt & 4095;
        typedef float f32x2 __attribute__((ext_vector_type(2)));
        f32x2 v[32]; float dc[32];
#pragma unroll
        for (int c = 0; c < 32; ++c) { v[c] = *(const f32x2*)(states + ((size_t)((b * 32 + c) * 8 + h)) * 8192 + 2 * e); dc[c] = cdec[(size_t)(b * 32 + c) * 8 + h]; }
        f32x2 run = {0.f, 0.f};
#pragma unroll
        for (int c = 0; c < 32; ++c) { const f32x2 t = v[c]; stb[((size_t)((b * 32 + c) * 8 + h)) * 4096 + e] = pk2(run.x, run.y); run = run * dc[c] + t; }
    }
}
__device__ __forceinline__ void ssd_out(Frame& F, int l) {
    unsigned char* ws = ARGWS();
    const bf16* proj = (const bf16*)(ws + WS_PROJ); const float* dt = (const float*)(ws + WS_DT); const bf16* stb = (const bf16*)((unsigned char*)ARGOUT() + 32 * MiB); bf16* y = (bf16*)(ws + WS_Y);
    const float* cw = ARGF(7) + (size_t)l * 4 * 1024; const float* cb = ARGF(8) + (size_t)l * 1024; const float* alog = ARGF(10) + l * 8;
    const float* dsk = ARGF(11) + l * 8; const float* nw = ARGF(12) + (size_t)l * 512;
    const int lane = F.lane, w = F.wave, tid = F.tid, hi = lane >> 5, r32 = lane & 31;
    LAS float* acs = (LAS float*)(F.lds + RING_OFF);
    LAS float* dts = acs + 512;
    LAS float* rss = dts + 512;
    LAS unsigned* CBT = (LAS unsigned*)(F.lds + RING_OFF + 8192);
    LAS unsigned char* Ct = F.lds + RING_OFF + 8192 + 20480;
    LAS unsigned char* Bt = Ct + 128 * ssd::RS_ROW;
    LAS unsigned char* Xh = Bt;
    static_assert(8192 + 20480 + 128 * ssd::RS_ROW + 128 * ssd::RS_XTR <= RING_BYTES, "stage Z LDS map");
    const int wq = w & 3, pt = w >> 2;
    for (int u = F.vcu; u < BATCH * 32 * 2; u += F.G) {
        const int b = u >> 6, c = (u >> 1) & 31, g = u & 1, rowg0 = b * SEQ + c * 128;
        v4u rawbc[11], rawx[11];
        ssd::conv_load(rawbc, proj, rowg0, c == 0, (tid & 255) >> 4, 512 + (tid >> 8) * 256 + g * 128 + 8 * (tid & 15));
        ssd::conv_load(rawx, proj, rowg0, c == 0, tid >> 5, g * 256 + 8 * (tid & 31));
        float dta = 0.f, dtb = 0.f, Ah = 0.f;
        if (w < 4) { dta = dt[(size_t)(rowg0 + lane) * 8 + 4 * g + w]; dtb = dt[(size_t)(rowg0 + 64 + lane) * 8 + 4 * g + w]; Ah = alog[4 * g + w]; }
        __syncthreads();
        if (tid < 128) rss[tid] = 0.f;
        if (w < 4) { const float A = -__expf(Ah); (void)ssd::chunk_acs(dta, dtb, A, acs + 128 * w, dts + 128 * w, lane); }
        { const int rb = (tid & 255) >> 4, ch = tid & 15, which = tid >> 8, c0 = 512 + which * 256 + g * 128 + 8 * ch;
          ssd::conv_compute(rawbc, cw, cb, rb, c0, (which ? Ct : Bt) + 16 * ch, ssd::RS_ROW, nullptr); }
        __syncthreads();
#pragma unroll 1
        for (int id = w; id < 10; id += NWAVES) {
            const int tl = (id >= 6) ? 3 : (id >= 3) ? 2 : (id >= 1) ? 1 : 0, ts = id - ((tl * (tl + 1)) >> 1);
            ssd::f32x16 t16;
#pragma unroll
            for (int r = 0; r < 16; ++r) t16[r] = 0.f;
#pragma unroll
            for (int k0 = 0; k0 < 8; ++k0) { const bf16x8 bfr = *(const LAS bf16x8*)(Bt + (32 * ts + r32) * ssd::RS_ROW + (16 * k0 + 8 * hi) * 2);
                const bf16x8 cfr = *(const LAS bf16x8*)(Ct + (32 * tl + r32) * ssd::RS_ROW + (16 * k0 + 8 * hi) * 2);
                t16 = SSD_MFMA(bfr, cfr, t16); }
#pragma unroll
            for (int q = 0; q < 8; ++q) CBT[(id * 8 + q) * 64 + lane] = att::cvtpk(t16[2 * q], t16[2 * q + 1]);
        }
        __syncthreads();
        { const int rb = tid >> 5, ch = tid & 31; ssd::conv_compute(rawx, cw, cb, rb, g * 256 + 8 * ch, Xh + 16 * ch, ssd::RS_XTR, nullptr); }
        __syncthreads();
        unsigned dmask = 0u;
#pragma unroll
        for (int r = 0; r < 16; ++r) dmask |= ((((r & 3) + 8 * (r >> 2) + 4 * hi) <= r32) ? 1u : 0u) << r;
        asm volatile("" : "+v"(dmask));
        bf16x8 sfr[8];
#pragma unroll
        for (int k0 = 0; k0 < 8; ++k0) sfr[k0] = *(const bf16x8*)(stb + ((size_t)((b * 32 + c) * 8 + 4 * g)) * 8192 + (size_t)(32 * pt + r32) * 128 + 8 * hi + 16 * k0);
        ssd::f32x16 yg0, yg1, yg2, yg3;
#pragma unroll
        for (int hl = 0; hl < 4; ++hl) {
            const int hh = 4 * g + hl, lt = (wq + hl) & 3, lrow = 32 * lt + r32;
            bf16x8 cf[8];
#pragma unroll
            for (int k0 = 0; k0 < 8; ++k0) cf[k0] = *(const LAS bf16x8*)(Ct + lrow * ssd::RS_ROW + (16 * k0 + 8 * hi) * 2);
            ssd::f32x16 acc;
#pragma unroll
            for (int r = 0; r < 16; ++r) acc[r] = 0.f;
#pragma unroll
            for (int k0 = 0; k0 < 8; ++k0) acc = SSD_MFMA(sfr[k0], cf[k0], acc);
            if (hl < 3) {
#pragma unroll
                for (int k0 = 0; k0 < 8; ++k0) sfr[k0] = *(const bf16x8*)(stb + ((size_t)((b * 32 + c) * 8 + hh + 1)) * 8192 + (size_t)(32 * pt + r32) * 128 + 8 * hi + 16 * k0); }
            const float al = acs[128 * hl + lrow]; const float el = __expf(al);
#pragma unroll
            for (int r = 0; r < 16; ++r) acc[r] *= el;
            LAS unsigned char* xa = Xh + (4 * hi + ((lane & 15) >> 2)) * ssd::RS_XTR + (hl * 64 + 32 * pt + 16 * ((lane >> 4) & 1) + 4 * (lane & 3)) * 2;
            const int tid0 = (lt * (lt + 1)) >> 1;
#pragma unroll
            for (int st = 0; st < 4; ++st) { if (st <= lt) {
                float sc[16];
#pragma unroll
                for (int g4 = 0; g4 < 4; ++g4) { const int s0 = 32 * st + 8 * g4 + 4 * hi;
                    const f32x4 as = *(const LAS f32x4*)(acs + 128 * hl + s0), ds = *(const LAS f32x4*)(dts + 128 * hl + s0);
                    const unsigned c01 = CBT[((tid0 + st) * 8 + 2 * g4) * 64 + lane], c23 = CBT[((tid0 + st) * 8 + 2 * g4 + 1) * 64 + lane];
                    const float cv[4] = {blo(c01), bhi(c01), blo(c23), bhi(c23)};
#pragma unroll
                    for (int e = 0; e < 4; ++e) sc[4 * g4 + e] = cv[e] * __expf(fminf(al - as[e], 0.f)) * ds[e]; }
                if (st == lt) {
#pragma unroll
                    for (int r = 0; r < 16; ++r) sc[r] = ((dmask >> r) & 1u) ? sc[r] : 0.f; }
#pragma unroll
                for (int s2 = 0; s2 < 2; ++s2) { v4u pw; pw.x = att::cvtpk(sc[8 * s2], sc[8 * s2 + 1]); pw.y = att::cvtpk(sc[8 * s2 + 2], sc[8 * s2 + 3]); pw.z = att::cvtpk(sc[8 * s2 + 4], sc[8 * s2 + 5]); pw.w = att::cvtpk(sc[8 * s2 + 6], sc[8 * s2 + 7]);
                    const bf16x8 xf = ssd::trpair(xa + (32 * st + 16 * s2) * ssd::RS_XTR, 8 * ssd::RS_XTR);
                    acc = SSD_MFMA(xf, __builtin_bit_cast(bf16x8, pw), acc); } } }
            const float Dk = dsk[hh]; float ssq = 0.f; ssd::f32x16 yv16;
#pragma unroll
            for (int g4 = 0; g4 < 4; ++g4) { float yv[4]; const unsigned long long zz = *(const unsigned long long*)(proj + (size_t)(rowg0 + lrow) * NPROJ + OFF_Z + hh * 64 + 32 * pt + 4 * hi + 8 * g4);
                const unsigned long long xx = *(const LAS unsigned long long*)(Xh + lrow * ssd::RS_XTR + (hl * 64 + 32 * pt + 8 * g4 + 4 * hi) * 2);
                const float zf[4] = {blo((unsigned)zz), bhi((unsigned)zz), blo((unsigned)(zz >> 32)), bhi((unsigned)(zz >> 32))};
                const float xf[4] = {blo((unsigned)xx), bhi((unsigned)xx), blo((unsigned)(xx >> 32)), bhi((unsigned)(xx >> 32))};
#pragma unroll
                for (int e = 0; e < 4; ++e) { const float v = (acc[4 * g4 + e] + Dk * xf[e]) * (zf[e] * __builtin_amdgcn_rcpf(1.0f + __builtin_amdgcn_exp2f(-1.4426950408889634f * zf[e]))); yv[e] = v; ssq += v * v; yv16[4 * g4 + e] = v; } }
            if (hl == 0) yg0 = yv16; else if (hl == 1) yg1 = yv16; else if (hl == 2) yg2 = yv16; else yg3 = yv16;
            ssq += __shfl_xor(ssq, 32);
            if (hi == 0) (void)__hip_atomic_fetch_add(rss + lrow, ssq, __ATOMIC_RELAXED, __HIP_MEMORY_SCOPE_WORKGROUP);
        }
        __syncthreads();
#pragma unroll
        for (int hl = 0; hl < 4; ++hl) {
            const int lrow = 32 * ((wq + hl) & 3) + r32;
            const float rstd = 1.0f / sqrtf(rss[lrow] * (1.0f / 256.0f) + EPS);
            bf16* yr = y + (size_t)(rowg0 + lrow) * DM + 256 + g * 256 + hl * 64 + 32 * pt + 4 * hi;
            const float* nwp = nw + g * 256 + hl * 64 + 32 * pt + 4 * hi;
            const ssd::f32x16 yv = (hl == 0) ? yg0 : (hl == 1) ? yg1 : (hl == 2) ? yg2 : yg3;
#pragma unroll
            for (int g4 = 0; g4 < 4; ++g4) { const f32x4 wv = *(const f32x4*)(nwp + 8 * g4);
                *(unsigned long long*)(yr + 8 * g4) = (unsigned long long)att::cvtpk(yv[4 * g4] * rstd * wv.x, yv[4 * g4 + 1] * rstd * wv.y) | ((unsigned long long)att::cvtpk(yv[4 * g4 + 2] * rstd * wv.z, yv[4 * g4 + 3] * rstd * wv.w) << 32); } }
    }
    __syncthreads();
}

constexpr int PH_PER_LAYER = 7, N_PHASES = 1 + DEPTH * PH_PER_LAYER;
#define IN(k) (lo <= (k) && (k) < hi)
#define FRESH() do { asm volatile("" : "+s"(F.wave), "+s"(F.vcu), "+s"(F.G)); F.lane = lane_id(); asm volatile("" : "+v"(F.lane)); F.tid = F.wave * 64 + F.lane; bx = (int)blockIdx.x; asm volatile("" : "+s"(bx)); } while (0)
#define SEAM(k) do { if (IN(k) && IN((k) + 1)) { int w0_ = F.wave; asm volatile("" : "+s"(w0_)); xcd_barrier(bar, w0_ == 0 && lane_id() == 0); } } while (0)

template <int l> __device__ __forceinline__ void layer_phases(Frame& F, const int lo, const int hi, const XcdBarrier& bar) {
    int bx;
        const int pb = 1 + l * PH_PER_LAYER;
        if (IN(pb + 0)) { FRESH();
            if (l > 0) { dt_rows_b(F, (const bf16*)ARGOUT(), l); FRESH(); }
            unsigned char* ws = ARGWS(); unsigned char* wb = ws + WS_W + (size_t)l * W_LAYER;
            pg8::Gemm g{l == 0 ? (const bf16*)(ws + WS_XB) : (const bf16*)ARGOUT(), (const bf16*)(wb + W_IN), M, NPROJ, DM}; pg8::StaticOrder S; S.init(M, NPROJ, F.G, bx);
            pg8::EpiProj E{(bf16*)(ws + WS_PROJ), l == 0 ? (const float*)(ws + WS_RSTD) : (const float*)(ws + WS_SSQ2), ARGF(3) + l * 64, ARGF(4) + l * 64, ARGF(5) + l * 64, ARGF(6) + l * 64, (float*)(ws + WS_KMS) + (size_t)l * (BATCH * 16 * 4 * 64)};
            pg8::gemm_phase<pg8::EpiProj, pg8::StaticOrder, true, true>(F.lds + RING_OFF, g, S, E, F.wave);
        }
        SEAM(pb + 0);
        if (IN(pb + 1)) { FRESH(); ssd_states(F, l); FRESH(); mixA1_coop(F); FRESH(); moba_build(F, l); }
        SEAM(pb + 1);
        if (IN(pb + 2)) {
#pragma unroll 1
            for (int s = 0; s < 3; ++s) { FRESH(); const int f = (F.vcu & 1) ? (s + 1) % 3 : s;
                if (f == 0) ssd_scan(F); else if (f == 1) moba_lists(F, l); else mixA23_mfma(F); }
        }
        SEAM(pb + 2);
        if (IN(pb + 3)) { FRESH(); ssd_out(F, l); FRESH(); moba_own256_merge(F, l); }
        SEAM(pb + 3);
        if (IN(pb + 4)) { FRESH();
            unsigned char* ws = ARGWS(); unsigned char* wb = ws + WS_W + (size_t)l * W_LAYER; float* out = ARGOUT();
            pg8::Gemm g{(const bf16*)(ws + WS_Y), (const bf16*)(wb + W_OUT), M, DM, DM}; pg8::StaticOrder S; S.init(M, DM, F.G, bx);
            pg8::EpiRes1 E{l == 0 ? (const bf16*)(ws + WS_XB) : (const bf16*)out, (bf16*)(ws + WS_XB), (float*)(ws + WS_SSQ) + (size_t)l * M};
            pg8::gemm_phase<pg8::EpiRes1, pg8::StaticOrder, true, false>(F.lds + RING_OFF, g, S, E, F.wave);
        }
        SEAM(pb + 4);
        if (IN(pb + 5)) { FRESH();
            unsigned char* ws = ARGWS(); unsigned char* wb = ws + WS_W + (size_t)l * W_LAYER;
            pg8::Gemm g{(const bf16*)(ws + WS_XB), (const bf16*)(wb + W_1), M, FF, DM}; pg8::StaticOrder S; S.init(M, FF, F.G, bx);
            pg8::EpiRelu2 E{(bf16*)(ws + WS_H), (const float*)(ws + WS_SSQ) + (size_t)l * M};
            pg8::gemm_phase<pg8::EpiRelu2, pg8::StaticOrder, true, true>(F.lds + RING_OFF, g, S, E, F.wave);
        }
        SEAM(pb + 5);
        if (IN(pb + 6)) { FRESH();
            unsigned char* ws = ARGWS(); unsigned char* wb = ws + WS_W + (size_t)l * W_LAYER;
            pg8::Gemm g{(const bf16*)(ws + WS_H), (const bf16*)(wb + W_2), M, DM, FF}; pg8::StaticOrder S; S.init(M, DM, F.G, bx);
            pg8::EpiRes2 E{ARGOUT(), (const bf16*)(ws + WS_XB), (l + 1 < DEPTH) ? (bf16*)ARGOUT() : (bf16*)nullptr, (float*)(ws + WS_SSQ2)};
            pg8::gemm_phase<pg8::EpiRes2, pg8::StaticOrder, true, true>(F.lds + RING_OFF, g, S, E, F.wave);
        }
        SEAM(pb + 6);
}

struct Args { const float* in[17]; float* out; unsigned char* ws; int ph_lo, ph_hi; };
__global__ void __launch_bounds__(NWAVES * 64, 2) mk_fwd(Args args) {
    extern __shared__ __attribute__((aligned(16))) unsigned char lds[];
    Frame F;
    F.lds = (LAS unsigned char*)lds;
    F.MISC = (volatile LAS unsigned*)(F.lds + MISC_OFF);
    F.tid = threadIdx.x; F.lane = F.tid & 63; F.wave = __builtin_amdgcn_readfirstlane(F.tid >> 6);
    F.G = gridDim.x; { const int bx = blockIdx.x; F.vcu = (F.G % 8 == 0) ? (bx % 8) * (F.G / 8) + bx / 8 : bx; }
    for (int u = F.tid; u < (LDS_BYTES - LDSCTL_OFF) / 4; u += NWAVES * 64) ((LAS unsigned*)(F.lds + LDSCTL_OFF))[u] = 0u;
    __syncthreads();
    const int lo = args.ph_lo, hi = args.ph_hi;
    XcdBarrier bar; bar.bar = (unsigned*)(ARGWS() + WS_CTL) + CW_BAR; bar.x = 0; bar.st = nullptr;
    if (hi - lo > 1) bar = xcd_barrier_post((unsigned*)(ARGWS() + WS_CTL) + CW_BAR, F.MISC + 8);
    int bx;
    if (IN(0)) { FRESH(); p0_weights(F); __syncthreads(); pre_rows(F, ARGF(0), 0); }
    SEAM(0);
    layer_phases<0>(F, lo, hi, bar);
    layer_phases<1>(F, lo, hi, bar);
#undef IN
#undef SEAM
}

#ifndef MK_N_LAUNCHES
#define MK_N_LAUNCHES 1
#endif
extern "C" void kernel_launch(void* const* d_in, const int* in_sizes, int n_in, void* d_out, int out_size, void* d_ws, size_t ws_size, hipStream_t stream) {
    static int grid = 0;
    if (grid == 0) {
        if (n_in != 17 || in_sizes[0] != M * DM || out_size != M * DM || ws_size < WS_END) { fprintf(stderr, "kernel_launch: unexpected shapes (n_in %d, in0 %d, out %d, ws %zu)\n", n_in, n_in > 0 ? in_sizes[0] : -1, out_size, ws_size); grid = -1; return; }
        int dev = 0, cus = 0, per_cu = 0;
        if (hipGetDevice(&dev) != hipSuccess || hipDeviceGetAttribute(&cus, hipDeviceAttributeMultiprocessorCount, dev) != hipSuccess) { grid = -1; return; }
        if (hipFuncSetAttribute((const void*)mk_fwd, hipFuncAttributeMaxDynamicSharedMemorySize, LDS_BYTES) != hipSuccess) { fprintf(stderr, "kernel_launch: hipFuncSetAttribute failed\n"); grid = -1; return; }
        if (hipOccupancyMaxActiveBlocksPerMultiprocessor(&per_cu, (const void*)mk_fwd, NWAVES * 64, LDS_BYTES) != hipSuccess || per_cu < 1) { fprintf(stderr, "kernel_launch: occupancy query says %d blocks per CU\n", per_cu); }
        (void)hipGetLastError();
        if (cus < 256) { fprintf(stderr, "kernel_launch: built for 256 CUs, device has %d\n", cus); grid = -1; return; }
        grid = 256;
    }
    if (grid < 0) return;
    if (hipMemsetAsync((char*)d_ws + WS_CTL, 0, CTL_ZERO_BYTES, stream) != hipSuccess) { fprintf(stderr, "kernel_launch: memset failed\n"); return; }
    Args a{};
    for (int i = 0; i < 17; ++i) a.in[i] = (const float*)d_in[i];
    a.out = (float*)d_out; a.ws = (unsigned char*)d_ws;
    const int NL = MK_N_LAUNCHES;
    if (NL == 1) { a.ph_lo = 0; a.ph_hi = N_PHASES; hipLaunchKernelGGL(mk_fwd, dim3(grid), dim3(NWAVES * 64), LDS_BYTES, stream, a); }
    else { for (int p = 0; p < N_PHASES; ++p) { a.ph_lo = p; a.ph_hi = p + 1; hipLaunchKernelGGL(mk_fwd, dim3(grid), dim3(NWAVES * 64), LDS_BYTES, stream, a); } }
    const hipError_t le = hipPeekAtLastError();
    if (le != hipSuccess) fprintf(stderr, "kernel_launch: launch failed: %s\n", hipGetErrorName(le));
}
```

```cpp
#include <hip/hip_runtime.h>
#include <cstdio>
#include <cstdint>
#include <cmath>
__device__ __forceinline__ int lane_id() { return (int)__builtin_amdgcn_mbcnt_hi(~0u, __builtin_amdgcn_mbcnt_lo(~0u, 0u)); }
namespace pg8 {
#define PG8_LAS __attribute__((address_space(3)))
typedef unsigned short bf16_t;
typedef short bf16x8 __attribute__((ext_vector_type(8)));
typedef float f32x4 __attribute__((ext_vector_type(4)));
typedef unsigned u32x4 __attribute__((ext_vector_type(4)));
constexpr int BM = 256, BK = 64, HALF = 128, HTB = HALF * BK * 2  , STAGE_BYTES = 8 * HTB, NXCD = 8, WGM = 4;

__host__ __device__ __forceinline__ int lds_byte(int r, int c) { const int st = (r >> 4) * 2 + (c >> 5), rr = r & 15, cc = c & 31, ob = rr * 64 + cc * 2; return st * 1024 + (ob ^ (((ob >> 9) & 1) << 5)); }
__host__ __device__ __forceinline__ void stage_rc(int b, int& R, int& C) { const int st = b / 1024, sb = b % 1024, swz = sb ^ (((sb >> 9) & 1) << 5); R = (st >> 1) * 16 + swz / 64; C = (st & 1) * 32 + (swz % 64) / 2; }
__host__ __device__ __forceinline__ int perm32(int rho) { const int n = rho >> 4, i = rho & 15; return 8 * (i >> 2) + 4 * n + (i & 3); }

struct Unit { int pm, pn; };
struct Gemm { const bf16_t* A; const bf16_t* Bt; int M, N, K; };

struct StaticOrder {
    int nM, nN, nwg, G, c;
    __host__ __device__ void init(int M, int N, int G_, int c_) { nM = M / BM; nN = N / BM; nwg = nM * nN; G = G_; c = c_; }
    __host__ __device__ bool next(int i, Unit& u) const {
        const long L = (long)i * G + c; if (L >= nwg) return false;
        int wgid = (int)L; { const int q = nwg / NXCD, r = nwg % NXCD, xcd = wgid % NXCD, off = wgid / NXCD; wgid = (xcd < r ? xcd * (q + 1) : r * (q + 1) + (xcd - r) * q) + off; }
        const int nig = WGM * nN, gid = wgid / nig, fm = gid * WGM, gsz = (nM - fm) < WGM ? (nM - fm) : WGM;
        u.pm = fm + ((wgid % nig) % gsz); u.pn = (wgid % nig) / gsz; return true;
    }
    __device__ __forceinline__ void a_ready(const Unit&) const {}
    __device__ __forceinline__ void done(const Unit&) const {}
};

__device__ __forceinline__ unsigned cvt_pk_bf16(float lo, float hi) { unsigned r; asm volatile("v_cvt_pk_bf16_f32 %0, %1, %2" : "=v"(r) : "v"(lo), "v"(hi)); return r; }
typedef float f32x2 __attribute__((ext_vector_type(2)));
typedef unsigned u32x2 __attribute__((ext_vector_type(2)));
struct EpiProj {
    static constexpr bool PERM = true, AFTER_DRAIN = false;
    bf16_t* P; const float* rss; const float *g0, *g1, *g2, *g3;
    float* kms;
    __device__ __forceinline__ void operator()(const f32x4 (&acc)[2][2][4][2], const Unit& u, int wr, int wc, int fr, int fq) const {
        const int pn = u.pn; const int nsel = (pn == 0) ? 0 : (pn == 1) ? 1 : (pn == 3) ? 2 : (pn == 4) ? 3 : -1;
        const int row0 = u.pm * BM + wr * 64 + fr;
        const float* nw = (nsel == 0) ? g0 : (nsel == 1) ? g1 : (nsel == 2) ? g2 : g3;
        f32x4 g[2][2];
#pragma unroll
        for (int bj = 0; bj < 2; ++bj)
#pragma unroll
            for (int n = 0; n < 2; ++n) g[bj][n] = (nsel >= 0) ? *(const f32x4*)(nw + 32 * bj + 8 * fq + 4 * n) : (f32x4){1.f, 1.f, 1.f, 1.f};
        f32x4 cs[2][2];
#pragma unroll
        for (int bj = 0; bj < 2; ++bj)
#pragma unroll
            for (int n = 0; n < 2; ++n) cs[bj][n] = (f32x4){0.f, 0.f, 0.f, 0.f};
#pragma unroll
        for (int ai = 0; ai < 2; ++ai)
#pragma unroll
            for (int m = 0; m < 4; ++m) {
                const int row = row0 + ai * HALF + m * 16; const float r = 1.0f / sqrtf(rss[row] * (1.0f / 1024.0f) + 1e-6f);
                f32x4 v[2][2]; float ss = 0.f;
#pragma unroll
                for (int bj = 0; bj < 2; ++bj)
#pragma unroll
                    for (int n = 0; n < 2; ++n) { v[bj][n] = acc[ai][bj][m][n] * r; const f32x4 x = v[bj][n]; ss += (x[0] * x[0] + x[1] * x[1]) + (x[2] * x[2] + x[3] * x[3]); }
                if (nsel >= 0) {
                    ss += __shfl_xor(ss, 16); ss += __shfl_xor(ss, 32);
                    const float hr = 1.0f / sqrtf(ss * (1.0f / 64.0f) + 1e-6f);
#pragma unroll
                    for (int bj = 0; bj < 2; ++bj)
#pragma unroll
                        for (int n = 0; n < 2; ++n) { v[bj][n] = v[bj][n] * hr * g[bj][n]; cs[bj][n] += v[bj][n]; }
                }
                bf16_t* rowp = P + (size_t)row * 3072 + pn * BM + wc * 64 + 8 * fq;
#pragma unroll
                for (int bj = 0; bj < 2; ++bj) { u32x4 w; w.x = cvt_pk_bf16(v[bj][0][0], v[bj][0][1]); w.y = cvt_pk_bf16(v[bj][0][2], v[bj][0][3]); w.z = cvt_pk_bf16(v[bj][1][0], v[bj][1][1]); w.w = cvt_pk_bf16(v[bj][1][2], v[bj][1][3]);
                    *(u32x4*)(rowp + 32 * bj) = w; }
            }
        if (nsel == 3) {
            float* dst = kms + ((size_t)(u.pm * 4 + wc)) * 64 + 8 * fq;
#pragma unroll
            for (int bj = 0; bj < 2; ++bj)
#pragma unroll
                for (int n = 0; n < 2; ++n)
#pragma unroll
                    for (int e = 0; e < 4; ++e) { float s = cs[bj][n][e]; s += __shfl_xor(s, 1); s += __shfl_xor(s, 2); s += __shfl_xor(s, 4); s += __shfl_xor(s, 8);
                        if (fr == 0) atomicAdd(dst + 32 * bj + 4 * n + e, s); }
        }
    }
};
struct EpiRes1 {
    static constexpr bool PERM = true, AFTER_DRAIN = false;
    const bf16_t* baseb; bf16_t* xb; float* ssq;
    __device__ __forceinline__ void operator()(const f32x4 (&acc)[2][2][4][2], const Unit& u, int wr, int wc, int fr, int fq) const {
        const int col0 = u.pn * BM + wc * 32 + 8 * fq;
#pragma unroll
        for (int ai = 0; ai < 2; ++ai)
#pragma unroll
            for (int m = 0; m < 4; ++m) {
                const int row = u.pm * BM + ai * HALF + wr * 64 + m * 16 + fr; const size_t off = (size_t)row * 1024 + col0; float ss = 0.f;
#pragma unroll
                for (int bj = 0; bj < 2; ++bj) { const size_t o2 = off + bj * HALF;
                    const u32x4 h = *(const u32x4*)(baseb + o2);
                    f32x4 o0, o1;
                    o0[0] = __uint_as_float(h.x << 16); o0[1] = __uint_as_float(h.x & 0xffff0000u); o0[2] = __uint_as_float(h.y << 16); o0[3] = __uint_as_float(h.y & 0xffff0000u);
                    o1[0] = __uint_as_float(h.z << 16); o1[1] = __uint_as_float(h.z & 0xffff0000u); o1[2] = __uint_as_float(h.w << 16); o1[3] = __uint_as_float(h.w & 0xffff0000u);
                    o0 = o0 + acc[ai][bj][m][0]; o1 = o1 + acc[ai][bj][m][1];
                    u32x4 w; w.x = cvt_pk_bf16(o0[0], o0[1]); w.y = cvt_pk_bf16(o0[2], o0[3]); w.z = cvt_pk_bf16(o1[0], o1[1]); w.w = cvt_pk_bf16(o1[2], o1[3]); *(u32x4*)(xb + o2) = w;
                    ss += ((o0[0] * o0[0] + o0[1] * o0[1]) + (o0[2] * o0[2] + o0[3] * o0[3])) + ((o1[0] * o1[0] + o1[1] * o1[1]) + (o1[2] * o1[2] + o1[3] * o1[3])); }
                ss += __shfl_xor(ss, 16); ss += __shfl_xor(ss, 32);
                if (fq == 0) atomicAdd(ssq + row, ss);
            }
    }
};
struct EpiRelu2 {
    static constexpr bool PERM = true, AFTER_DRAIN = false;
    bf16_t* H; const float* ssq;
    __device__ __forceinline__ void operator()(const f32x4 (&acc)[2][2][4][2], const Unit& u, int wr, int wc, int fr, int fq) const {
        const int col0 = u.pn * BM + wc * 32 + 8 * fq;
#pragma unroll
        for (int ai = 0; ai < 2; ++ai)
#pragma unroll
            for (int m = 0; m < 4; ++m) {
                const int row = u.pm * BM + ai * HALF + wr * 64 + m * 16 + fr; const float r = 1.0f / sqrtf(ssq[row] * (1.0f / 1024.0f) + 1e-6f);
                bf16_t* rowp = H + (size_t)row * 4096 + col0;
#pragma unroll
                for (int bj = 0; bj < 2; ++bj) { f32x4 v0 = acc[ai][bj][m][0] * r, v1 = acc[ai][bj][m][1] * r;
#pragma unroll
                    for (int e = 0; e < 4; ++e) { const float a = fmaxf(v0[e], 0.f), b = fmaxf(v1[e], 0.f); v0[e] = a * a; v1[e] = b * b; }
                    u32x4 w; w.x = cvt_pk_bf16(v0[0], v0[1]); w.y = cvt_pk_bf16(v0[2], v0[3]); w.z = cvt_pk_bf16(v1[0], v1[1]); w.w = cvt_pk_bf16(v1[2], v1[3]);
                    *(u32x4*)(rowp + bj * HALF) = w; }
            }
    }
};
struct EpiRes2 {
    static constexpr bool PERM = true, AFTER_DRAIN = false;
    float* out; const bf16_t* xhi; bf16_t* xnb; float* ssqn;
    __device__ __forceinline__ void operator()(const f32x4 (&acc)[2][2][4][2], const Unit& u, int wr, int wc, int fr, int fq) const {
        const int col0 = u.pn * BM + wc * 32 + 8 * fq;
#pragma unroll
        for (int ai = 0; ai < 2; ++ai)
#pragma unroll
            for (int m = 0; m < 4; ++m) {
                const int row = u.pm * BM + ai * HALF + wr * 64 + m * 16 + fr; const size_t off = (size_t)row * 1024 + col0; float ss = 0.f;
#pragma unroll
                for (int bj = 0; bj < 2; ++bj) { const size_t o2 = off + bj * HALF;
                    const u32x4 h = *(const u32x4*)(xhi + o2);
                    f32x4 o0, o1;
                    o0[0] = __uint_as_float(h.x << 16); o0[1] = __uint_as_float(h.x & 0xffff0000u); o0[2] = __uint_as_float(h.y << 16); o0[3] = __uint_as_float(h.y & 0xffff0000u);
                    o1[0] = __uint_as_float(h.z << 16); o1[1] = __uint_as_float(h.z & 0xffff0000u); o1[2] = __uint_as_float(h.w << 16); o1[3] = __uint_as_float(h.w & 0xffff0000u);
                    o0 = o0 + acc[ai][bj][m][0]; o1 = o1 + acc[ai][bj][m][1];
                    if (xnb) { u32x4 w; w.x = cvt_pk_bf16(o0[0], o0[1]); w.y = cvt_pk_bf16(o0[2], o0[3]); w.z = cvt_pk_bf16(o1[0], o1[1]); w.w = cvt_pk_bf16(o1[2], o1[3]); *(u32x4*)(xnb + o2) = w;
                        ss += ((o0[0] * o0[0] + o0[1] * o0[1]) + (o0[2] * o0[2] + o0[3] * o0[3])) + ((o1[0] * o1[0] + o1[1] * o1[1]) + (o1[2] * o1[2] + o1[3] * o1[3])); }
                    else { *(f32x4*)(out + o2) = o0; *(f32x4*)(out + o2 + 4) = o1; } }
                if (xnb) { ss += __shfl_xor(ss, 16); ss += __shfl_xor(ss, 32); if (fq == 0) atomicAdd(ssqn + row, ss); }
            }
    }
};
template <class Epi, class Sched, bool ALIGN_EPI = false, bool SP2 = false>
__device__ __forceinline__ void gemm_phase(PG8_LAS unsigned char* lds, const Gemm g, const Sched& S, const Epi& E, const int wave_in) {
    int tid_ = wave_in * 64 + lane_id(); asm volatile("" : "+v"(tid_));
    const int tid = tid_, wid = __builtin_amdgcn_readfirstlane(tid >> 6), lane = tid & 63, wr = wid >> 2, wc = wid & 3, fr = lane & 15, fq = lane >> 4;
    const int K = g.K, nt = K / BK;
    unsigned voffA[2], voffB[2];
#pragma unroll
    for (int i = 0; i < 2; ++i) { int R, C; stage_rc(tid * 16 + i * 8192, R, C); const int Rb = Epi::PERM ? ((R & ~31) + perm32(R & 31)) : R;
        voffA[i] = (unsigned)(R * K + C) * 2u; voffB[i] = (unsigned)(Rb * K + C) * 2u; }
    const size_t kstep = (size_t)(BK * 2);
    const size_t hstep = (size_t)HALF * K * 2;
    const size_t tstep = 2 * hstep;
    const unsigned ldsw = (unsigned)wid * 1024u;
    const int aoff = lds_byte(wr * 64 + fr, fq * 8), boff = lds_byte(wc * 32 + fr, fq * 8);
#define PG8_SA(b, h) (((b) * 2 + (h)) * HTB)
#define PG8_SB(b, h) ((4 + (b) * 2 + (h)) * HTB)
#define PG8_STAGE(bufoff, gbase, voff) do { _Pragma("unroll") for (int _i = 0; _i < 2; ++_i) \
        __builtin_amdgcn_global_load_lds((const unsigned*)((const char*)(gbase) + (voff)[_i]), (PG8_LAS unsigned*)(lds + (bufoff) + ldsw + _i * 8192), 16, 0, 0); } while (0)
#define PG8_LDA(dst, b, h) do { _Pragma("unroll") for (int m = 0; m < 4; ++m) _Pragma("unroll") for (int k = 0; k < 2; ++k) dst[m][k] = *(const PG8_LAS bf16x8*)(lds + PG8_SA(b, h) + aoff + m * 2048 + k * 1024); } while (0)
#define PG8_LDB(dst, b, h) do { _Pragma("unroll") for (int n = 0; n < 2; ++n) _Pragma("unroll") for (int k = 0; k < 2; ++k) dst[n][k] = *(const PG8_LAS bf16x8*)(lds + PG8_SB(b, h) + boff + n * 2048 + k * 1024); } while (0)
#define PG8_MMA(ai, bj, At, Bt) do { __builtin_amdgcn_s_setprio(1); _Pragma("unroll") for (int m = 0; m < 4; ++m) _Pragma("unroll") for (int n = 0; n < 2; ++n) _Pragma("unroll") for (int k = 0; k < 2; ++k) \
        acc[ai][bj][m][n] = __builtin_amdgcn_mfma_f32_16x16x32_bf16(Bt[n][k], At[m][k], acc[ai][bj][m][n], 0, 0, 0); __builtin_amdgcn_s_setprio(0); } while (0)
#define PG8_WAIT_V(n) asm volatile("s_waitcnt vmcnt(" #n ")" ::: "memory")
#define PG8_WAIT_L(n) asm volatile("s_waitcnt lgkmcnt(" #n ")" ::: "memory")
#define PG8_BAR __builtin_amdgcn_s_barrier()
#define PG8_SCHED __builtin_amdgcn_sched_barrier(0)
    Unit cur, nxt; int ui = 0;
    if (!S.next(0, cur)) return;
    f32x4 acc[2][2][4][2];
#pragma unroll
    for (int a = 0; a < 2; ++a)
#pragma unroll
        for (int b = 0; b < 2; ++b)
#pragma unroll
            for (int m = 0; m < 4; ++m)
#pragma unroll
                for (int n = 0; n < 2; ++n) acc[a][b][m][n] = (f32x4){0.f, 0.f, 0.f, 0.f};
    bf16x8 At[4][2], B0[2][2], B1[2][2];
    const char* cA = (const char*)g.A + (size_t)cur.pm * tstep; const char* cB = (const char*)g.Bt + (size_t)cur.pn * tstep;
    S.a_ready(cur);
    if constexpr (SP2) {
        PG8_STAGE(PG8_SB(0, 0), cB, voffB); PG8_STAGE(PG8_SB(0, 1), cB + hstep, voffB); PG8_STAGE(PG8_SA(0, 0), cA, voffA); PG8_STAGE(PG8_SA(0, 1), cA + hstep, voffA);
        if (wr == 1) PG8_BAR;
        PG8_WAIT_V(2); PG8_BAR;
        PG8_STAGE(PG8_SB(1, 0), cB + kstep, voffB); PG8_STAGE(PG8_SA(1, 0), cA + kstep, voffA); PG8_STAGE(PG8_SB(1, 1), cB + hstep + kstep, voffB);
        PG8_WAIT_V(6); PG8_BAR;
    } else {
        PG8_STAGE(PG8_SB(0, 0), cB, voffB); PG8_STAGE(PG8_SA(0, 0), cA, voffA); PG8_STAGE(PG8_SB(0, 1), cB + hstep, voffB); PG8_STAGE(PG8_SA(0, 1), cA + hstep, voffA);
        if (wr == 1) PG8_BAR;
        PG8_WAIT_V(4); PG8_BAR;
        PG8_STAGE(PG8_SB(1, 0), cB + kstep, voffB); PG8_STAGE(PG8_SA(1, 0), cA + kstep, voffA); PG8_STAGE(PG8_SB(1, 1), cB + hstep + kstep, voffB);
        PG8_WAIT_V(6); PG8_BAR;
    }
    for (;;) {
        const bool has_next = S.next(ui + 1, nxt);
        const char* nA = has_next ? (const char*)g.A + (size_t)nxt.pm * tstep : cA; const char* nB = has_next ? (const char*)g.Bt + (size_t)nxt.pn * tstep : cB;
        for (int t = 0; t < nt; t += 2) {
            const bool last = (t == nt - 2);
            const char* a1 = cA + (size_t)(t + 1) * kstep;
            const char* a2 = last ? nA : cA + (size_t)(t + 2) * kstep; const char* b2 = last ? nB : cB + (size_t)(t + 2) * kstep;
            const char* a3 = a2 + kstep; const char* b3 = b2 + kstep;
            if (last && has_next) S.a_ready(nxt);
            if constexpr (SP2) {
            PG8_LDB(B0, 0, 0); PG8_LDB(B1, 0, 1); PG8_SCHED; PG8_LDA(At, 0, 0); PG8_STAGE(PG8_SA(1, 1), a1 + hstep, voffA);
            PG8_WAIT_V(8); PG8_WAIT_L(0); PG8_BAR; PG8_MMA(0, 0, At, B0); PG8_MMA(0, 1, At, B1); PG8_BAR; PG8_SCHED;
            PG8_LDA(At, 0, 1); PG8_STAGE(PG8_SB(0, 0), b2, voffB); PG8_STAGE(PG8_SB(0, 1), b2 + hstep, voffB); PG8_STAGE(PG8_SA(0, 0), a2, voffA);
            PG8_WAIT_V(8); PG8_WAIT_L(0); PG8_BAR; PG8_MMA(1, 0, At, B0); PG8_MMA(1, 1, At, B1); PG8_BAR; PG8_SCHED;
            PG8_LDB(B0, 1, 0); PG8_LDB(B1, 1, 1); PG8_SCHED; PG8_LDA(At, 1, 0); PG8_STAGE(PG8_SA(0, 1), a2 + hstep, voffA);
            PG8_WAIT_V(8); PG8_WAIT_L(0); PG8_BAR; PG8_MMA(0, 0, At, B0); PG8_MMA(0, 1, At, B1); PG8_BAR; PG8_SCHED;
            PG8_LDA(At, 1, 1); PG8_STAGE(PG8_SB(1, 0), b3, voffB); PG8_STAGE(PG8_SB(1, 1), b3 + hstep, voffB); PG8_STAGE(PG8_SA(1, 0), a3, voffA);
            PG8_WAIT_V(8); PG8_WAIT_L(0); PG8_BAR; PG8_MMA(1, 0, At, B0); PG8_MMA(1, 1, At, B1); PG8_BAR; PG8_SCHED;
            } else {
            PG8_LDB(B0, 0, 0); PG8_SCHED; PG8_LDA(At, 0, 0); PG8_STAGE(PG8_SA(1, 1), a1 + hstep, voffA);
            PG8_WAIT_L(8); PG8_BAR; PG8_WAIT_L(0); PG8_MMA(0, 0, At, B0); PG8_BAR; PG8_SCHED;
            PG8_LDB(B1, 0, 1); PG8_STAGE(PG8_SB(0, 0), b2, voffB);
            PG8_BAR; PG8_WAIT_L(0); PG8_MMA(0, 1, At, B1); PG8_BAR;
            PG8_LDA(At, 0, 1); PG8_STAGE(PG8_SA(0, 0), a2, voffA);
            PG8_BAR; PG8_WAIT_L(0); PG8_MMA(1, 0, At, B0); PG8_BAR; PG8_SCHED;
            PG8_STAGE(PG8_SB(0, 1), b2 + hstep, voffB);
            PG8_WAIT_V(6); PG8_BAR; PG8_MMA(1, 1, At, B1); PG8_BAR;
            PG8_LDB(B0, 1, 0); PG8_SCHED; PG8_LDA(At, 1, 0); PG8_STAGE(PG8_SA(0, 1), a2 + hstep, voffA);
            PG8_WAIT_L(8); PG8_BAR; PG8_WAIT_L(0); PG8_MMA(0, 0, At, B0); PG8_BAR; PG8_SCHED;
            PG8_LDB(B1, 1, 1); PG8_STAGE(PG8_SB(1, 0), b3, voffB);
            PG8_BAR; PG8_WAIT_L(0); PG8_MMA(0, 1, At, B1); PG8_BAR;
            PG8_LDA(At, 1, 1); PG8_STAGE(PG8_SA(1, 0), a3, voffA);
            PG8_BAR; PG8_WAIT_L(0); PG8_MMA(1, 0, At, B0); PG8_BAR; PG8_SCHED;
            PG8_STAGE(PG8_SB(1, 1), b3 + hstep, voffB);
            PG8_WAIT_V(6); PG8_BAR; PG8_MMA(1, 1, At, B1); PG8_BAR;
            }
        }
        if constexpr (ALIGN_EPI) { if (wr == 0) PG8_BAR; }
        if constexpr (!Epi::AFTER_DRAIN) { E(acc, cur, wr, wc, fr, fq); S.done(cur); }
        if (!has_next) break;
#pragma unroll
        for (int a = 0; a < 2; ++a)
#pragma unroll
            for (int b = 0; b < 2; ++b)
#pragma unroll
                for (int m = 0; m < 4; ++m)
#pragma unroll
                    for (int n = 0; n < 2; ++n) acc[a][b][m][n] = (f32x4){0.f, 0.f, 0.f, 0.f};
        cur = nxt; cA = nA; cB = nB; ++ui;
        if constexpr (ALIGN_EPI) { if (wr == 1) PG8_BAR; }
    }
    PG8_WAIT_V(0);
    if constexpr (!ALIGN_EPI) { if (wr == 0) PG8_BAR; }
    PG8_BAR;
    if constexpr (Epi::AFTER_DRAIN) { E.fused(acc, cur, wr, wc, fr, fq, lds, wid, lane); S.done(cur); }
#undef PG8_SA
#undef PG8_SB
#undef PG8_STAGE
#undef PG8_LDA
#undef PG8_LDB
#undef PG8_MMA
#undef PG8_WAIT_V
#undef PG8_WAIT_L
#undef PG8_BAR
#undef PG8_SCHED
}
}
#define GAS __attribute__((address_space(1)))
#define LAS __attribute__((address_space(3)))
typedef unsigned short bf16;
typedef unsigned v4u __attribute__((ext_vector_type(4)));
typedef float f32x4 __attribute__((ext_vector_type(4)));
typedef short bf16x8 __attribute__((ext_vector_type(8)));
typedef GAS unsigned gu32;
typedef GAS unsigned long long gu64;
#define RLX_AGENT __ATOMIC_RELAXED, __HIP_MEMORY_SCOPE_AGENT
#define LDS_WAIT() asm volatile("s_waitcnt lgkmcnt(0)" ::: "memory")
#define VM_WAIT() asm volatile("s_waitcnt vmcnt(0)" ::: "memory")
__device__ __forceinline__ unsigned long long rt() { return __builtin_amdgcn_s_memrealtime(); }
__device__ __forceinline__ unsigned f2bf(float f) { unsigned u = __builtin_bit_cast(unsigned, f); return (u + 0x7fffu + ((u >> 16) & 1u)) >> 16; }
__device__ __forceinline__ unsigned pk2(float lo, float hi) { typedef float f2_t __attribute__((ext_vector_type(2))); typedef __bf16 b2_t __attribute__((ext_vector_type(2))); const f2_t v = {lo, hi}; return __builtin_bit_cast(unsigned, __builtin_convertvector(v, b2_t)); }
#define XB_TMO      128
#define XB_XCNT(j)  (256  + 64 * (j))
#define XB_XSUB(j)  (1280 + 64 * (j))
#define XB_XGEN(j)  (2304 + 64 * (j))
#define XB_TOP      3328
#define XB_TOPGEN   3392
#define XCD_BAR_WORDS 3456
#define XB_SPIN_CAP (1u << 18)

__device__ __forceinline__ unsigned xb_ld(unsigned* p)              { return __hip_atomic_load(p, __ATOMIC_RELAXED, __HIP_MEMORY_SCOPE_AGENT); }
__device__ __forceinline__ unsigned xb_add(unsigned* p, unsigned v) { return __hip_atomic_fetch_add(p, v, __ATOMIC_RELAXED, __HIP_MEMORY_SCOPE_AGENT); }
__device__ __forceinline__ unsigned xb_xcc_id() { return (unsigned)__builtin_amdgcn_s_getreg((3 << 11) | 20) & 0xFu; }
#define XB_SPIN(cond, bar) do { unsigned _sp = 0; while (cond) { __builtin_amdgcn_s_sleep(1); \
    if ((++_sp & 255u) == 0u) { if (xb_ld(&(bar)[XB_TMO])) break; if (_sp > XB_SPIN_CAP) { atomicAdd(&(bar)[XB_TMO], 1u); break; } } } } while (0)

struct XcdBarrier {
    unsigned* bar; unsigned x;
    volatile LAS unsigned* st;
};

__device__ __forceinline__ XcdBarrier xcd_barrier_post(unsigned* bar, volatile LAS unsigned* st) {
    XcdBarrier b; b.bar = bar; b.x = xb_xcc_id(); b.st = st;
    if (threadIdx.x == 0) (void)xb_add(&bar[XB_XCNT(b.x)], 1u);
    return b;
}
__device__ __forceinline__ void xcd_barrier_complete(unsigned* bar, unsigned x, unsigned& nloc, unsigned& nx) {
    const unsigned G = gridDim.x * gridDim.y * gridDim.z;
    unsigned sum, cnt, mine, sp = 0u;
    for (;;) {
        sum = 0u; cnt = 0u; mine = 0u;
#pragma unroll
        for (unsigned j = 0; j < 16; ++j) { const unsigned c = xb_ld(&bar[XB_XCNT(j)]); sum += c; cnt += (c > 0u) ? 1u : 0u; mine = (j == x) ? c : mine; }
        if (sum == G) break;
        __builtin_amdgcn_s_sleep(1);
        if ((++sp & 255u) == 0u) { if (xb_ld(&bar[XB_TMO])) break; if (sp > XB_SPIN_CAP) { atomicAdd(&bar[XB_TMO], 1u); break; } }
    }
    nloc = mine > 0u ? mine : 1u; nx = cnt > 0u ? cnt : 1u;
}

__device__ __forceinline__ void xcd_barrier(const XcdBarrier& b, const bool leader  ) {
    asm volatile("s_waitcnt vmcnt(0)" ::: "memory");
    __syncthreads();
    unsigned zoff_ = 0u; asm volatile("s_mov_b32 %0, 0" : "=s"(zoff_)); unsigned* bar_ = b.bar + zoff_; const unsigned bx_ = b.x + zoff_;
    if (leader) {
        unsigned* bar = bar_;
        __builtin_amdgcn_s_waitcnt(0);
        unsigned nloc = b.st[0], nx = b.st[1];
        if (nloc == 0u) { xcd_barrier_complete(bar, bx_, nloc, nx); b.st[0] = nloc; b.st[1] = nx; }
        const unsigned old = xb_add(&bar[XB_XSUB(bx_)], 1u);
        const unsigned gen = old / nloc;
        if (old + 1u == (gen + 1u) * nloc) {
            __builtin_amdgcn_fence(__ATOMIC_RELEASE, "agent");
            asm volatile("s_waitcnt vmcnt(0)" ::: "memory");
            const unsigned og = xb_add(&bar[XB_TOP], 1u);
            const unsigned tg = og / nx;
            if (og + 1u == (tg + 1u) * nx) xb_add(&bar[XB_TOPGEN], 1u);
            else XB_SPIN(xb_ld(&bar[XB_TOPGEN]) == tg, bar);
            __builtin_amdgcn_fence(__ATOMIC_ACQUIRE, "agent");
            xb_add(&bar[XB_XGEN(bx_)], 1u);
            asm volatile("s_waitcnt vmcnt(0)" ::: "memory");
        } else {
            XB_SPIN(xb_ld(&bar[XB_XGEN(bx_)]) == gen, bar);
            __builtin_amdgcn_fence(__ATOMIC_ACQUIRE, "agent");
            asm volatile("s_waitcnt vmcnt(0)" ::: "memory");
        }
    }
    __syncthreads();
}
constexpr int NWAVES = 8;
constexpr int BATCH = 4, SEQ = 4096, DM = 1024, M = BATCH * SEQ, DIN = 3080, NPROJ = 3072, FF = 4096, DEPTH = 2;
constexpr int OFF_QA = 0, OFF_KA = 256, OFF_VA = 512, OFF_QC = 768, OFF_KC = 1024, OFF_VC = 1280, OFF_Z = 1536, OFF_XBC = 2048;
constexpr float EPS = 1e-6f;
constexpr size_t MiB = 1u << 20;
constexpr size_t WS_CTL = 0, CTL_ZERO_BYTES = 1 * MiB;
constexpr size_t WS_KMS = 512 * 1024;
constexpr size_t WS_SSQ2 = 384 * 1024;
constexpr size_t WS_SSQ = 256 * 1024;
constexpr size_t WS_W = 2 * MiB, W_LAYER = 24 * MiB, W_IN = 0, W_OUT = 6 * MiB, W_1 = 8 * MiB, W_2 = 16 * MiB;
constexpr size_t WS_RSTD = 50 * MiB, WS_DT = 51 * MiB, WS_KMEAN = 52 * MiB;
constexpr size_t WS_PROJ = 56 * MiB, WS_Y = 152 * MiB, WS_H = 56 * MiB, WS_XB = 184 * MiB, WS_ST = 216 * MiB, WS_END = 256 * MiB;
static_assert(WS_PROJ + (size_t)M * NPROJ * 2 <= WS_Y && WS_Y + (size_t)M * DM * 2 <= WS_XB && WS_H + (size_t)M * FF * 2 <= WS_XB && WS_XB + (size_t)M * DM * 2 <= WS_ST && WS_ST + 32 * MiB <= WS_END, "d_ws map");
constexpr int CW_BAR = 4096;
constexpr int RING_OFF = 0, RING_BYTES = 143360;
constexpr int LDSCTL_OFF = RING_BYTES, MISC_OFF = LDSCTL_OFF + 320;
constexpr int LDS_BYTES = 147456;

struct Frame {
    LAS unsigned char* lds; volatile LAS unsigned* MISC;
    int tid, lane, wave, vcu, G;
};
typedef const __attribute__((address_space(4))) unsigned char* kptr_t;
__device__ __forceinline__ kptr_t kargs() { kptr_t p = (kptr_t)__builtin_amdgcn_kernarg_segment_ptr(); asm volatile("" : "+s"(p)); return p; }
#define ARGF(i) (*(const float* const __attribute__((address_space(4)))*)(kargs() + 8 * (i)))
#define ARGOUT() (*(float* const __attribute__((address_space(4)))*)(kargs() + 8 * 17))
#define ARGWS() (*(unsigned char* const __attribute__((address_space(4)))*)(kargs() + 8 * 18))
__device__ __forceinline__ float wave_sum(float v) {
#pragma unroll
    for (int o = 1; o < 64; o <<= 1) v += __shfl_xor(v, o);
    return v;
}
__device__ __forceinline__ float wave_max(float v) {
#pragma unroll
    for (int o = 1; o < 64; o <<= 1) v = fmaxf(v, __shfl_xor(v, o));
    return v;
}
__device__ __forceinline__ float blo(unsigned w) { return __uint_as_float(w << 16); }
__device__ __forceinline__ float bhi(unsigned w) { return __uint_as_float(w & 0xffff0000u); }
__device__ __forceinline__ float bf2f(bf16 u) { return __uint_as_float((unsigned)u << 16); }

__device__ __forceinline__ void p0_transpose_item(const float* W, int ldw, int K, int nblk, bf16* WT, LAS float* scr, int item, int lane, const float* kscale, bool perm) {
    const int kb = item / nblk, nb = item % nblk, k0 = 64 * kb, n0 = 32 * nb;
#pragma unroll
    for (int i = 0; i < 8; ++i) { const int kk = 8 * i + (lane >> 3), c4 = 4 * (lane & 7); f32x4 v = *(const f32x4*)(W + (size_t)(k0 + kk) * ldw + n0 + c4);
        if (kscale) v = v * kscale[k0 + kk]; LAS float* d = scr + kk * 33 + c4; d[0] = v.x; d[1] = v.y; d[2] = v.z; d[3] = v.w; }
    LDS_WAIT(); asm volatile("" ::: "memory");
    const int c = lane & 7;
#pragma unroll
    for (int j = 0; j < 4; ++j) { const int n = (lane >> 3) + 8 * j; const LAS float* s = scr + (8 * c) * 33 + n;
        v4u o; o.x = pk2(s[0 * 33], s[1 * 33]); o.y = pk2(s[2 * 33], s[3 * 33]); o.z = pk2(s[4 * 33], s[5 * 33]); o.w = pk2(s[6 * 33], s[7 * 33]);
        int cc = n0 + n; if (perm) { const int cl = cc & 255; cc = (cc & ~255) + 128 * ((cl >> 5) & 1) + 32 * (cl >> 6) + (cl & 31); }
        *(GAS v4u*)(WT + (size_t)cc * K + k0 + 8 * c) = o; }
    LDS_WAIT(); asm volatile("" ::: "memory");
}
__device__ __forceinline__ void p0_weights(Frame& F) {
    LAS float* scr = (LAS float*)(F.lds + RING_OFF + F.wave * 16384);
    const int gw = F.vcu * NWAVES + F.wave, NGW = F.G * NWAVES;
    constexpr int I_IN = (DM / 64) * (NPROJ / 32), I_O = (DM / 64) * (DM / 32), I_1 = (DM / 64) * (FF / 32), I_2 = (FF / 64) * (DM / 32);
    constexpr int PER_L = I_IN + I_O + I_1 + I_2;
    for (int it = gw; it < DEPTH * PER_L; it += NGW) {
        const int l = it / PER_L; int r = it % PER_L;
        unsigned char* wb = ARGWS() + WS_W + (size_t)l * W_LAYER;
        if (r < I_IN) { p0_transpose_item(ARGF(2) + (size_t)l * DM * DIN, DIN, DM, NPROJ / 32, (bf16*)(wb + W_IN), scr, r, F.lane, ARGF(1) + l * DM, true); continue; } r -= I_IN;
        if (r < I_O) { p0_transpose_item(ARGF(13) + (size_t)l * DM * DM, DM, DM, DM / 32, (bf16*)(wb + W_OUT), scr, r, F.lane, nullptr, false); continue; } r -= I_O;
        if (r < I_1) { p0_transpose_item(ARGF(15) + (size_t)l * DM * FF, FF, DM, FF / 32, (bf16*)(wb + W_1), scr, r, F.lane, ARGF(14) + l * DM, false); continue; } r -= I_1;
        p0_transpose_item(ARGF(16) + (size_t)l * FF * DM, DM, FF, DM / 32, (bf16*)(wb + W_2), scr, r, F.lane, nullptr, false);
    }
}
__device__ __forceinline__ void pre_rows(Frame& F, const float* xs, int l) {
    LAS float* wdt = (LAS float*)(F.lds + RING_OFF);
    const float* win = ARGF(2) + (size_t)l * DM * DIN; const float* nw = ARGF(1) + l * DM;
#pragma unroll
    for (int m = 0; m < 2; ++m) { const int k = F.tid + 512 * m; const float g = nw[k];
        const f32x4 a = *(const f32x4*)(win + (size_t)k * DIN + NPROJ), b = *(const f32x4*)(win + (size_t)k * DIN + NPROJ + 4);
        wdt[0 * DM + k] = g * a.x; wdt[1 * DM + k] = g * a.y; wdt[2 * DM + k] = g * a.z; wdt[3 * DM + k] = g * a.w; wdt[4 * DM + k] = g * b.x; wdt[5 * DM + k] = g * b.y; wdt[6 * DM + k] = g * b.z; wdt[7 * DM + k] = g * b.w; }
    __syncthreads();
    const int gw = F.vcu * NWAVES + F.wave, NGW = F.G * NWAVES;
    bf16* xb = (bf16*)(ARGWS() + WS_XB); float* rstd1 = (float*)(ARGWS() + WS_RSTD); float* dt = (float*)(ARGWS() + WS_DT);
    const float bias = (F.lane < 8) ? ARGF(9)[l * 8 + F.lane] : 0.f;
    for (int row0 = gw; row0 < M; row0 += 4 * NGW) {
        f32x4 v[4][4]; float ss[4] = {0.f, 0.f, 0.f, 0.f};
#pragma unroll
        for (int q = 0; q < 4; ++q) { const f32x4* xr = (const f32x4*)(xs + (size_t)(row0 + q * NGW) * DM) + F.lane;
#pragma unroll
            for (int j = 0; j < 4; ++j) v[q][j] = xr[64 * j]; }
#pragma unroll
        for (int q = 0; q < 4; ++q) {
            const int row = row0 + q * NGW;
#pragma unroll
            for (int j = 0; j < 4; ++j) ss[q] += (v[q][j].x * v[q][j].x + v[q][j].y * v[q][j].y) + (v[q][j].z * v[q][j].z + v[q][j].w * v[q][j].w);
            const float ssw = wave_sum(ss[q]); const float rstd = 1.0f / sqrtf(ssw * (1.0f / DM) + EPS);
            unsigned long long* o8 = (unsigned long long*)(xb + (size_t)row * DM) + F.lane;
#pragma unroll
            for (int j = 0; j < 4; ++j) o8[64 * j] = (unsigned long long)pk2(v[q][j].x, v[q][j].y) | ((unsigned long long)pk2(v[q][j].z, v[q][j].w) << 32);
            float mine = 0.f;
#pragma unroll
            for (int jj = 0; jj < 8; ++jj) { float d = 0.f;
#pragma unroll
                for (int j = 0; j < 4; ++j) { const f32x4 w = *(const LAS f32x4*)(wdt + jj * DM + 256 * j + 4 * F.lane); d += (v[q][j].x * w.x + v[q][j].y * w.y) + (v[q][j].z * w.z + v[q][j].w * w.w); }
                d = wave_sum(d); if (F.lane == jj) mine = d; }
            if (F.lane < 8) { const float r = mine * rstd + bias; dt[(size_t)row * 8 + F.lane] = fmaxf(r, 0.f) + log1pf(expf(-fabsf(r))); }
            if (F.lane == 0) rstd1[row] = ssw;
        }
    }
    __syncthreads();
}

__device__ __forceinline__ void dt_rows_b(Frame& F, const bf16* xs, int l) {
    LAS float* wdt = (LAS float*)(F.lds + RING_OFF);
    const int gw = F.vcu * NWAVES + F.wave, NGW = F.G * NWAVES;
    static_assert(M == 8 * 256 * NWAVES, "dt_rows_b: 8 rows per wave on 256 workgroups");
    unsigned long long raw[8][4];
#pragma unroll
    for (int q = 0; q < 8; ++q)
#pragma unroll
        for (int j = 0; j < 4; ++j) raw[q][j] = *((const unsigned long long*)(xs + (size_t)(gw + q * NGW) * DM) + F.lane + 64 * j);
    const float* win = ARGF(2) + (size_t)l * DM * DIN; const float* nw = ARGF(1) + l * DM;
#pragma unroll
    for (int m = 0; m < 2; ++m) { const int k = F.tid + 512 * m; const float g = nw[k];
        const f32x4 a = *(const f32x4*)(win + (size_t)k * DIN + NPROJ), b = *(const f32x4*)(win + (size_t)k * DIN + NPROJ + 4);
        wdt[0 * DM + k] = g * a.x; wdt[1 * DM + k] = g * a.y; wdt[2 * DM + k] = g * a.z; wdt[3 * DM + k] = g * a.w; wdt[4 * DM + k] = g * b.x; wdt[5 * DM + k] = g * b.y; wdt[6 * DM + k] = g * b.z; wdt[7 * DM + k] = g * b.w; }
    float* dt = (float*)(ARGWS() + WS_DT);
    const float bias = (F.lane < 8) ? ARGF(9)[l * 8 + F.lane] : 0.f;
    __syncthreads();
#pragma unroll
    for (int q = 0; q < 8; ++q) {
        const int row = gw + q * NGW; f32x4 v[4]; float ss = 0.f;
#pragma unroll
        for (int j = 0; j < 4; ++j) { v[j].x = blo((unsigned)raw[q][j]); v[j].y = bhi((unsigned)raw[q][j]); v[j].z = blo((unsigned)(raw[q][j] >> 32)); v[j].w = bhi((unsigned)(raw[q][j] >> 32));
            ss += (v[j].x * v[j].x + v[j].y * v[j].y) + (v[j].z * v[j].z + v[j].w * v[j].w); }
        const float rstd = 1.0f / sqrtf(wave_sum(ss) * (1.0f / DM) + EPS);
        float mine = 0.f;
#pragma unroll
        for (int jj = 0; jj < 8; ++jj) { float d = 0.f;
#pragma unroll
            for (int j = 0; j < 4; ++j) { const f32x4 w = *(const LAS f32x4*)(wdt + jj * DM + 256 * j + 4 * F.lane); d += (v[j].x * w.x + v[j].y * w.y) + (v[j].z * w.z + v[j].w * w.w); }
            d = wave_sum(d); if (F.lane == jj) mine = d; }
        if (F.lane < 8) { const float r = mine * rstd + bias; dt[(size_t)row * 8 + F.lane] = fmaxf(r, 0.f) + log1pf(expf(-fabsf(r))); }
    }
    __syncthreads();
}
namespace att {
typedef float f32x16 __attribute__((ext_vector_type(16)));
typedef short v4i16_t __attribute__((ext_vector_type(4)));
typedef __bf16 bf16x2_t __attribute__((ext_vector_type(2)));
typedef float f32x2_t __attribute__((ext_vector_type(2)));
constexpr float C2 = 0.125f * 1.4426950408889634f;
constexpr int VROW = 192, VT_BYTES = 64 * VROW;
constexpr int BIGD = 1 << 28;
#define ATT_MFMA(a, b, c) __builtin_amdgcn_mfma_f32_32x32x16_bf16((a), (b), (c), 0, 0, 0)
__device__ __forceinline__ unsigned cvtpk(float lo, float hi) { f32x2_t v = {lo, hi}; return __builtin_bit_cast(unsigned, __builtin_convertvector(v, bf16x2_t)); }
__device__ __forceinline__ int clampt(int t) { return t < 0 ? 0 : (t > SEQ - 1 ? SEQ - 1 : t); }
__device__ __forceinline__ float half_max(float v) { auto rr = __builtin_amdgcn_permlane32_swap(__float_as_uint(v), __float_as_uint(v), false, false); return fmaxf(__uint_as_float(rr[0]), __uint_as_float(rr[1])); }
__device__ __forceinline__ float half_sum(float v) { auto rr = __builtin_amdgcn_permlane32_swap(__float_as_uint(v), __float_as_uint(v), false, false); return __uint_as_float(rr[0]) + __uint_as_float(rr[1]); }
struct St { f32x16 o0, o1; float m, l; };
template <int D> __device__ __forceinline__ void bias_vecs(f32x16& b0, f32x16& b1, float ns) {
#pragma unroll
    for (int r = 0; r < 16; ++r) { const int e0 = (r & 3) + 8 * (r >> 2); b0[r] = ns * (float)(D * e0); b1[r] = ns * (float)(D * (e0 + 32)); }
}
template <int MODE, int D, int VR>
__device__ __forceinline__ void tile_core(St& st, f32x16& u0, f32x16& u1, float zoff, bool okl, int D0, int maxd, LAS unsigned char* vrd) {
    if (MODE == 1) {
#pragma unroll
        for (int r = 0; r < 16; ++r) { const int e0 = (r & 3) + 8 * (r >> 2);
            u0[r] = ((unsigned)(D0 - D * e0) <= (unsigned)maxd) ? u0[r] : -INFINITY; u1[r] = ((unsigned)(D0 - D * (e0 + 32)) <= (unsigned)maxd) ? u1[r] : -INFINITY; }
    }
    float tmax = fmaxf(u0[0], u1[0]);
#pragma unroll
    for (int r = 1; r < 16; ++r) tmax = fmaxf(tmax, fmaxf(u0[r], u1[r]));
    tmax = (MODE == 0 && !okl) ? -INFINITY : tmax + zoff;
    tmax = half_max(tmax);
    if (__any(tmax > st.m)) { const float mn = fmaxf(st.m, tmax), al = __builtin_amdgcn_exp2f(C2 * (st.m - mn));
#pragma unroll
        for (int r = 0; r < 16; ++r) { st.o0[r] *= al; st.o1[r] *= al; }
        st.l *= al; st.m = mn; }
    const float off = (MODE == 0 && !okl) ? -INFINITY : C2 * (zoff - st.m);
    float ps = 0.f;
#pragma unroll
    for (int r = 0; r < 16; ++r) { u0[r] = __builtin_amdgcn_exp2f(fmaf(u0[r], C2, off)); u1[r] = __builtin_amdgcn_exp2f(fmaf(u1[r], C2, off)); ps += u0[r] + u1[r]; }
    st.l += ps;
#pragma unroll
    for (int sub = 0; sub < 2; ++sub)
#pragma unroll
        for (int s = 0; s < 2; ++s) {
            v4u pw;
            if (sub == 0) { pw.x = cvtpk(u0[8 * s], u0[8 * s + 1]); pw.y = cvtpk(u0[8 * s + 2], u0[8 * s + 3]); pw.z = cvtpk(u0[8 * s + 4], u0[8 * s + 5]); pw.w = cvtpk(u0[8 * s + 6], u0[8 * s + 7]); }
            else { pw.x = cvtpk(u1[8 * s], u1[8 * s + 1]); pw.y = cvtpk(u1[8 * s + 2], u1[8 * s + 3]); pw.z = cvtpk(u1[8 * s + 4], u1[8 * s + 5]); pw.w = cvtpk(u1[8 * s + 6], u1[8 * s + 7]); }
            const bf16x8 pb = __builtin_bit_cast(bf16x8, pw);
#pragma unroll
            for (int dblk = 0; dblk < 2; ++dblk) {
                const v4i16_t lo = __builtin_amdgcn_ds_read_tr16_b64_v4i16((LAS v4i16_t*)(vrd + (32 * sub + 16 * s) * VR + 64 * dblk));
                const v4i16_t hh = __builtin_amdgcn_ds_read_tr16_b64_v4i16((LAS v4i16_t*)(vrd + (32 * sub + 16 * s + 8) * VR + 64 * dblk));
                const bf16x8 va = __builtin_shufflevector(lo, hh, 0, 1, 2, 3, 4, 5, 6, 7);
                if (dblk == 0) st.o0 = ATT_MFMA(va, pb, st.o0); else st.o1 = ATT_MFMA(va, pb, st.o1);
            }
        }
}
template <int D>
__device__ __forceinline__ void run(St& st, const bf16x8 (&qf)[4], const unsigned char* Kb, const unsigned char* Vb, int tkb, int ntiles,
                                    int tq, int maxd, float ns, LAS unsigned char* vl, int lane) {
    const int r32 = lane & 31, hi = lane >> 5;
    LAS unsigned char* vrd = vl + (4 * hi + ((lane & 15) >> 2)) * VROW + (((lane >> 4) & 1) * 16 + (lane & 3) * 4) * 2;
    LAS unsigned char* vwr = vl + (lane >> 3) * VROW + 16 * (lane & 7);
    f32x16 b0, b1; bias_vecs<D>(b0, b1, ns);
    bf16x8 kf[2][4]; v4u vr[8];
#define ATT_LOADK(t) do { _Pragma("unroll") for (int sub = 0; sub < 2; ++sub) { const unsigned o_ = (unsigned)clampt(tkb + D * (64 * (t) + 32 * sub + r32)) * (unsigned)(NPROJ * 2) + 16u * hi; \
        _Pragma("unroll") for (int d0 = 0; d0 < 4; ++d0) kf[sub][d0] = *(const bf16x8*)(Kb + o_ + 32 * d0); } } while (0)
#define ATT_LOADV(t) do { _Pragma("unroll") for (int i2 = 0; i2 < 8; ++i2) { const unsigned o_ = (unsigned)clampt(tkb + D * (64 * (t) + (lane >> 3) + 8 * i2)) * (unsigned)(NPROJ * 2) + 16u * (lane & 7); \
        vr[i2] = *(const v4u*)(Vb + o_); } } while (0)
    ATT_LOADK(ntiles - 1); ATT_LOADV(ntiles - 1);
    for (int t = ntiles - 1; t >= 0; --t) {
#pragma unroll
        for (int i2 = 0; i2 < 8; ++i2) *(LAS v4u*)(vwr + 8 * i2 * VROW) = vr[i2];
        const int tn = (t > 0) ? t - 1 : 0;
        ATT_LOADV(tn);
        f32x16 s0 = b0, s1 = b1;
#pragma unroll
        for (int d0 = 0; d0 < 4; ++d0) { s0 = ATT_MFMA(kf[0][d0], qf[d0], s0); s1 = ATT_MFMA(kf[1][d0], qf[d0], s1); }
        ATT_LOADK(tn);
        const int tk0 = tkb + D * (64 * t + 4 * hi);
        tile_core<1, D, VROW>(st, s0, s1, ns * (float)tk0, true, tq - tk0, maxd, vrd);
    }
#undef ATT_LOADK
#undef ATT_LOADV
}
__device__ __forceinline__ void st_init(St& st) {
#pragma unroll
    for (int r = 0; r < 16; ++r) { st.o0[r] = 0.f; st.o1[r] = 0.f; }
    st.m = -1e30f; st.l = 0.f;
}
__device__ __forceinline__ void load_q(bf16x8 (&qf)[4], const bf16* qrow, int hi) {
#pragma unroll
    for (int d0 = 0; d0 < 4; ++d0) qf[d0] = *(const bf16x8*)(qrow + 16 * d0 + 8 * hi);
}
__device__ __forceinline__ void st_store(St& st, bf16* yrow, int hi) {
    const float lt = half_sum(st.l), inv = 1.0f / lt;
#pragma unroll
    for (int g = 0; g < 4; ++g) {
        unsigned long long w0 = (unsigned long long)cvtpk(st.o0[4 * g] * inv, st.o0[4 * g + 1] * inv) | ((unsigned long long)cvtpk(st.o0[4 * g + 2] * inv, st.o0[4 * g + 3] * inv) << 32);
        unsigned long long w1 = (unsigned long long)cvtpk(st.o1[4 * g] * inv, st.o1[4 * g + 1] * inv) | ((unsigned long long)cvtpk(st.o1[4 * g + 2] * inv, st.o1[4 * g + 3] * inv) << 32);
        *(unsigned long long*)(yrow + 8 * g + 4 * hi) = w0; *(unsigned long long*)(yrow + 32 + 8 * g + 4 * hi) = w1; }
}
__device__ __forceinline__ unsigned moba_select(const bf16x8 (&qf)[4], const float* kms, int b, int h, int blk, int r32, int hi, unsigned& picks) {
    f32x16 gt;
#pragma unroll
    for (int r = 0; r < 16; ++r) gt[r] = 0.f;
    { const float* kp = kms + ((size_t)((b * 16 + (r32 & 15)) * 4 + h)) * 64 + 8 * hi;
#pragma unroll
      for (int d0 = 0; d0 < 4; ++d0) { const f32x4 a = *(const f32x4*)(kp + 16 * d0) * (1.0f / 256.0f), c = *(const f32x4*)(kp + 16 * d0 + 4) * (1.0f / 256.0f);
          v4u hw, lw; hw.x = cvtpk(a.x, a.y); hw.y = cvtpk(a.z, a.w); hw.z = cvtpk(c.x, c.y); hw.w = cvtpk(c.z, c.w);
          lw.x = cvtpk(a.x - blo(hw.x), a.y - bhi(hw.x)); lw.y = cvtpk(a.z - blo(hw.y), a.w - bhi(hw.y)); lw.z = cvtpk(c.x - blo(hw.z), c.y - bhi(hw.z)); lw.w = cvtpk(c.z - blo(hw.w), c.w - bhi(hw.w));
          gt = ATT_MFMA(__builtin_bit_cast(bf16x8, hw), qf[d0], gt); gt = ATT_MFMA(__builtin_bit_cast(bf16x8, lw), qf[d0], gt); } }
    float og[8];
#pragma unroll
    for (int r = 0; r < 8; ++r) og[r] = __shfl_xor(gt[r], 32);
    float G[16];
#pragma unroll
    for (int n = 0; n < 16; ++n) { const int rn = (n & 3) + 4 * (n >> 3); G[n] = (((n >> 2) & 1) == hi) ? gt[rn] : og[rn]; }
    unsigned selmask = 0u; picks = 0xfffu;
#pragma unroll
    for (int s = 0; s < 3; ++s) { float bv = -INFINITY; int best = -1;
#pragma unroll
        for (int n = 0; n < 16; ++n) { if (n < blk && !((selmask >> n) & 1u) && G[n] > bv) { bv = G[n]; best = n; } }
        if (best >= 0) { selmask |= 1u << best; picks = (picks & ~(15u << (4 * s))) | ((unsigned)best << (4 * s)); } }
    return selmask;
}
}

constexpr size_t WS_PAO = 248 * MiB, WS_PAM = 54 * MiB, WS_PAL = 54 * MiB + 256 * 1024;
namespace attc {
constexpr int KROW = 144, VROWC = 192;
constexpr int KT_BYTES = 128 * KROW, VT_BYTES_C = 128 * VROWC, STAGE = KT_BYTES + VT_BYTES_C;
}
__device__ __forceinline__ void mixA1_coop(Frame& F) {
    using namespace att;
    unsigned char* ws = ARGWS();
    const bf16* proj = (const bf16*)(ws + WS_PROJ); bf16* pao = (bf16*)(ws + WS_PAO); float* pam = (float*)(ws + WS_PAM); float* pal = (float*)(ws + WS_PAL);
    const int lane = F.lane, r32 = lane & 31, hi = lane >> 5, w = F.wave, tid = F.tid;
    LAS unsigned char* L0 = F.lds + RING_OFF;
    const int bh = F.vcu >> 4, qb = F.vcu & 15, b = bh >> 2, h = bh & 3, rowb = b * SEQ, t0 = 256 * qb, tq = t0 + 32 * w + r32;
    const float ns = 8.0f * exp2f(-(float)(2 * h + 1));
    const bf16* Kg = proj + (size_t)rowb * NPROJ + OFF_KA + h * 64; const bf16* Vg = proj + (size_t)rowb * NPROJ + OFF_VA + h * 64;
    const int lrow0 = tid >> 3, lch = tid & 7;
    const int koff = lrow0 * attc::KROW + 16 * lch, voff = attc::KT_BYTES + lrow0 * attc::VROWC + 16 * lch;
    const int kfo = r32 * attc::KROW + 16 * hi;
    const int vfo = attc::KT_BYTES + (4 * hi + ((lane & 15) >> 2)) * attc::VROWC + (((lane >> 4) & 1) * 16 + (lane & 3) * 4) * 2;
    f32x16 b0, b1; bias_vecs<1>(b0, b1, ns);
    bf16x8 qf[4]; load_q(qf, proj + (size_t)(rowb + tq) * NPROJ + OFF_QA + h * 64, hi);
    St st; st_init(st);
    const int s_lo = (qb == 0) ? 1 : 0;
    v4u kr[2], vr[2];
#define MA_LOAD(s) do { _Pragma("unroll") for (int j = 0; j < 2; ++j) { const size_t o_ = (size_t)(t0 - 128 + 128 * (s) + 64 * j + lrow0) * NPROJ + 8 * lch; kr[j] = *(const v4u*)(Kg + o_); vr[j] = *(const v4u*)(Vg + o_); } } while (0)
#define MA_STORE(buf) do { LAS unsigned char* sb_ = L0 + (buf) * attc::STAGE; _Pragma("unroll") for (int j = 0; j < 2; ++j) { *(LAS v4u*)(sb_ + koff + 64 * j * attc::KROW) = kr[j]; *(LAS v4u*)(sb_ + voff + 64 * j * attc::VROWC) = vr[j]; } } while (0)
    __syncthreads();
    MA_LOAD(2); MA_STORE(0); MA_LOAD(1);
#pragma unroll 1
    for (int i = 0; i < 3 - s_lo; ++i) {
        const int s = 2 - i;
        __syncthreads();
        if (s - 1 >= s_lo) { MA_STORE((i + 1) & 1); if (s - 2 >= s_lo) MA_LOAD(s - 2); }
        LAS unsigned char* sb = L0 + (i & 1) * attc::STAGE;
#pragma unroll
        for (int u = 1; u >= 0; --u) {
            const int ta = t0 - 128 + 128 * s + 64 * u;
            if (ta <= t0 + 32 * w + 31 && ta + 63 >= t0 + 32 * w - 128) {
                bf16x8 kf[2][4];
#pragma unroll
                for (int sub = 0; sub < 2; ++sub)
#pragma unroll
                    for (int d0 = 0; d0 < 4; ++d0) kf[sub][d0] = *(const LAS bf16x8*)(sb + kfo + (64 * u + 32 * sub) * attc::KROW + 32 * d0);
                f32x16 s0 = b0, s1 = b1;
#pragma unroll
                for (int d0 = 0; d0 < 4; ++d0) { s0 = ATT_MFMA(kf[0][d0], qf[d0], s0); s1 = ATT_MFMA(kf[1][d0], qf[d0], s1); }
                const int tk0 = ta + 4 * hi;
                tile_core<1, 1, attc::VROWC>(st, s0, s1, ns * (float)tk0, true, tq - tk0, tq < 128 ? tq : 128, sb + vfo + 64 * u * attc::VROWC);
            }
        }
    }
#undef MA_LOAD
#undef MA_STORE
    const float lt = half_sum(st.l), inv = 1.0f / lt;
    bf16* orow = pao + ((size_t)(rowb + tq) * 4 + h) * 64;
#pragma unroll
    for (int g = 0; g < 4; ++g) {
        unsigned long long w0 = (unsigned long long)cvtpk(st.o0[4 * g] * inv, st.o0[4 * g + 1] * inv) | ((unsigned long long)cvtpk(st.o0[4 * g + 2] * inv, st.o0[4 * g + 3] * inv) << 32);
        unsigned long long w1 = (unsigned long long)cvtpk(st.o1[4 * g] * inv, st.o1[4 * g + 1] * inv) | ((unsigned long long)cvtpk(st.o1[4 * g + 2] * inv, st.o1[4 * g + 3] * inv) << 32);
        *(unsigned long long*)(orow + 8 * g + 4 * hi) = w0; *(unsigned long long*)(orow + 32 + 8 * g + 4 * hi) = w1; }
    if (hi == 0) { pam[(size_t)(rowb + tq) * 4 + h] = st.m; pal[(size_t)(rowb + tq) * 4 + h] = lt; }
    __syncthreads();
}
__device__ __forceinline__ void mixA23_mfma(Frame& F) {
    unsigned char* ws = ARGWS();
    const bf16* proj = (const bf16*)(ws + WS_PROJ); bf16* y = (bf16*)(ws + WS_Y);
    const bf16* pao = (const bf16*)(ws + WS_PAO); const float* pam = (const float*)(ws + WS_PAM); const float* pal = (const float*)(ws + WS_PAL);
    const int lane = F.lane, r32 = lane & 31, hi = lane >> 5, w = F.wave;
    LAS unsigned char* vl = F.lds + RING_OFF + w * att::VT_BYTES;
    const int gw = F.vcu * NWAVES + w;
    const int bh = gw >> 7, r16 = (gw >> 3) & 15, ig = gw & 7;
    const int b = bh >> 2, h = bh & 3, rowb = b * SEQ, tq0 = r16 + 512 * ig, tq = tq0 + 16 * r32;
    bf16x8 qf[4]; att::load_q(qf, proj + (size_t)(rowb + tq) * NPROJ + OFF_QA + h * 64, hi);
    att::St st; att::st_init(st);
    const float ns = 8.0f * exp2f(-(float)(2 * h + 1));
    const unsigned char* Kb = (const unsigned char*)(proj + (size_t)rowb * NPROJ + OFF_KA + h * 64); const unsigned char* Vb = (const unsigned char*)(proj + (size_t)rowb * NPROJ + OFF_VA + h * 64);
    att::run<4>(st, qf, Kb, Vb, tq0 - 512, 4, tq, tq < 512 ? tq : 512, ns, vl, lane);
    att::run<16>(st, qf, Kb, Vb, tq0 - 2048, 3, tq, tq < 2048 ? tq : 2048, ns, vl, lane);
    const size_t pidx = (size_t)(rowb + tq) * 4 + h;
    const float m1 = pam[pidx], l1 = pal[pidx], l2 = att::half_sum(st.l), mm = fmaxf(st.m, m1);
    const float a2 = __builtin_amdgcn_exp2f(att::C2 * (st.m - mm)), a1 = __builtin_amdgcn_exp2f(att::C2 * (m1 - mm)) * l1;
    const float inv = 1.0f / (l2 * a2 + a1);
    const bf16* orow = pao + pidx * 64; bf16* yrow = y + (size_t)(rowb + tq) * DM + h * 64;
#pragma unroll
    for (int g = 0; g < 4; ++g) {
        const unsigned long long p0 = *(const unsigned long long*)(orow + 8 * g + 4 * hi), p1 = *(const unsigned long long*)(orow + 32 + 8 * g + 4 * hi);
        const float q0[4] = {blo((unsigned)p0), bhi((unsigned)p0), blo((unsigned)(p0 >> 32)), bhi((unsigned)(p0 >> 32))};
        const float q1[4] = {blo((unsigned)p1), bhi((unsigned)p1), blo((unsigned)(p1 >> 32)), bhi((unsigned)(p1 >> 32))};
        float r0[4], r1[4];
#pragma unroll
        for (int e = 0; e < 4; ++e) { r0[e] = (st.o0[4 * g + e] * a2 + q0[e] * a1) * inv; r1[e] = (st.o1[4 * g + e] * a2 + q1[e] * a1) * inv; }
        *(unsigned long long*)(yrow + 8 * g + 4 * hi) = (unsigned long long)att::cvtpk(r0[0], r0[1]) | ((unsigned long long)att::cvtpk(r0[2], r0[3]) << 32);
        *(unsigned long long*)(yrow + 32 + 8 * g + 4 * hi) = (unsigned long long)att::cvtpk(r1[0], r1[1]) | ((unsigned long long)att::cvtpk(r1[2], r1[3]) << 32); }
}
constexpr size_t WS_MCNT = 768 * 1024;
constexpr size_t WS_MLIST = 51 * MiB + 512 * 1024;
constexpr size_t WS_MPM = 52 * MiB + 512 * 1024, WS_MPL = 53 * MiB + 256 * 1024;
__device__ __forceinline__ int moba_list_base(int b, int h, int j) { return (b * 4 + h) * 30720 + 256 * (15 * j - ((j * (j - 1)) >> 1)); }
__device__ __forceinline__ void moba_build(Frame& F, int l) {
    using namespace att;
    unsigned char* ws = ARGWS();
    const bf16* proj = (const bf16*)(ws + WS_PROJ); const float* kms = (const float*)(ws + WS_KMS) + (size_t)l * (BATCH * 16 * 4 * 64);
    unsigned* cnt = (unsigned*)(ws + WS_MCNT) + l * 256; unsigned short* list = (unsigned short*)(ws + WS_MLIST);
    const int lane = F.lane, r32 = lane & 31, hi = lane >> 5, w = F.wave;
    const int bh = F.vcu >> 4, blk = F.vcu & 15, b = bh >> 2, h = bh & 3, rowb = b * SEQ, tq = 256 * blk + 32 * w + r32;
    if (blk == 0) return;
    bf16x8 qf[4]; load_q(qf, proj + (size_t)(rowb + tq) * NPROJ + OFF_QC + h * 64, hi);
    unsigned picks; (void)moba_select(qf, kms, b, h, blk, r32, hi, picks);
    const int p0 = picks & 15, p1 = (picks >> 4) & 15, p2 = (picks >> 8) & 15;
    unsigned cntv = 0u;
#pragma unroll 1
    for (int j = 0; j < blk; ++j) { const bool pr = (hi == 0) && (p0 == j || p1 == j || p2 == j); const unsigned long long bal = __ballot(pr); if (lane == j) cntv = (unsigned)__popcll(bal); }
    unsigned basev = 0u;
    if (lane < 15 && cntv > 0u) basev = atomicAdd(cnt + (b * 4 + h) * 16 + lane, cntv);
#pragma unroll 1
    for (int j = 0; j < blk; ++j) { {
        const bool pr = (hi == 0) && (p0 == j || p1 == j || p2 == j); const unsigned long long bal = __ballot(pr);
        if (bal) { const unsigned bj = (unsigned)__shfl((int)basev, j);
            if (pr) { const unsigned pos = bj + (unsigned)__popcll(bal & ((1ull << lane) - 1ull)); const unsigned slot = (p0 == j) ? 0u : (p1 == j) ? 1u : 2u;
                list[moba_list_base(b, h, j) + pos] = (unsigned short)((unsigned)tq | (slot << 12)); } } } }
}
__device__ __forceinline__ void moba_lists(Frame& F, int l) {
    using namespace att;
    unsigned char* ws = ARGWS();
    const bf16* proj = (const bf16*)(ws + WS_PROJ);
    const unsigned* cnt = (const unsigned*)(ws + WS_MCNT) + l * 256; const unsigned short* list = (const unsigned short*)(ws + WS_MLIST);
    unsigned char* PB = (l == 0) ? (unsigned char*)ARGOUT() : ws + WS_W;
    float* pm = (float*)(ws + WS_MPM); float* pl = (float*)(ws + WS_MPL);
    asm volatile("" : "+v"(pm), "+v"(pl), "+v"(PB));
    const int lane = F.lane, r32 = lane & 31, hi = lane >> 5, w = F.wave, tid = F.tid;
    LAS unsigned char* L0 = F.lds + RING_OFF;
    constexpr int KB_BYTES = 256 * attc::KROW, VB_BYTES = 256 * attc::VROWC;
    LAS unsigned* cin = (LAS unsigned*)(L0 + KB_BYTES + VB_BYTES); LAS unsigned* pre = cin + 256;
    __syncthreads();
    unsigned cmine = 0u, cinc = 0u;
    constexpr unsigned SEGW = 256u;
    if (tid < 256) { cmine = cnt[tid]; cmine = cmine ? cmine + SEGW : 0u; cinc = cmine;
#pragma unroll
        for (int o = 1; o < 64; o <<= 1) { const unsigned t_ = (unsigned)__shfl_up((int)cinc, o); if (lane >= o) cinc += t_; }
        if (lane == 63) cin[w] = cinc; }
    __syncthreads();
    if (tid < 256) { unsigned off = 0u;
#pragma unroll
        for (int i = 0; i < 3; ++i) if (i < w) off += cin[i];
        pre[tid] = off + cinc - cmine; if (tid == 255) pre[256] = off + cinc; }
    __syncthreads();
    const unsigned T = pre[256];
    const unsigned lo = (unsigned)(((unsigned long long)T * (unsigned)F.vcu) >> 8), hi_ = (unsigned)(((unsigned long long)T * (unsigned)(F.vcu + 1)) >> 8);
    LAS unsigned* lrng = pre + 260;
    if (tid == 0) { lrng[0] = 256u; lrng[1] = 0u; }
    __syncthreads();
    if (tid < 256) { const unsigned sL = pre[tid] + SEGW, eL = pre[tid + 1]; if (eL > sL && sL < hi_ && eL > lo) { atomicMin((unsigned*)lrng, (unsigned)tid); atomicMax((unsigned*)lrng + 1, (unsigned)tid); } }
    __syncthreads();
    const int Lfirst = (int)lrng[0], Llast = (int)lrng[1];
    const int kfo = r32 * attc::KROW + 16 * hi;
    const int vfo = KB_BYTES + (4 * hi + ((lane & 15) >> 2)) * attc::VROWC + (((lane >> 4) & 1) * 16 + (lane & 3) * 4) * 2;
#pragma unroll 1
    for (int L = Lfirst; L <= Llast; ++L) {
        const unsigned sL = pre[L] + SEGW, eL = pre[L + 1]; const unsigned a = lo > sL ? lo : sL, e = hi_ < eL ? hi_ : eL;
        if (a >= e) continue;
        const int bh = L >> 4, j = L & 15, b = bh >> 2, h = bh & 3, rowb = b * SEQ;
        const float ns = 8.0f * exp2f(-(float)(2 * h + 2));
        const int lb = moba_list_base(b, h, j) - (int)sL;
        const int nt = (int)((e - a + 31u) >> 5);
        unsigned ent_n = 0u;
        if (w < nt) { const unsigned idx0 = a + 32u * (unsigned)w + (unsigned)r32; ent_n = list[lb + (int)(idx0 < e ? idx0 : a)]; }
        __syncthreads();
        { const bf16* Kg = proj + (size_t)(rowb + 256 * j) * NPROJ + OFF_KC + h * 64; const bf16* Vg = proj + (size_t)(rowb + 256 * j) * NPROJ + OFF_VC + h * 64;
          v4u kr[4], vr[4];
#pragma unroll
          for (int i = 0; i < 4; ++i) { const int c = tid + 512 * i, row = c >> 3, ch = c & 7; kr[i] = *(const v4u*)(Kg + (size_t)row * NPROJ + 8 * ch); vr[i] = *(const v4u*)(Vg + (size_t)row * NPROJ + 8 * ch); }
#pragma unroll
          for (int i = 0; i < 4; ++i) { const int c = tid + 512 * i, row = c >> 3, ch = c & 7; *(LAS v4u*)(L0 + row * attc::KROW + 16 * ch) = kr[i]; *(LAS v4u*)(L0 + KB_BYTES + row * attc::VROWC + 16 * ch) = vr[i]; } }
        __syncthreads();
#pragma unroll 1
        for (int t = w; t < nt; t += NWAVES) {
            const unsigned idx = a + 32u * (unsigned)t + (unsigned)r32; const bool valid = idx < e;
            const unsigned ent = ent_n; const int tq = (int)(ent & 4095u); const unsigned slot = ent >> 12;
            bf16x8 qf[4]; load_q(qf, proj + (size_t)(rowb + tq) * NPROJ + OFF_QC + h * 64, hi);
            if (t + NWAVES < nt) { const unsigned idx1 = idx + 32u * NWAVES; ent_n = list[lb + (int)(idx1 < e ? idx1 : a)]; }
            St st; st_init(st);
#pragma unroll 1
            for (int kt = 3; kt >= 0; --kt) {
                bf16x8 kf[2][4];
#pragma unroll
                for (int sub = 0; sub < 2; ++sub)
#pragma unroll
                    for (int d0 = 0; d0 < 4; ++d0) kf[sub][d0] = *(const LAS bf16x8*)(L0 + kfo + (64 * kt + 32 * sub) * attc::KROW + 32 * d0);
                f32x16 s0, s1; bias_vecs<1>(s0, s1, ns);
#pragma unroll
                for (int d0 = 0; d0 < 4; ++d0) { s0 = ATT_MFMA(kf[0][d0], qf[d0], s0); s1 = ATT_MFMA(kf[1][d0], qf[d0], s1); }
                tile_core<0, 1, attc::VROWC>(st, s0, s1, ns * (float)(256 * j + 64 * kt + 4 * hi), valid, 0, 0, L0 + vfo + 64 * kt * attc::VROWC);
            }
            const float lt = half_sum(st.l), inv = 1.0f / lt;
            if (valid) {
                const size_t pidx = (size_t)(rowb + tq) * 4 + h;
                bf16* orow = (bf16*)(PB + (size_t)slot * (8 * MiB)) + pidx * 64;
#pragma unroll
                for (int g = 0; g < 4; ++g) {
                    unsigned long long w0 = (unsigned long long)cvtpk(st.o0[4 * g] * inv, st.o0[4 * g + 1] * inv) | ((unsigned long long)cvtpk(st.o0[4 * g + 2] * inv, st.o0[4 * g + 3] * inv) << 32);
                    unsigned long long w1 = (unsigned long long)cvtpk(st.o1[4 * g] * inv, st.o1[4 * g + 1] * inv) | ((unsigned long long)cvtpk(st.o1[4 * g + 2] * inv, st.o1[4 * g + 3] * inv) << 32);
                    *(unsigned long long*)(orow + 8 * g + 4 * hi) = w0; *(unsigned long long*)(orow + 32 + 8 * g + 4 * hi) = w1; }
                if (hi == 0) { pm[(size_t)slot * (M * 4) + pidx] = st.m; pl[(size_t)slot * (M * 4) + pidx] = lt; }
            }
        }
    }
    __syncthreads();
}
__device__ __forceinline__ void moba_own256_merge(Frame& F, int l) {
    using namespace att;
    unsigned char* ws = ARGWS();
    const bf16* proj = (const bf16*)(ws + WS_PROJ); bf16* y = (bf16*)(ws + WS_Y);
    const unsigned char* PB = (l == 0) ? (const unsigned char*)ARGOUT() : ws + WS_W;
    const float* pm = (const float*)(ws + WS_MPM); const float* pl = (const float*)(ws + WS_MPL);
    const int lane = F.lane, r32 = lane & 31, hi = lane >> 5, w = F.wave, tid = F.tid;
    LAS unsigned char* L0 = F.lds + RING_OFF;
    constexpr int KB_BYTES = 256 * attc::KROW;
    const int bh = F.vcu >> 4, blk = F.vcu & 15, b = bh >> 2, h = bh & 3, rowb = b * SEQ, tq = 256 * blk + 32 * w + r32;
    const float ns = 8.0f * exp2f(-(float)(2 * h + 2));
    const int kfo = r32 * attc::KROW + 16 * hi;
    const int vfo = KB_BYTES + (4 * hi + ((lane & 15) >> 2)) * attc::VROWC + (((lane >> 4) & 1) * 16 + (lane & 3) * 4) * 2;
    bf16x8 qf[4]; load_q(qf, proj + (size_t)(rowb + tq) * NPROJ + OFF_QC + h * 64, hi);
    __syncthreads();
    { const bf16* Kg = proj + (size_t)(rowb + 256 * blk) * NPROJ + OFF_KC + h * 64; const bf16* Vg = proj + (size_t)(rowb + 256 * blk) * NPROJ + OFF_VC + h * 64;
      v4u kr[4], vr[4];
#pragma unroll
      for (int i = 0; i < 4; ++i) { const int c = tid + 512 * i, row = c >> 3, ch = c & 7; kr[i] = *(const v4u*)(Kg + (size_t)row * NPROJ + 8 * ch); vr[i] = *(const v4u*)(Vg + (size_t)row * NPROJ + 8 * ch); }
#pragma unroll
      for (int i = 0; i < 4; ++i) { const int c = tid + 512 * i, row = c >> 3, ch = c & 7; *(LAS v4u*)(L0 + row * attc::KROW + 16 * ch) = kr[i]; *(LAS v4u*)(L0 + KB_BYTES + row * attc::VROWC + 16 * ch) = vr[i]; } }
    const size_t pidx = (size_t)(rowb + tq) * 4 + h; const int nsel = blk < 3 ? blk : 3;
    float mp[3], lp[3];
#pragma unroll
    for (int s = 0; s < 3; ++s) { mp[s] = -1e30f; lp[s] = 0.f; if (s < nsel) { mp[s] = pm[(size_t)s * (M * 4) + pidx]; lp[s] = pl[(size_t)s * (M * 4) + pidx]; } }
    __syncthreads();
    St st; st_init(st);
    const int ktl = w >> 1;
#pragma unroll 1
    for (int kt = ktl; kt >= 0; --kt) {
        bf16x8 kf[2][4];
#pragma unroll
        for (int sub = 0; sub < 2; ++sub)
#pragma unroll
            for (int d0 = 0; d0 < 4; ++d0) kf[sub][d0] = *(const LAS bf16x8*)(L0 + kfo + (64 * kt + 32 * sub) * attc::KROW + 32 * d0);
        f32x16 s0, s1; bias_vecs<1>(s0, s1, ns);
#pragma unroll
        for (int d0 = 0; d0 < 4; ++d0) { s0 = ATT_MFMA(kf[0][d0], qf[d0], s0); s1 = ATT_MFMA(kf[1][d0], qf[d0], s1); }
        const int tk0 = 256 * blk + 64 * kt + 4 * hi;
        if (kt == ktl) tile_core<1, 1, attc::VROWC>(st, s0, s1, ns * (float)tk0, true, tq - tk0, BIGD, L0 + vfo + 64 * kt * attc::VROWC);
        else tile_core<0, 1, attc::VROWC>(st, s0, s1, ns * (float)tk0, true, 0, 0, L0 + vfo + 64 * kt * attc::VROWC);
    }
    float mm = st.m;
#pragma unroll
    for (int s = 0; s < 3; ++s) mm = fmaxf(mm, mp[s]);
    const float a1 = __builtin_amdgcn_exp2f(C2 * (st.m - mm));
    float ap[3];
#pragma unroll
    for (int s = 0; s < 3; ++s) ap[s] = __builtin_amdgcn_exp2f(C2 * (mp[s] - mm)) * lp[s];
    const float inv = 1.0f / (half_sum(st.l) * a1 + ap[0] + ap[1] + ap[2]);
    bf16* yrow = y + (size_t)(rowb + tq) * DM + 768 + h * 64;
#pragma unroll
    for (int g = 0; g < 4; ++g) {
        float r0[4], r1[4];
#pragma unroll
        for (int e = 0; e < 4; ++e) { r0[e] = st.o0[4 * g + e] * a1; r1[e] = st.o1[4 * g + e] * a1; }
#pragma unroll
        for (int s = 0; s < 3; ++s) { if (s < nsel) {
            const bf16* orow = (const bf16*)(PB + (size_t)s * (8 * MiB)) + pidx * 64;
            const unsigned long long p0 = *(const unsigned long long*)(orow + 8 * g + 4 * hi), p1 = *(const unsigned long long*)(orow + 32 + 8 * g + 4 * hi);
            r0[0] += blo((unsigned)p0) * ap[s]; r0[1] += bhi((unsigned)p0) * ap[s]; r0[2] += blo((unsigned)(p0 >> 32)) * ap[s]; r0[3] += bhi((unsigned)(p0 >> 32)) * ap[s];
            r1[0] += blo((unsigned)p1) * ap[s]; r1[1] += bhi((unsigned)p1) * ap[s]; r1[2] += blo((unsigned)(p1 >> 32)) * ap[s]; r1[3] += bhi((unsigned)(p1 >> 32)) * ap[s]; } }
        *(unsigned long long*)(yrow + 8 * g + 4 * hi) = (unsigned long long)cvtpk(r0[0] * inv, r0[1] * inv) | ((unsigned long long)cvtpk(r0[2] * inv, r0[3] * inv) << 32);
        *(unsigned long long*)(yrow + 32 + 8 * g + 4 * hi) = (unsigned long long)cvtpk(r1[0] * inv, r1[1] * inv) | ((unsigned long long)cvtpk(r1[2] * inv, r1[3] * inv) << 32); }
    __syncthreads();
}

namespace ssd {
typedef float f32x16 __attribute__((ext_vector_type(16)));
typedef short v4i16_t __attribute__((ext_vector_type(4)));
constexpr int RS_BTR = 320, RS_XTR = 576;
constexpr int RS_ROW = 272;
constexpr int RS_XH = 192;
#define SSD_MFMA(a, b, c) __builtin_amdgcn_mfma_f32_32x32x16_bf16((a), (b), (c), 0, 0, 0)
__device__ __forceinline__ bf16x8 trpair(LAS unsigned char* p, int rs4  ) {
    const v4i16_t lo = __builtin_amdgcn_ds_read_tr16_b64_v4i16((LAS v4i16_t*)p);
    const v4i16_t hh = __builtin_amdgcn_ds_read_tr16_b64_v4i16((LAS v4i16_t*)(p + rs4));
    return __builtin_shufflevector(lo, hh, 0, 1, 2, 3, 4, 5, 6, 7);
}
__device__ __forceinline__ float chunk_acs(float d0, float d1  , float A, LAS float* acs, LAS float* dts, int lane) {
    float s0 = d0 * A, s1 = d1 * A;
#pragma unroll
    for (int o = 1; o < 64; o <<= 1) { const float t0 = __shfl_up(s0, o), t1 = __shfl_up(s1, o); if (lane >= o) { s0 += t0; s1 += t1; } }
    const float tot0 = __shfl(s0, 63); s1 += tot0;
    acs[lane] = s0; acs[64 + lane] = s1; dts[lane] = d0; dts[64 + lane] = d1;
    return __shfl(s1, 63);
}
__device__ __forceinline__ void conv_load(v4u (&raw)[11], const bf16* proj, int rowg0, bool first_chunk, int rb, int c0) {
#pragma unroll
    for (int j = 0; j < 11; ++j) { const int rr = 8 * rb - 3 + j;
        if (first_chunk && rr < 0) raw[j] = (v4u){0u, 0u, 0u, 0u}; else raw[j] = *(const v4u*)(proj + (size_t)(rowg0 + rr) * NPROJ + OFF_XBC + c0); }
}
__device__ __forceinline__ void conv_compute(const v4u (&raw)[11], const float* cw, const float* cb, int rb, int c0, LAS unsigned char* dst, int rs, const LAS float* rowscale) {
    float w[4][8], bs[8];
#pragma unroll
    for (int j = 0; j < 4; ++j) { const f32x4 a = *(const f32x4*)(cw + j * 1024 + c0), b = *(const f32x4*)(cw + j * 1024 + c0 + 4);
        w[j][0] = a.x; w[j][1] = a.y; w[j][2] = a.z; w[j][3] = a.w; w[j][4] = b.x; w[j][5] = b.y; w[j][6] = b.z; w[j][7] = b.w; }
    { const f32x4 a = *(const f32x4*)(cb + c0), b = *(const f32x4*)(cb + c0 + 4); bs[0] = a.x; bs[1] = a.y; bs[2] = a.z; bs[3] = a.w; bs[4] = b.x; bs[5] = b.y; bs[6] = b.z; bs[7] = b.w; }
#pragma unroll
    for (int r = 0; r < 8; ++r) {
        float o[8];
#pragma unroll
        for (int e = 0; e < 8; ++e) o[e] = bs[e];
#pragma unroll
        for (int j = 0; j < 4; ++j) { const v4u u = raw[r + j];
            o[0] += w[j][0] * blo(u.x); o[1] += w[j][1] * bhi(u.x); o[2] += w[j][2] * blo(u.y); o[3] += w[j][3] * bhi(u.y);
            o[4] += w[j][4] * blo(u.z); o[5] += w[j][5] * bhi(u.z); o[6] += w[j][6] * blo(u.w); o[7] += w[j][7] * bhi(u.w); }
        const float sc = rowscale ? rowscale[8 * rb + r] : 1.0f;
#pragma unroll
        for (int e = 0; e < 8; ++e) o[e] = o[e] * __builtin_amdgcn_rcpf(1.0f + __builtin_amdgcn_exp2f(-1.4426950408889634f * o[e])) * sc;
        v4u q; q.x = pk2(o[0], o[1]); q.y = pk2(o[2], o[3]); q.z = pk2(o[4], o[5]); q.w = pk2(o[6], o[7]);
        *(LAS v4u*)(dst + (8 * rb + r) * rs) = q;
    }
}
}
constexpr size_t WS_CDEC = 50 * MiB + 512 * 1024;

__device__ __forceinline__ void ssd_states(Frame& F, int l) {
    unsigned char* ws = ARGWS();
    const bf16* proj = (const bf16*)(ws + WS_PROJ); const float* dt = (const float*)(ws + WS_DT); float* states = (float*)(ws + WS_ST); float* cdec = (float*)(ws + WS_CDEC);
    const float* cw = ARGF(7) + (size_t)l * 4 * 1024; const float* cb = ARGF(8) + (size_t)l * 1024; const float* alog = ARGF(10) + l * 8;
    const int lane = F.lane, w = F.wave, tid = F.tid, hi = lane >> 5;
    LAS float* acs = (LAS float*)(F.lds + RING_OFF);
    LAS float* wl = acs + 512;
    LAS unsigned char* Bt = F.lds + RING_OFF + 4096;
    LAS unsigned char* Xt = Bt + 128 * ssd::RS_BTR;
    for (int u = F.vcu; u < BATCH * 32 * 2; u += F.G) {
        const int b = u >> 6, c = (u >> 1) & 31, g = u & 1, rowg0 = b * SEQ + c * 128;
        v4u rawx[11], rawb[11];
        ssd::conv_load(rawx, proj, rowg0, c == 0, tid >> 5, g * 256 + 8 * (tid & 31));
        if (tid < 256) ssd::conv_load(rawb, proj, rowg0, c == 0, tid >> 4, 512 + g * 128 + 8 * (tid & 15));
        float dta = 0.f, dtb = 0.f, Ah = 0.f;
        if (w < 4) { dta = dt[(size_t)(rowg0 + lane) * 8 + 4 * g + w]; dtb = dt[(size_t)(rowg0 + 64 + lane) * 8 + 4 * g + w]; Ah = alog[4 * g + w]; }
        __syncthreads();
        if (w < 4) { const int hh = 4 * g + w; const float A = -__expf(Ah);
            const float last = ssd::chunk_acs(dta, dtb, A, acs + 128 * w, wl + 128 * w, lane);
            const float a0 = acs[128 * w + lane], a1 = acs[128 * w + 64 + lane];
            wl[128 * w + lane] = wl[128 * w + lane] * __expf(last - a0); wl[128 * w + 64 + lane] = wl[128 * w + 64 + lane] * __expf(last - a1);
            if (lane == 0) cdec[(size_t)(b * 32 + c) * 8 + hh] = __expf(last); }
        __syncthreads();
        { const int rb = tid >> 5, ch = tid & 31, c0 = g * 256 + 8 * ch;
          ssd::conv_compute(rawx, cw, cb, rb, c0, Xt + 16 * ch, ssd::RS_XTR, wl + 128 * (ch >> 3)); }
        if (tid < 256) { const int rb = tid >> 4, ch = tid & 15, c0 = 512 + g * 128 + 8 * ch;
          ssd::conv_compute(rawb, cw, cb, rb, c0, Bt + 16 * ch, ssd::RS_BTR, nullptr); }
        __syncthreads();
        { const int hl = w >> 1, ph = w & 1, hh = 4 * g + hl;
          LAS unsigned char* xa = Xt + (8 * hi + ((lane & 15) >> 2)) * ssd::RS_XTR + (hl * 64 + 32 * ph + 16 * ((lane >> 4) & 1) + 4 * (lane & 3)) * 2;
          LAS unsigned char* ba = Bt + (8 * hi + ((lane & 15) >> 2)) * ssd::RS_BTR + (16 * ((lane >> 4) & 1) + 4 * (lane & 3)) * 2;
          float* sp = states + ((size_t)((b * 32 + c) * 8 + hh)) * 8192 + (size_t)(32 * ph) * 128 + (lane & 31);
#pragma unroll
          for (int nt = 0; nt < 4; ++nt) {
              ssd::f32x16 acc;
#pragma unroll
              for (int r = 0; r < 16; ++r) acc[r] = 0.f;
#pragma unroll
              for (int kk = 0; kk < 8; ++kk) {
                  const bf16x8 af = ssd::trpair(xa + 16 * kk * ssd::RS_XTR, 4 * ssd::RS_XTR);
                  const bf16x8 bfr = ssd::trpair(ba + 16 * kk * ssd::RS_BTR + 64 * nt, 4 * ssd::RS_BTR);
                  acc = SSD_MFMA(af, bfr, acc); }
#pragma unroll
              for (int r = 0; r < 16; ++r) sp[(size_t)((r & 3) + 8 * (r >> 2) + 4 * hi) * 128 + 32 * nt] = acc[r];
          } }
    }
    __syncthreads();
}
__device__ __forceinline__ void ssd_scan(Frame& F) {
    unsigned char* ws = ARGWS();
    const float* states = (const float*)(ws + WS_ST); const float* cdec = (const float*)(ws + WS_CDEC); unsigned* stb = (unsigned*)((unsigned char*)ARGOUT() + 32 * MiB);
    const int gt = F.vcu * (NWAVES * 64) + F.tid;
    if (gt < BATCH * 8 * 4096) {
        const int b = gt >> 15, h = (gt >> 12) & 7, e = gt & 4095;
        typedef float f32x2 __attribute__((ext_vector_type(2)));
        f32x2 v[32]; float dc[32];
#pragma unroll
        for (int c = 0; c < 32; ++c) { v[c] = *(const f32x2*)(states + ((size_t)((b * 32 + c) * 8 + h)) * 8192 + 2 * e); dc[c] = cdec[(size_t)(b * 32 + c) * 8 + h]; }
        f32x2 run = {0.f, 0.f};
#pragma unroll
        for (int c = 0; c < 32; ++c) { const f32x2 t = v[c]; stb[((size_t)((b * 32 + c) * 8 + h)) * 4096 + e] = pk2(run.x, run.y); run = run * dc[c] + t; }
    }
}
__device__ __forceinline__ void ssd_out(Frame& F, int l) {
    unsigned char* ws = ARGWS();
    const bf16* proj = (const bf16*)(ws + WS_PROJ); const float* dt = (const float*)(ws + WS_DT); const bf16* stb = (const bf16*)((unsigned char*)ARGOUT() + 32 * MiB); bf16* y = (bf16*)(ws + WS_Y);
    const float* cw = ARGF(7) + (size_t)l * 4 * 1024; const float* cb = ARGF(8) + (size_t)l * 1024; const float* alog = ARGF(10) + l * 8;
    const float* dsk = ARGF(11) + l * 8; const float* nw = ARGF(12) + (size_t)l * 512;
    const int lane = F.lane, w = F.wave, tid = F.tid, hi = lane >> 5, r32 = lane & 31;
    LAS float* acs = (LAS float*)(F.lds + RING_OFF);
    LAS float* dts = acs + 512;
    LAS float* rss = dts + 512;
    LAS unsigned* CBT = (LAS unsigned*)(F.lds + RING_OFF + 8192);
    LAS unsigned char* Ct = F.lds + RING_OFF + 8192 + 20480;
    LAS unsigned char* Bt = Ct + 128 * ssd::RS_ROW;
    LAS unsigned char* Xh = Bt;
    static_assert(8192 + 20480 + 128 * ssd::RS_ROW + 128 * ssd::RS_XTR <= RING_BYTES, "stage Z LDS map");
    const int wq = w & 3, pt = w >> 2;
    for (int u = F.vcu; u < BATCH * 32 * 2; u += F.G) {
        const int b = u >> 6, c = (u >> 1) & 31, g = u & 1, rowg0 = b * SEQ + c * 128;
        v4u rawbc[11], rawx[11];
        ssd::conv_load(rawbc, proj, rowg0, c == 0, (tid & 255) >> 4, 512 + (tid >> 8) * 256 + g * 128 + 8 * (tid & 15));
        ssd::conv_load(rawx, proj, rowg0, c == 0, tid >> 5, g * 256 + 8 * (tid & 31));
        float dta = 0.f, dtb = 0.f, Ah = 0.f;
        if (w < 4) { dta = dt[(size_t)(rowg0 + lane) * 8 + 4 * g + w]; dtb = dt[(size_t)(rowg0 + 64 + lane) * 8 + 4 * g + w]; Ah = alog[4 * g + w]; }
        __syncthreads();
        if (tid < 128) rss[tid] = 0.f;
        if (w < 4) { const float A = -__expf(Ah); (void)ssd::chunk_acs(dta, dtb, A, acs + 128 * w, dts + 128 * w, lane); }
        { const int rb = (tid & 255) >> 4, ch = tid & 15, which = tid >> 8, c0 = 512 + which * 256 + g * 128 + 8 * ch;
          ssd::conv_compute(rawbc, cw, cb, rb, c0, (which ? Ct : Bt) + 16 * ch, ssd::RS_ROW, nullptr); }
        __syncthreads();
#pragma unroll 1
        for (int id = w; id < 10; id += NWAVES) {
            const int tl = (id >= 6) ? 3 : (id >= 3) ? 2 : (id >= 1) ? 1 : 0, ts = id - ((tl * (tl + 1)) >> 1);
            ssd::f32x16 t16;
#pragma unroll
            for (int r = 0; r < 16; ++r) t16[r] = 0.f;
#pragma unroll
            for (int k0 = 0; k0 < 8; ++k0) { const bf16x8 bfr = *(const LAS bf16x8*)(Bt + (32 * ts + r32) * ssd::RS_ROW + (16 * k0 + 8 * hi) * 2);
                const bf16x8 cfr = *(const LAS bf16x8*)(Ct + (32 * tl + r32) * ssd::RS_ROW + (16 * k0 + 8 * hi) * 2);
                t16 = SSD_MFMA(bfr, cfr, t16); }
#pragma unroll
            for (int q = 0; q < 8; ++q) CBT[(id * 8 + q) * 64 + lane] = att::cvtpk(t16[2 * q], t16[2 * q + 1]);
        }
        __syncthreads();
        { const int rb = tid >> 5, ch = tid & 31; ssd::conv_compute(rawx, cw, cb, rb, g * 256 + 8 * ch, Xh + 16 * ch, ssd::RS_XTR, nullptr); }
        __syncthreads();
        unsigned dmask = 0u;
#pragma unroll
        for (int r = 0; r < 16; ++r) dmask |= ((((r & 3) + 8 * (r >> 2) + 4 * hi) <= r32) ? 1u : 0u) << r;
        asm volatile("" : "+v"(dmask));
        bf16x8 sfr[8];
#pragma unroll
        for (int k0 = 0; k0 < 8; ++k0) sfr[k0] = *(const bf16x8*)(stb + ((size_t)((b * 32 + c) * 8 + 4 * g)) * 8192 + (size_t)(32 * pt + r32) * 128 + 8 * hi + 16 * k0);
        ssd::f32x16 yg0, yg1, yg2, yg3;
#pragma unroll
        for (int hl = 0; hl < 4; ++hl) {
            const int hh = 4 * g + hl, lt = (wq + hl) & 3, lrow = 32 * lt + r32;
            bf16x8 cf[8];
#pragma unroll
            for (int k0 = 0; k0 < 8; ++k0) cf[k0] = *(const LAS bf16x8*)(Ct + lrow * ssd::RS_ROW + (16 * k0 + 8 * hi) * 2);
            ssd::f32x16 acc;
#pragma unroll
            for (int r = 0; r < 16; ++r) acc[r] = 0.f;
#pragma unroll
            for (int k0 = 0; k0 < 8; ++k0) acc = SSD_MFMA(sfr[k0], cf[k0], acc);
            if (hl < 3) {
#pragma unroll
                for (int k0 = 0; k0 < 8; ++k0) sfr[k0] = *(const bf16x8*)(stb + ((size_t)((b * 32 + c) * 8 + hh + 1)) * 8192 + (size_t)(32 * pt + r32) * 128 + 8 * hi + 16 * k0); }
            const float al = acs[128 * hl + lrow]; const float el = __expf(al);
#pragma unroll
            for (int r = 0; r < 16; ++r) acc[r] *= el;
            LAS unsigned char* xa = Xh + (4 * hi + ((lane & 15) >> 2)) * ssd::RS_XTR + (hl * 64 + 32 * pt + 16 * ((lane >> 4) & 1) + 4 * (lane & 3)) * 2;
            const int tid0 = (lt * (lt + 1)) >> 1;
#pragma unroll
            for (int st = 0; st < 4; ++st) { if (st <= lt) {
                float sc[16];
#pragma unroll
                for (int g4 = 0; g4 < 4; ++g4) { const int s0 = 32 * st + 8 * g4 + 4 * hi;
                    const f32x4 as = *(const LAS f32x4*)(acs + 128 * hl + s0), ds = *(const LAS f32x4*)(dts + 128 * hl + s0);
                    const unsigned c01 = CBT[((tid0 + st) * 8 + 2 * g4) * 64 + lane], c23 = CBT[((tid0 + st) * 8 + 2 * g4 + 1) * 64 + lane];
                    const float cv[4] = {blo(c01), bhi(c01), blo(c23), bhi(c23)};
#pragma unroll
                    for (int e = 0; e < 4; ++e) sc[4 * g4 + e] = cv[e] * __expf(fminf(al - as[e], 0.f)) * ds[e]; }
                if (st == lt) {
#pragma unroll
                    for (int r = 0; r < 16; ++r) sc[r] = ((dmask >> r) & 1u) ? sc[r] : 0.f; }
#pragma unroll
                for (int s2 = 0; s2 < 2; ++s2) { v4u pw; pw.x = att::cvtpk(sc[8 * s2], sc[8 * s2 + 1]); pw.y = att::cvtpk(sc[8 * s2 + 2], sc[8 * s2 + 3]); pw.z = att::cvtpk(sc[8 * s2 + 4], sc[8 * s2 + 5]); pw.w = att::cvtpk(sc[8 * s2 + 6], sc[8 * s2 + 7]);
                    const bf16x8 xf = ssd::trpair(xa + (32 * st + 16 * s2) * ssd::RS_XTR, 8 * ssd::RS_XTR);
                    acc = SSD_MFMA(xf, __builtin_bit_cast(bf16x8, pw), acc); } } }
            const float Dk = dsk[hh]; float ssq = 0.f; ssd::f32x16 yv16;
#pragma unroll
            for (int g4 = 0; g4 < 4; ++g4) { float yv[4]; const unsigned long long zz = *(const unsigned long long*)(proj + (size_t)(rowg0 + lrow) * NPROJ + OFF_Z + hh * 64 + 32 * pt + 4 * hi + 8 * g4);
                const unsigned long long xx = *(const LAS unsigned long long*)(Xh + lrow * ssd::RS_XTR + (hl * 64 + 32 * pt + 8 * g4 + 4 * hi) * 2);
                const float zf[4] = {blo((unsigned)zz), bhi((unsigned)zz), blo((unsigned)(zz >> 32)), bhi((unsigned)(zz >> 32))};
                const float xf[4] = {blo((unsigned)xx), bhi((unsigned)xx), blo((unsigned)(xx >> 32)), bhi((unsigned)(xx >> 32))};
#pragma unroll
                for (int e = 0; e < 4; ++e) { const float v = (acc[4 * g4 + e] + Dk * xf[e]) * (zf[e] * __builtin_amdgcn_rcpf(1.0f + __builtin_amdgcn_exp2f(-1.4426950408889634f * zf[e]))); yv[e] = v; ssq += v * v; yv16[4 * g4 + e] = v; } }
            if (hl == 0) yg0 = yv16; else if (hl == 1) yg1 = yv16; else if (hl == 2) yg2 = yv16; else yg3 = yv16;
            ssq += __shfl_xor(ssq, 32);
            if (hi == 0) (void)__hip_atomic_fetch_add(rss + lrow, ssq, __ATOMIC_RELAXED, __HIP_MEMORY_SCOPE_WORKGROUP);
        }
        __syncthreads();
#pragma unroll
        for (int hl = 0; hl < 4; ++hl) {
            const int lrow = 32 * ((wq + hl) & 3) + r32;
            const float rstd = 1.0f / sqrtf(rss[lrow] * (1.0f / 256.0f) + EPS);
            bf16* yr = y + (size_t)(rowg0 + lrow) * DM + 256 + g * 256 + hl * 64 + 32 * pt + 4 * hi;
            const float* nwp = nw + g * 256 + hl * 64 + 32 * pt + 4 * hi;
            const ssd::f32x16 yv = (hl == 0) ? yg0 : (hl == 1) ? yg1 : (hl == 2) ? yg2 : yg3;
#pragma unroll
            for (int g4 = 0; g4 < 4; ++g4) { const f32x4 wv = *(const f32x4*)(nwp + 8 * g4);
                *(unsigned long long*)(yr + 8 * g4) = (unsigned long long)att::cvtpk(yv[4 * g4] * rstd * wv.x, yv[4 * g4 + 1] * rstd * wv.y) | ((unsigned long long)att::cvtpk(yv[4 * g4 + 2] * rstd * wv.z, yv[4 * g4 + 3] * rstd * wv.w) << 32); } }
    }
    __syncthreads();
}

constexpr int PH_PER_LAYER = 7, N_PHASES = 1 + DEPTH * PH_PER_LAYER;
#define IN(k) (lo <= (k) && (k) < hi)
#define FRESH() do { asm volatile("" : "+s"(F.wave), "+s"(F.vcu), "+s"(F.G)); F.lane = lane_id(); asm volatile("" : "+v"(F.lane)); F.tid = F.wave * 64 + F.lane; bx = (int)blockIdx.x; asm volatile("" : "+s"(bx)); } while (0)
#define SEAM(k) do { if (IN(k) && IN((k) + 1)) { int w0_ = F.wave; asm volatile("" : "+s"(w0_)); xcd_barrier(bar, w0_ == 0 && lane_id() == 0); } } while (0)

template <int l> __device__ __forceinline__ void layer_phases(Frame& F, const int lo, const int hi, const XcdBarrier& bar) {
    int bx;
        const int pb = 1 + l * PH_PER_LAYER;
        if (IN(pb + 0)) { FRESH();
            if (l > 0) { dt_rows_b(F, (const bf16*)ARGOUT(), l); FRESH(); }
            unsigned char* ws = ARGWS(); unsigned char* wb = ws + WS_W + (size_t)l * W_LAYER;
            pg8::Gemm g{l == 0 ? (const bf16*)(ws + WS_XB) : (const bf16*)ARGOUT(), (const bf16*)(wb + W_IN), M, NPROJ, DM}; pg8::StaticOrder S; S.init(M, NPROJ, F.G, bx);
            pg8::EpiProj E{(bf16*)(ws + WS_PROJ), l == 0 ? (const float*)(ws + WS_RSTD) : (const float*)(ws + WS_SSQ2), ARGF(3) + l * 64, ARGF(4) + l * 64, ARGF(5) + l * 64, ARGF(6) + l * 64, (float*)(ws + WS_KMS) + (size_t)l * (BATCH * 16 * 4 * 64)};
            pg8::gemm_phase<pg8::EpiProj, pg8::StaticOrder, true, true>(F.lds + RING_OFF, g, S, E, F.wave);
        }
        SEAM(pb + 0);
        if (IN(pb + 1)) { FRESH(); ssd_states(F, l); FRESH(); mixA1_coop(F); FRESH(); moba_build(F, l); }
        SEAM(pb + 1);
        if (IN(pb + 2)) { FRESH(); ssd_scan(F); FRESH(); moba_lists(F, l); FRESH(); mixA23_mfma(F); }
        SEAM(pb + 2);
        if (IN(pb + 3)) { FRESH(); ssd_out(F, l); FRESH(); moba_own256_merge(F, l); }
        SEAM(pb + 3);
        if (IN(pb + 4)) { FRESH();
            unsigned char* ws = ARGWS(); unsigned char* wb = ws + WS_W + (size_t)l * W_LAYER; float* out = ARGOUT();
            pg8::Gemm g{(const bf16*)(ws + WS_Y), (const bf16*)(wb + W_OUT), M, DM, DM}; pg8::StaticOrder S; S.init(M, DM, F.G, bx);
            pg8::EpiRes1 E{l == 0 ? (const bf16*)(ws + WS_XB) : (const bf16*)out, (bf16*)(ws + WS_XB), (float*)(ws + WS_SSQ) + (size_t)l * M};
            pg8::gemm_phase<pg8::EpiRes1, pg8::StaticOrder, true, false>(F.lds + RING_OFF, g, S, E, F.wave);
        }
        SEAM(pb + 4);
        if (IN(pb + 5)) { FRESH();
            unsigned char* ws = ARGWS(); unsigned char* wb = ws + WS_W + (size_t)l * W_LAYER;
            pg8::Gemm g{(const bf16*)(ws + WS_XB), (const bf16*)(wb + W_1), M, FF, DM}; pg8::StaticOrder S; S.init(M, FF, F.G, bx);
            pg8::EpiRelu2 E{(bf16*)(ws + WS_H), (const float*)(ws + WS_SSQ) + (size_t)l * M};
            pg8::gemm_phase<pg8::EpiRelu2, pg8::StaticOrder, true, true>(F.lds + RING_OFF, g, S, E, F.wave);
        }
        SEAM(pb + 5);
        if (IN(pb + 6)) { FRESH();
            unsigned char* ws = ARGWS(); unsigned char* wb = ws + WS_W + (size_t)l * W_LAYER;
            pg8::Gemm g{(const bf16*)(ws + WS_H), (const bf16*)(wb + W_2), M, DM, FF}; pg8::StaticOrder S; S.init(M, DM, F.G, bx);
            pg8::EpiRes2 E{ARGOUT(), (const bf16*)(ws + WS_XB), (l + 1 < DEPTH) ? (bf16*)ARGOUT() : (bf16*)nullptr, (float*)(ws + WS_SSQ2)};
            pg8::gemm_phase<pg8::EpiRes2, pg8::StaticOrder, true, true>(F.lds + RING_OFF, g, S, E, F.wave);
        }
        SEAM(pb + 6);
}

struct Args { const float* in[17]; float* out; unsigned char* ws; int ph_lo, ph_hi; };
__global__ void __launch_bounds__(NWAVES * 64, 2) mk_fwd(Args args) {
    extern __shared__ __attribute__((aligned(16))) unsigned char lds[];
    Frame F;
    F.lds = (LAS unsigned char*)lds;
    F.MISC = (volatile LAS unsigned*)(F.lds + MISC_OFF);
    F.tid = threadIdx.x; F.lane = F.tid & 63; F.wave = __builtin_amdgcn_readfirstlane(F.tid >> 6);
    F.G = gridDim.x; { const int bx = blockIdx.x; F.vcu = (F.G % 8 == 0) ? (bx % 8) * (F.G / 8) + bx / 8 : bx; }
    for (int u = F.tid; u < (LDS_BYTES - LDSCTL_OFF) / 4; u += NWAVES * 64) ((LAS unsigned*)(F.lds + LDSCTL_OFF))[u] = 0u;
    __syncthreads();
    const int lo = args.ph_lo, hi = args.ph_hi;
    XcdBarrier bar; bar.bar = (unsigned*)(ARGWS() + WS_CTL) + CW_BAR; bar.x = 0; bar.st = nullptr;
    if (hi - lo > 1) bar = xcd_barrier_post((unsigned*)(ARGWS() + WS_CTL) + CW_BAR, F.MISC + 8);
    int bx;
    if (IN(0)) { FRESH(); p0_weights(F); __syncthreads(); pre_rows(F, ARGF(0), 0); }
    SEAM(0);
    layer_phases<0>(F, lo, hi, bar);
    layer_phases<1>(F, lo, hi, bar);
#undef IN
#undef SEAM
}

#ifndef MK_N_LAUNCHES
#define MK_N_LAUNCHES 1
#endif
extern "C" void kernel_launch(void* const* d_in, const int* in_sizes, int n_in, void* d_out, int out_size, void* d_ws, size_t ws_size, hipStream_t stream) {
    static int grid = 0;
    if (grid == 0) {
        if (n_in != 17 || in_sizes[0] != M * DM || out_size != M * DM || ws_size < WS_END) { fprintf(stderr, "kernel_launch: unexpected shapes (n_in %d, in0 %d, out %d, ws %zu)\n", n_in, n_in > 0 ? in_sizes[0] : -1, out_size, ws_size); grid = -1; return; }
        int dev = 0, cus = 0, per_cu = 0;
        if (hipGetDevice(&dev) != hipSuccess || hipDeviceGetAttribute(&cus, hipDeviceAttributeMultiprocessorCount, dev) != hipSuccess) { grid = -1; return; }
        if (hipFuncSetAttribute((const void*)mk_fwd, hipFuncAttributeMaxDynamicSharedMemorySize, LDS_BYTES) != hipSuccess) { fprintf(stderr, "kernel_launch: hipFuncSetAttribute failed\n"); grid = -1; return; }
        if (hipOccupancyMaxActiveBlocksPerMultiprocessor(&per_cu, (const void*)mk_fwd, NWAVES * 64, LDS_BYTES) != hipSuccess || per_cu < 1) { fprintf(stderr, "kernel_launch: occupancy query says %d blocks per CU\n", per_cu); }
        (void)hipGetLastError();
        if (cus < 256) { fprintf(stderr, "kernel_launch: built for 256 CUs, device has %d\n", cus); grid = -1; return; }
        grid = 256;
    }
    if (grid < 0) return;
    if (hipMemsetAsync((char*)d_ws + WS_CTL, 0, CTL_ZERO_BYTES, stream) != hipSuccess) { fprintf(stderr, "kernel_launch: memset failed\n"); return; }
    Args a{};
    for (int i = 0; i < 17; ++i) a.in[i] = (const float*)d_in[i];
    a.out = (float*)d_out; a.ws = (unsigned char*)d_ws;
    const int NL = MK_N_LAUNCHES;
    if (NL == 1) { a.ph_lo = 0; a.ph_hi = N_PHASES; hipLaunchKernelGGL(mk_fwd, dim3(grid), dim3(NWAVES * 64), LDS_BYTES, stream, a); }
    else { for (int p = 0; p < N_PHASES; ++p) { a.ph_lo = p; a.ph_hi = p + 1; hipLaunchKernelGGL(mk_fwd, dim3(grid), dim3(NWAVES * 64), LDS_BYTES, stream, a); } }
    const hipError_t le = hipPeekAtLastError();
    if (le != hipSuccess) fprintf(stderr, "kernel_launch: launch failed: %s\n", hipGetErrorName(le));
}
```

```cpp
#include <hip/hip_runtime.h>
#include <cstdio>
#include <cstdint>
#include <cmath>
__device__ __forceinline__ int lane_id() { return (int)__builtin_amdgcn_mbcnt_hi(~0u, __builtin_amdgcn_mbcnt_lo(~0u, 0u)); }
namespace pg8 {
#define PG8_LAS __attribute__((address_space(3)))
typedef unsigned short bf16_t;
typedef short bf16x8 __attribute__((ext_vector_type(8)));
typedef float f32x4 __attribute__((ext_vector_type(4)));
typedef unsigned u32x4 __attribute__((ext_vector_type(4)));
constexpr int BM = 256, BK = 64, HALF = 128, HTB = HALF * BK * 2  , STAGE_BYTES = 8 * HTB, NXCD = 8, WGM = 4;

__host__ __device__ __forceinline__ int lds_byte(int r, int c) { const int st = (r >> 4) * 2 + (c >> 5), rr = r & 15, cc = c & 31, ob = rr * 64 + cc * 2; return st * 1024 + (ob ^ (((ob >> 9) & 1) << 5)); }
__host__ __device__ __forceinline__ void stage_rc(int b, int& R, int& C) { const int st = b / 1024, sb = b % 1024, swz = sb ^ (((sb >> 9) & 1) << 5); R = (st >> 1) * 16 + swz / 64; C = (st & 1) * 32 + (swz % 64) / 2; }
__host__ __device__ __forceinline__ int perm32(int rho) { const int n = rho >> 4, i = rho & 15; return 8 * (i >> 2) + 4 * n + (i & 3); }

struct Unit { int pm, pn; };
struct Gemm { const bf16_t* A; const bf16_t* Bt; int M, N, K; };

struct StaticOrder {
    int nM, nN, nwg, G, c;
    __host__ __device__ void init(int M, int N, int G_, int c_) { nM = M / BM; nN = N / BM; nwg = nM * nN; G = G_; c = c_; }
    __host__ __device__ bool next(int i, Unit& u) const {
        const long L = (long)i * G + c; if (L >= nwg) return false;
        int wgid = (int)L; { const int q = nwg / NXCD, r = nwg % NXCD, xcd = wgid % NXCD, off = wgid / NXCD; wgid = (xcd < r ? xcd * (q + 1) : r * (q + 1) + (xcd - r) * q) + off; }
        const int nig = WGM * nN, gid = wgid / nig, fm = gid * WGM, gsz = (nM - fm) < WGM ? (nM - fm) : WGM;
        u.pm = fm + ((wgid % nig) % gsz); u.pn = (wgid % nig) / gsz; return true;
    }
    __device__ __forceinline__ void a_ready(const Unit&) const {}
    __device__ __forceinline__ void done(const Unit&) const {}
};

__device__ __forceinline__ unsigned cvt_pk_bf16(float lo, float hi) { unsigned r; asm volatile("v_cvt_pk_bf16_f32 %0, %1, %2" : "=v"(r) : "v"(lo), "v"(hi)); return r; }
typedef float f32x2 __attribute__((ext_vector_type(2)));
typedef unsigned u32x2 __attribute__((ext_vector_type(2)));
struct EpiProj {
    static constexpr bool PERM = true, AFTER_DRAIN = false;
    bf16_t* P; const float* rss; const float *g0, *g1, *g2, *g3;
    float* kms;
    __device__ __forceinline__ void operator()(const f32x4 (&acc)[2][2][4][2], const Unit& u, int wr, int wc, int fr, int fq) const {
        const int pn = u.pn; const int nsel = (pn == 0) ? 0 : (pn == 1) ? 1 : (pn == 3) ? 2 : (pn == 4) ? 3 : -1;
        const int row0 = u.pm * BM + wr * 64 + fr;
        const float* nw = (nsel == 0) ? g0 : (nsel == 1) ? g1 : (nsel == 2) ? g2 : g3;
        f32x4 g[2][2];
#pragma unroll
        for (int bj = 0; bj < 2; ++bj)
#pragma unroll
            for (int n = 0; n < 2; ++n) g[bj][n] = (nsel >= 0) ? *(const f32x4*)(nw + 32 * bj + 8 * fq + 4 * n) : (f32x4){1.f, 1.f, 1.f, 1.f};
        f32x4 cs[2][2];
#pragma unroll
        for (int bj = 0; bj < 2; ++bj)
#pragma unroll
            for (int n = 0; n < 2; ++n) cs[bj][n] = (f32x4){0.f, 0.f, 0.f, 0.f};
#pragma unroll
        for (int ai = 0; ai < 2; ++ai)
#pragma unroll
            for (int m = 0; m < 4; ++m) {
                const int row = row0 + ai * HALF + m * 16; const float r = 1.0f / sqrtf(rss[row] * (1.0f / 1024.0f) + 1e-6f);
                f32x4 v[2][2]; float ss = 0.f;
#pragma unroll
                for (int bj = 0; bj < 2; ++bj)
#pragma unroll
                    for (int n = 0; n < 2; ++n) { v[bj][n] = acc[ai][bj][m][n] * r; const f32x4 x = v[bj][n]; ss += (x[0] * x[0] + x[1] * x[1]) + (x[2] * x[2] + x[3] * x[3]); }
                if (nsel >= 0) {
                    ss += __shfl_xor(ss, 16); ss += __shfl_xor(ss, 32);
                    const float hr = 1.0f / sqrtf(ss * (1.0f / 64.0f) + 1e-6f);
#pragma unroll
                    for (int bj = 0; bj < 2; ++bj)
#pragma unroll
                        for (int n = 0; n < 2; ++n) { v[bj][n] = v[bj][n] * hr * g[bj][n]; cs[bj][n] += v[bj][n]; }
                }
                bf16_t* rowp = P + (size_t)row * 3072 + pn * BM + wc * 64 + 8 * fq;
#pragma unroll
                for (int bj = 0; bj < 2; ++bj) { u32x4 w; w.x = cvt_pk_bf16(v[bj][0][0], v[bj][0][1]); w.y = cvt_pk_bf16(v[bj][0][2], v[bj][0][3]); w.z = cvt_pk_bf16(v[bj][1][0], v[bj][1][1]); w.w = cvt_pk_bf16(v[bj][1][2], v[bj][1][3]);
                    *(u32x4*)(rowp + 32 * bj) = w; }
            }
        if (nsel == 3) {
            float* dst = kms + ((size_t)(u.pm * 4 + wc)) * 64 + 8 * fq;
#pragma unroll
            for (int bj = 0; bj < 2; ++bj)
#pragma unroll
                for (int n = 0; n < 2; ++n)
#pragma unroll
                    for (int e = 0; e < 4; ++e) { float s = cs[bj][n][e]; s += __shfl_xor(s, 1); s += __shfl_xor(s, 2); s += __shfl_xor(s, 4); s += __shfl_xor(s, 8);
                        if (fr == 0) atomicAdd(dst + 32 * bj + 4 * n + e, s); }
        }
    }
};
struct EpiRes1 {
    static constexpr bool PERM = true, AFTER_DRAIN = false;
    const bf16_t* baseb; bf16_t* xb; float* ssq;
    __device__ __forceinline__ void operator()(const f32x4 (&acc)[2][2][4][2], const Unit& u, int wr, int wc, int fr, int fq) const {
        const int col0 = u.pn * BM + wc * 32 + 8 * fq;
#pragma unroll
        for (int ai = 0; ai < 2; ++ai)
#pragma unroll
            for (int m = 0; m < 4; ++m) {
                const int row = u.pm * BM + ai * HALF + wr * 64 + m * 16 + fr; const size_t off = (size_t)row * 1024 + col0; float ss = 0.f;
#pragma unroll
                for (int bj = 0; bj < 2; ++bj) { const size_t o2 = off + bj * HALF;
                    const u32x4 h = *(const u32x4*)(baseb + o2);
                    f32x4 o0, o1;
                    o0[0] = __uint_as_float(h.x << 16); o0[1] = __uint_as_float(h.x & 0xffff0000u); o0[2] = __uint_as_float(h.y << 16); o0[3] = __uint_as_float(h.y & 0xffff0000u);
                    o1[0] = __uint_as_float(h.z << 16); o1[1] = __uint_as_float(h.z & 0xffff0000u); o1[2] = __uint_as_float(h.w << 16); o1[3] = __uint_as_float(h.w & 0xffff0000u);
                    o0 = o0 + acc[ai][bj][m][0]; o1 = o1 + acc[ai][bj][m][1];
                    u32x4 w; w.x = cvt_pk_bf16(o0[0], o0[1]); w.y = cvt_pk_bf16(o0[2], o0[3]); w.z = cvt_pk_bf16(o1[0], o1[1]); w.w = cvt_pk_bf16(o1[2], o1[3]); *(u32x4*)(xb + o2) = w;
                    ss += ((o0[0] * o0[0] + o0[1] * o0[1]) + (o0[2] * o0[2] + o0[3] * o0[3])) + ((o1[0] * o1[0] + o1[1] * o1[1]) + (o1[2] * o1[2] + o1[3] * o1[3])); }
                ss += __shfl_xor(ss, 16); ss += __shfl_xor(ss, 32);
                if (fq == 0) atomicAdd(ssq + row, ss);
            }
    }
};
struct EpiRelu2 {
    static constexpr bool PERM = true, AFTER_DRAIN = false;
    bf16_t* H; const float* ssq;
    __device__ __forceinline__ void operator()(const f32x4 (&acc)[2][2][4][2], const Unit& u, int wr, int wc, int fr, int fq) const {
        const int col0 = u.pn * BM + wc * 32 + 8 * fq;
#pragma unroll
        for (int ai = 0; ai < 2; ++ai)
#pragma unroll
            for (int m = 0; m < 4; ++m) {
                const int row = u.pm * BM + ai * HALF + wr * 64 + m * 16 + fr; const float r = 1.0f / sqrtf(ssq[row] * (1.0f / 1024.0f) + 1e-6f);
                bf16_t* rowp = H + (size_t)row * 4096 + col0;
#pragma unroll
                for (int bj = 0; bj < 2; ++bj) { f32x4 v0 = acc[ai][bj][m][0] * r, v1 = acc[ai][bj][m][1] * r;
#pragma unroll
                    for (int e = 0; e < 4; ++e) { const float a = fmaxf(v0[e], 0.f), b = fmaxf(v1[e], 0.f); v0[e] = a * a; v1[e] = b * b; }
                    u32x4 w; w.x = cvt_pk_bf16(v0[0], v0[1]); w.y = cvt_pk_bf16(v0[2], v0[3]); w.z = cvt_pk_bf16(v1[0], v1[1]); w.w = cvt_pk_bf16(v1[2], v1[3]);
                    *(u32x4*)(rowp + bj * HALF) = w; }
            }
    }
};
struct EpiRes2 {
    static constexpr bool PERM = true, AFTER_DRAIN = false;
    float* out; const bf16_t* xhi; bf16_t* xnb; float* ssqn;
    __device__ __forceinline__ void operator()(const f32x4 (&acc)[2][2][4][2], const Unit& u, int wr, int wc, int fr, int fq) const {
        const int col0 = u.pn * BM + wc * 32 + 8 * fq;
#pragma unroll
        for (int ai = 0; ai < 2; ++ai)
#pragma unroll
            for (int m = 0; m < 4; ++m) {
                const int row = u.pm * BM + ai * HALF + wr * 64 + m * 16 + fr; const size_t off = (size_t)row * 1024 + col0; float ss = 0.f;
#pragma unroll
                for (int bj = 0; bj < 2; ++bj) { const size_t o2 = off + bj * HALF;
                    const u32x4 h = *(const u32x4*)(xhi + o2);
                    f32x4 o0, o1;
                    o0[0] = __uint_as_float(h.x << 16); o0[1] = __uint_as_float(h.x & 0xffff0000u); o0[2] = __uint_as_float(h.y << 16); o0[3] = __uint_as_float(h.y & 0xffff0000u);
                    o1[0] = __uint_as_float(h.z << 16); o1[1] = __uint_as_float(h.z & 0xffff0000u); o1[2] = __uint_as_float(h.w << 16); o1[3] = __uint_as_float(h.w & 0xffff0000u);
                    o0 = o0 + acc[ai][bj][m][0]; o1 = o1 + acc[ai][bj][m][1];
                    if (xnb) { u32x4 w; w.x = cvt_pk_bf16(o0[0], o0[1]); w.y = cvt_pk_bf16(o0[2], o0[3]); w.z = cvt_pk_bf16(o1[0], o1[1]); w.w = cvt_pk_bf16(o1[2], o1[3]); *(u32x4*)(xnb + o2) = w;
                        ss += ((o0[0] * o0[0] + o0[1] * o0[1]) + (o0[2] * o0[2] + o0[3] * o0[3])) + ((o1[0] * o1[0] + o1[1] * o1[1]) + (o1[2] * o1[2] + o1[3] * o1[3])); }
                    else { *(f32x4*)(out + o2) = o0; *(f32x4*)(out + o2 + 4) = o1; } }
                if (xnb) { ss += __shfl_xor(ss, 16); ss += __shfl_xor(ss, 32); if (fq == 0) atomicAdd(ssqn + row, ss); }
            }
    }
};
template <class Epi, class Sched, bool ALIGN_EPI = false, bool SP2 = false>
__device__ __forceinline__ void gemm_phase(PG8_LAS unsigned char* lds, const Gemm g, const Sched& S, const Epi& E, const int wave_in) {
    int tid_ = wave_in * 64 + lane_id(); asm volatile("" : "+v"(tid_));
    const int tid = tid_, wid = __builtin_amdgcn_readfirstlane(tid >> 6), lane = tid & 63, wr = wid >> 2, wc = wid & 3, fr = lane & 15, fq = lane >> 4;
    const int K = g.K, nt = K / BK;
    unsigned voffA[2], voffB[2];
#pragma unroll
    for (int i = 0; i < 2; ++i) { int R, C; stage_rc(tid * 16 + i * 8192, R, C); const int Rb = Epi::PERM ? ((R & ~31) + perm32(R & 31)) : R;
        voffA[i] = (unsigned)(R * K + C) * 2u; voffB[i] = (unsigned)(Rb * K + C) * 2u; }
    const size_t kstep = (size_t)(BK * 2);
    const size_t hstep = (size_t)HALF * K * 2;
    const size_t tstep = 2 * hstep;
    const unsigned ldsw = (unsigned)wid * 1024u;
    const int aoff = lds_byte(wr * 64 + fr, fq * 8), boff = lds_byte(wc * 32 + fr, fq * 8);
#define PG8_SA(b, h) (((b) * 2 + (h)) * HTB)
#define PG8_SB(b, h) ((4 + (b) * 2 + (h)) * HTB)
#define PG8_STAGE(bufoff, gbase, voff) do { _Pragma("unroll") for (int _i = 0; _i < 2; ++_i) \
        __builtin_amdgcn_global_load_lds((const unsigned*)((const char*)(gbase) + (voff)[_i]), (PG8_LAS unsigned*)(lds + (bufoff) + ldsw + _i * 8192), 16, 0, 0); } while (0)
#define PG8_LDA(dst, b, h) do { _Pragma("unroll") for (int m = 0; m < 4; ++m) _Pragma("unroll") for (int k = 0; k < 2; ++k) dst[m][k] = *(const PG8_LAS bf16x8*)(lds + PG8_SA(b, h) + aoff + m * 2048 + k * 1024); } while (0)
#define PG8_LDB(dst, b, h) do { _Pragma("unroll") for (int n = 0; n < 2; ++n) _Pragma("unroll") for (int k = 0; k < 2; ++k) dst[n][k] = *(const PG8_LAS bf16x8*)(lds + PG8_SB(b, h) + boff + n * 2048 + k * 1024); } while (0)
#define PG8_MMA(ai, bj, At, Bt) do { __builtin_amdgcn_s_setprio(1); _Pragma("unroll") for (int m = 0; m < 4; ++m) _Pragma("unroll") for (int n = 0; n < 2; ++n) _Pragma("unroll") for (int k = 0; k < 2; ++k) \
        acc[ai][bj][m][n] = __builtin_amdgcn_mfma_f32_16x16x32_bf16(Bt[n][k], At[m][k], acc[ai][bj][m][n], 0, 0, 0); __builtin_amdgcn_s_setprio(0); } while (0)
#define PG8_WAIT_V(n) asm volatile("s_waitcnt vmcnt(" #n ")" ::: "memory")
#define PG8_WAIT_L(n) asm volatile("s_waitcnt lgkmcnt(" #n ")" ::: "memory")
#define PG8_BAR __builtin_amdgcn_s_barrier()
#define PG8_SCHED __builtin_amdgcn_sched_barrier(0)
    Unit cur, nxt; int ui = 0;
    if (!S.next(0, cur)) return;
    f32x4 acc[2][2][4][2];
#pragma unroll
    for (int a = 0; a < 2; ++a)
#pragma unroll
        for (int b = 0; b < 2; ++b)
#pragma unroll
            for (int m = 0; m < 4; ++m)
#pragma unroll
                for (int n = 0; n < 2; ++n) acc[a][b][m][n] = (f32x4){0.f, 0.f, 0.f, 0.f};
    bf16x8 At[4][2], B0[2][2], B1[2][2];
    const char* cA = (const char*)g.A + (size_t)cur.pm * tstep; const char* cB = (const char*)g.Bt + (size_t)cur.pn * tstep;
    S.a_ready(cur);
    if constexpr (SP2) {
        PG8_STAGE(PG8_SB(0, 0), cB, voffB); PG8_STAGE(PG8_SB(0, 1), cB + hstep, voffB); PG8_STAGE(PG8_SA(0, 0), cA, voffA); PG8_STAGE(PG8_SA(0, 1), cA + hstep, voffA);
        if (wr == 1) PG8_BAR;
        PG8_WAIT_V(2); PG8_BAR;
        PG8_STAGE(PG8_SB(1, 0), cB + kstep, voffB); PG8_STAGE(PG8_SA(1, 0), cA + kstep, voffA); PG8_STAGE(PG8_SB(1, 1), cB + hstep + kstep, voffB);
        PG8_WAIT_V(6); PG8_BAR;
    } else {
        PG8_STAGE(PG8_SB(0, 0), cB, voffB); PG8_STAGE(PG8_SA(0, 0), cA, voffA); PG8_STAGE(PG8_SB(0, 1), cB + hstep, voffB); PG8_STAGE(PG8_SA(0, 1), cA + hstep, voffA);
        if (wr == 1) PG8_BAR;
        PG8_WAIT_V(4); PG8_BAR;
        PG8_STAGE(PG8_SB(1, 0), cB + kstep, voffB); PG8_STAGE(PG8_SA(1, 0), cA + kstep, voffA); PG8_STAGE(PG8_SB(1, 1), cB + hstep + kstep, voffB);
        PG8_WAIT_V(6); PG8_BAR;
    }
    for (;;) {
        const bool has_next = S.next(ui + 1, nxt);
        const char* nA = has_next ? (const char*)g.A + (size_t)nxt.pm * tstep : cA; const char* nB = has_next ? (const char*)g.Bt + (size_t)nxt.pn * tstep : cB;
        for (int t = 0; t < nt; t += 2) {
            const bool last = (t == nt - 2);
            const char* a1 = cA + (size_t)(t + 1) * kstep;
            const char* a2 = last ? nA : cA + (size_t)(t + 2) * kstep; const char* b2 = last ? nB : cB + (size_t)(t + 2) * kstep;
            const char* a3 = a2 + kstep; const char* b3 = b2 + kstep;
            if (last && has_next) S.a_ready(nxt);
            if constexpr (SP2) {
            PG8_LDB(B0, 0, 0); PG8_LDB(B1, 0, 1); PG8_SCHED; PG8_LDA(At, 0, 0); PG8_STAGE(PG8_SA(1, 1), a1 + hstep, voffA);
            PG8_WAIT_V(8); PG8_WAIT_L(0); PG8_BAR; PG8_MMA(0, 0, At, B0); PG8_MMA(0, 1, At, B1); PG8_BAR; PG8_SCHED;
            PG8_LDA(At, 0, 1); PG8_STAGE(PG8_SB(0, 0), b2, voffB); PG8_STAGE(PG8_SB(0, 1), b2 + hstep, voffB); PG8_STAGE(PG8_SA(0, 0), a2, voffA);
            PG8_WAIT_V(8); PG8_WAIT_L(0); PG8_BAR; PG8_MMA(1, 0, At, B0); PG8_MMA(1, 1, At, B1); PG8_BAR; PG8_SCHED;
            PG8_LDB(B0, 1, 0); PG8_LDB(B1, 1, 1); PG8_SCHED; PG8_LDA(At, 1, 0); PG8_STAGE(PG8_SA(0, 1), a2 + hstep, voffA);
            PG8_WAIT_V(8); PG8_WAIT_L(0); PG8_BAR; PG8_MMA(0, 0, At, B0); PG8_MMA(0, 1, At, B1); PG8_BAR; PG8_SCHED;
            PG8_LDA(At, 1, 1); PG8_STAGE(PG8_SB(1, 0), b3, voffB); PG8_STAGE(PG8_SB(1, 1), b3 + hstep, voffB); PG8_STAGE(PG8_SA(1, 0), a3, voffA);
            PG8_WAIT_V(8); PG8_WAIT_L(0); PG8_BAR; PG8_MMA(1, 0, At, B0); PG8_MMA(1, 1, At, B1); PG8_BAR; PG8_SCHED;
            } else {
            PG8_LDB(B0, 0, 0); PG8_SCHED; PG8_LDA(At, 0, 0); PG8_STAGE(PG8_SA(1, 1), a1 + hstep, voffA);
            PG8_WAIT_L(8); PG8_BAR; PG8_WAIT_L(0); PG8_MMA(0, 0, At, B0); PG8_BAR; PG8_SCHED;
            PG8_LDB(B1, 0, 1); PG8_STAGE(PG8_SB(0, 0), b2, voffB);
            PG8_BAR; PG8_WAIT_L(0); PG8_MMA(0, 1, At, B1); PG8_BAR;
            PG8_LDA(At, 0, 1); PG8_STAGE(PG8_SA(0, 0), a2, voffA);
            PG8_BAR; PG8_WAIT_L(0); PG8_MMA(1, 0, At, B0); PG8_BAR; PG8_SCHED;
            PG8_STAGE(PG8_SB(0, 1), b2 + hstep, voffB);
            PG8_WAIT_V(6); PG8_BAR; PG8_MMA(1, 1, At, B1); PG8_BAR;
            PG8_LDB(B0, 1, 0); PG8_SCHED; PG8_LDA(At, 1, 0); PG8_STAGE(PG8_SA(0, 1), a2 + hstep, voffA);
            PG8_WAIT_L(8); PG8_BAR; PG8_WAIT_L(0); PG8_MMA(0, 0, At, B0); PG8_BAR; PG8_SCHED;
            PG8_LDB(B1, 1, 1); PG8_STAGE(PG8_SB(1, 0), b3, voffB);
            PG8_BAR; PG8_WAIT_L(0); PG8_MMA(0, 1, At, B1); PG8_BAR;
            PG8_LDA(At, 1, 1); PG8_STAGE(PG8_SA(1, 0), a3, voffA);
            PG8_BAR; PG8_WAIT_L(0); PG8_MMA(1, 0, At, B0); PG8_BAR; PG8_SCHED;
            PG8_STAGE(PG8_SB(1, 1), b3 + hstep, voffB);
            PG8_WAIT_V(6); PG8_BAR; PG8_MMA(1, 1, At, B1); PG8_BAR;
            }
        }
        if constexpr (ALIGN_EPI) { if (wr == 0) PG8_BAR; }
        if constexpr (!Epi::AFTER_DRAIN) { E(acc, cur, wr, wc, fr, fq); S.done(cur); }
        if (!has_next) break;
#pragma unroll
        for (int a = 0; a < 2; ++a)
#pragma unroll
            for (int b = 0; b < 2; ++b)
#pragma unroll
                for (int m = 0; m < 4; ++m)
#pragma unroll
                    for (int n = 0; n < 2; ++n) acc[a][b][m][n] = (f32x4){0.f, 0.f, 0.f, 0.f};
        cur = nxt; cA = nA; cB = nB; ++ui;
        if constexpr (ALIGN_EPI) { if (wr == 1) PG8_BAR; }
    }
    PG8_WAIT_V(0);
    if constexpr (!ALIGN_EPI) { if (wr == 0) PG8_BAR; }
    PG8_BAR;
    if constexpr (Epi::AFTER_DRAIN) { E.fused(acc, cur, wr, wc, fr, fq, lds, wid, lane); S.done(cur); }
#undef PG8_SA
#undef PG8_SB
#undef PG8_STAGE
#undef PG8_LDA
#undef PG8_LDB
#undef PG8_MMA
#undef PG8_WAIT_V
#undef PG8_WAIT_L
#undef PG8_BAR
#undef PG8_SCHED
}
}
#define GAS __attribute__((address_space(1)))
#define LAS __attribute__((address_space(3)))
typedef unsigned short bf16;
typedef unsigned v4u __attribute__((ext_vector_type(4)));
typedef float f32x4 __attribute__((ext_vector_type(4)));
typedef short bf16x8 __attribute__((ext_vector_type(8)));
typedef GAS unsigned gu32;
typedef GAS unsigned long long gu64;
#define RLX_AGENT __ATOMIC_RELAXED, __HIP_MEMORY_SCOPE_AGENT
#define LDS_WAIT() asm volatile("s_waitcnt lgkmcnt(0)" ::: "memory")
#define VM_WAIT() asm volatile("s_waitcnt vmcnt(0)" ::: "memory")
__device__ __forceinline__ unsigned long long rt() { return __builtin_amdgcn_s_memrealtime(); }
__device__ __forceinline__ unsigned f2bf(float f) { unsigned u = __builtin_bit_cast(unsigned, f); return (u + 0x7fffu + ((u >> 16) & 1u)) >> 16; }
__device__ __forceinline__ unsigned pk2(float lo, float hi) { typedef float f2_t __attribute__((ext_vector_type(2))); typedef __bf16 b2_t __attribute__((ext_vector_type(2))); const f2_t v = {lo, hi}; return __builtin_bit_cast(unsigned, __builtin_convertvector(v, b2_t)); }
#define XB_TMO      128
#define XB_XCNT(j)  (256  + 64 * (j))
#define XB_XSUB(j)  (1280 + 64 * (j))
#define XB_XGEN(j)  (2304 + 64 * (j))
#define XB_TOP      3328
#define XB_TOPGEN   3392
#define XCD_BAR_WORDS 3456
#define XB_SPIN_CAP (1u << 18)

__device__ __forceinline__ unsigned xb_ld(unsigned* p)              { return __hip_atomic_load(p, __ATOMIC_RELAXED, __HIP_MEMORY_SCOPE_AGENT); }
__device__ __forceinline__ unsigned xb_add(unsigned* p, unsigned v) { return __hip_atomic_fetch_add(p, v, __ATOMIC_RELAXED, __HIP_MEMORY_SCOPE_AGENT); }
__device__ __forceinline__ unsigned xb_xcc_id() { return (unsigned)__builtin_amdgcn_s_getreg((3 << 11) | 20) & 0xFu; }
#define XB_SPIN(cond, bar) do { unsigned _sp = 0; while (cond) { __builtin_amdgcn_s_sleep(1); \
    if ((++_sp & 255u) == 0u) { if (xb_ld(&(bar)[XB_TMO])) break; if (_sp > XB_SPIN_CAP) { atomicAdd(&(bar)[XB_TMO], 1u); break; } } } } while (0)

struct XcdBarrier {
    unsigned* bar; unsigned x;
    volatile LAS unsigned* st;
};

__device__ __forceinline__ XcdBarrier xcd_barrier_post(unsigned* bar, volatile LAS unsigned* st) {
    XcdBarrier b; b.bar = bar; b.x = xb_xcc_id(); b.st = st;
    if (threadIdx.x == 0) (void)xb_add(&bar[XB_XCNT(b.x)], 1u);
    return b;
}
__device__ __forceinline__ void xcd_barrier_complete(unsigned* bar, unsigned x, unsigned& nloc, unsigned& nx) {
    const unsigned G = gridDim.x * gridDim.y * gridDim.z;
    unsigned sum, cnt, mine, sp = 0u;
    for (;;) {
        sum = 0u; cnt = 0u; mine = 0u;
#pragma unroll
        for (unsigned j = 0; j < 16; ++j) { const unsigned c = xb_ld(&bar[XB_XCNT(j)]); sum += c; cnt += (c > 0u) ? 1u : 0u; mine = (j == x) ? c : mine; }
        if (sum == G) break;
        __builtin_amdgcn_s_sleep(1);
        if ((++sp & 255u) == 0u) { if (xb_ld(&bar[XB_TMO])) break; if (sp > XB_SPIN_CAP) { atomicAdd(&bar[XB_TMO], 1u); break; } }
    }
    nloc = mine > 0u ? mine : 1u; nx = cnt > 0u ? cnt : 1u;
}

__device__ __forceinline__ void xcd_barrier(const XcdBarrier& b, const bool leader  ) {
    asm volatile("s_waitcnt vmcnt(0)" ::: "memory");
    __syncthreads();
    unsigned zoff_ = 0u; asm volatile("s_mov_b32 %0, 0" : "=s"(zoff_)); unsigned* bar_ = b.bar + zoff_; const unsigned bx_ = b.x + zoff_;
    if (leader) {
        unsigned* bar = bar_;
        __builtin_amdgcn_s_waitcnt(0);
        unsigned nloc = b.st[0], nx = b.st[1];
        if (nloc == 0u) { xcd_barrier_complete(bar, bx_, nloc, nx); b.st[0] = nloc; b.st[1] = nx; }
        const unsigned old = xb_add(&bar[XB_XSUB(bx_)], 1u);
        const unsigned gen = old / nloc;
        if (old + 1u == (gen + 1u) * nloc) {
            __builtin_amdgcn_fence(__ATOMIC_RELEASE, "agent");
            asm volatile("s_waitcnt vmcnt(0)" ::: "memory");
            const unsigned og = xb_add(&bar[XB_TOP], 1u);
            const unsigned tg = og / nx;
            if (og + 1u == (tg + 1u) * nx) xb_add(&bar[XB_TOPGEN], 1u);
            else XB_SPIN(xb_ld(&bar[XB_TOPGEN]) == tg, bar);
            __builtin_amdgcn_fence(__ATOMIC_ACQUIRE, "agent");
            xb_add(&bar[XB_XGEN(bx_)], 1u);
            asm volatile("s_waitcnt vmcnt(0)" ::: "memory");
        } else {
            XB_SPIN(xb_ld(&bar[XB_XGEN(bx_)]) == gen, bar);
            __builtin_amdgcn_fence(__ATOMIC_ACQUIRE, "agent");
            asm volatile("s_waitcnt vmcnt(0)" ::: "memory");
        }
    }
    __syncthreads();
}
constexpr int NWAVES = 8;
constexpr int BATCH = 4, SEQ = 4096, DM = 1024, M = BATCH * SEQ, DIN = 3080, NPROJ = 3072, FF = 4096, DEPTH = 2;
constexpr int OFF_QA = 0, OFF_KA = 256, OFF_VA = 512, OFF_QC = 768, OFF_KC = 1024, OFF_VC = 1280, OFF_Z = 1536, OFF_XBC = 2048;
constexpr float EPS = 1e-6f;
constexpr size_t MiB = 1u << 20;
constexpr size_t WS_CTL = 0, CTL_ZERO_BYTES = 1 * MiB;
constexpr size_t WS_KMS = 512 * 1024;
constexpr size_t WS_SSQ2 = 384 * 1024;
constexpr size_t WS_SSQ = 256 * 1024;
constexpr size_t WS_W = 2 * MiB, W_LAYER = 24 * MiB, W_IN = 0, W_OUT = 6 * MiB, W_1 = 8 * MiB, W_2 = 16 * MiB;
constexpr size_t WS_RSTD = 50 * MiB, WS_DT = 51 * MiB, WS_KMEAN = 52 * MiB;
constexpr size_t WS_PROJ = 56 * MiB, WS_Y = 152 * MiB, WS_H = 56 * MiB, WS_XB = 184 * MiB, WS_ST = 216 * MiB, WS_END = 256 * MiB;
static_assert(WS_PROJ + (size_t)M * NPROJ * 2 <= WS_Y && WS_Y + (size_t)M * DM * 2 <= WS_XB && WS_H + (size_t)M * FF * 2 <= WS_XB && WS_XB + (size_t)M * DM * 2 <= WS_ST && WS_ST + 32 * MiB <= WS_END, "d_ws map");
constexpr int CW_BAR = 4096;
constexpr int RING_OFF = 0, RING_BYTES = 143360;
constexpr int LDSCTL_OFF = RING_BYTES, MISC_OFF = LDSCTL_OFF + 320;
constexpr int LDS_BYTES = 147456;

struct Frame {
    LAS unsigned char* lds; volatile LAS unsigned* MISC;
    int tid, lane, wave, vcu, G;
};
typedef const __attribute__((address_space(4))) unsigned char* kptr_t;
__device__ __forceinline__ kptr_t kargs() { kptr_t p = (kptr_t)__builtin_amdgcn_kernarg_segment_ptr(); asm volatile("" : "+s"(p)); return p; }
#define ARGF(i) (*(const float* const __attribute__((address_space(4)))*)(kargs() + 8 * (i)))
#define ARGOUT() (*(float* const __attribute__((address_space(4)))*)(kargs() + 8 * 17))
#define ARGWS() (*(unsigned char* const __attribute__((address_space(4)))*)(kargs() + 8 * 18))
__device__ __forceinline__ float wave_sum(float v) {
#pragma unroll
    for (int o = 1; o < 64; o <<= 1) v += __shfl_xor(v, o);
    return v;
}
__device__ __forceinline__ float wave_max(float v) {
#pragma unroll
    for (int o = 1; o < 64; o <<= 1) v = fmaxf(v, __shfl_xor(v, o));
    return v;
}
__device__ __forceinline__ float blo(unsigned w) { return __uint_as_float(w << 16); }
__device__ __forceinline__ float bhi(unsigned w) { return __uint_as_float(w & 0xffff0000u); }
__device__ __forceinline__ float bf2f(bf16 u) { return __uint_as_float((unsigned)u << 16); }

__device__ __forceinline__ void p0_transpose_item(const float* W, int ldw, int K, int nblk, bf16* WT, LAS float* scr, int item, int lane, const float* kscale, bool perm) {
    const int kb = item / nblk, nb = item % nblk, k0 = 64 * kb, n0 = 32 * nb;
#pragma unroll
    for (int i = 0; i < 8; ++i) { const int kk = 8 * i + (lane >> 3), c4 = 4 * (lane & 7); f32x4 v = __builtin_nontemporal_load((const f32x4*)(W + (size_t)(k0 + kk) * ldw + n0 + c4));
        if (kscale) v = v * kscale[k0 + kk]; LAS float* d = scr + kk * 33 + c4; d[0] = v.x; d[1] = v.y; d[2] = v.z; d[3] = v.w; }
    LDS_WAIT(); asm volatile("" ::: "memory");
    const int c = lane & 7;
#pragma unroll
    for (int j = 0; j < 4; ++j) { const int n = (lane >> 3) + 8 * j; const LAS float* s = scr + (8 * c) * 33 + n;
        v4u o; o.x = pk2(s[0 * 33], s[1 * 33]); o.y = pk2(s[2 * 33], s[3 * 33]); o.z = pk2(s[4 * 33], s[5 * 33]); o.w = pk2(s[6 * 33], s[7 * 33]);
        int cc = n0 + n; if (perm) { const int cl = cc & 255; cc = (cc & ~255) + 128 * ((cl >> 5) & 1) + 32 * (cl >> 6) + (cl & 31); }
        *(GAS v4u*)(WT + (size_t)cc * K + k0 + 8 * c) = o; }
    LDS_WAIT(); asm volatile("" ::: "memory");
}
__device__ __forceinline__ void p0_weights(Frame& F) {
    LAS float* scr = (LAS float*)(F.lds + RING_OFF + F.wave * 16384);
    const int gw = F.vcu * NWAVES + F.wave, NGW = F.G * NWAVES;
    constexpr int I_IN = (DM / 64) * (NPROJ / 32), I_O = (DM / 64) * (DM / 32), I_1 = (DM / 64) * (FF / 32), I_2 = (FF / 64) * (DM / 32);
    constexpr int PER_L = I_IN + I_O + I_1 + I_2;
    for (int it = gw; it < DEPTH * PER_L; it += NGW) {
        const int l = it / PER_L; int r = it % PER_L;
        unsigned char* wb = ARGWS() + WS_W + (size_t)l * W_LAYER;
        if (r < I_IN) { p0_transpose_item(ARGF(2) + (size_t)l * DM * DIN, DIN, DM, NPROJ / 32, (bf16*)(wb + W_IN), scr, r, F.lane, ARGF(1) + l * DM, true); continue; } r -= I_IN;
        if (r < I_O) { p0_transpose_item(ARGF(13) + (size_t)l * DM * DM, DM, DM, DM / 32, (bf16*)(wb + W_OUT), scr, r, F.lane, nullptr, false); continue; } r -= I_O;
        if (r < I_1) { p0_transpose_item(ARGF(15) + (size_t)l * DM * FF, FF, DM, FF / 32, (bf16*)(wb + W_1), scr, r, F.lane, ARGF(14) + l * DM, false); continue; } r -= I_1;
        p0_transpose_item(ARGF(16) + (size_t)l * FF * DM, DM, FF, DM / 32, (bf16*)(wb + W_2), scr, r, F.lane, nullptr, false);
    }
}
__device__ __forceinline__ void pre_rows(Frame& F, const float* xs, int l) {
    LAS float* wdt = (LAS float*)(F.lds + RING_OFF);
    const float* win = ARGF(2) + (size_t)l * DM * DIN; const float* nw = ARGF(1) + l * DM;
#pragma unroll
    for (int m = 0; m < 2; ++m) { const int k = F.tid + 512 * m; const float g = nw[k];
        const f32x4 a = *(const f32x4*)(win + (size_t)k * DIN + NPROJ), b = *(const f32x4*)(win + (size_t)k * DIN + NPROJ + 4);
        wdt[0 * DM + k] = g * a.x; wdt[1 * DM + k] = g * a.y; wdt[2 * DM + k] = g * a.z; wdt[3 * DM + k] = g * a.w; wdt[4 * DM + k] = g * b.x; wdt[5 * DM + k] = g * b.y; wdt[6 * DM + k] = g * b.z; wdt[7 * DM + k] = g * b.w; }
    __syncthreads();
    const int gw = F.vcu * NWAVES + F.wave, NGW = F.G * NWAVES;
    bf16* xb = (bf16*)(ARGWS() + WS_XB); float* rstd1 = (float*)(ARGWS() + WS_RSTD); float* dt = (float*)(ARGWS() + WS_DT);
    const float bias = (F.lane < 8) ? ARGF(9)[l * 8 + F.lane] : 0.f;
    for (int row0 = gw; row0 < M; row0 += 2 * NGW) {
        f32x4 v[2][4]; float ss[2] = {0.f, 0.f};
#pragma unroll
        for (int q = 0; q < 2; ++q) { const f32x4* xr = (const f32x4*)(xs + (size_t)(row0 + q * NGW) * DM) + F.lane;
#pragma unroll
            for (int j = 0; j < 4; ++j) v[q][j] = __builtin_nontemporal_load(xr + 64 * j); }
#pragma unroll
        for (int q = 0; q < 2; ++q) {
            const int row = row0 + q * NGW;
#pragma unroll
            for (int j = 0; j < 4; ++j) ss[q] += (v[q][j].x * v[q][j].x + v[q][j].y * v[q][j].y) + (v[q][j].z * v[q][j].z + v[q][j].w * v[q][j].w);
            const float ssw = wave_sum(ss[q]); const float rstd = 1.0f / sqrtf(ssw * (1.0f / DM) + EPS);
            unsigned long long* o8 = (unsigned long long*)(xb + (size_t)row * DM) + F.lane;
#pragma unroll
            for (int j = 0; j < 4; ++j) o8[64 * j] = (unsigned long long)pk2(v[q][j].x, v[q][j].y) | ((unsigned long long)pk2(v[q][j].z, v[q][j].w) << 32);
            float mine = 0.f;
#pragma unroll
            for (int jj = 0; jj < 8; ++jj) { float d = 0.f;
#pragma unroll
                for (int j = 0; j < 4; ++j) { const f32x4 w = *(const LAS f32x4*)(wdt + jj * DM + 256 * j + 4 * F.lane); d += (v[q][j].x * w.x + v[q][j].y * w.y) + (v[q][j].z * w.z + v[q][j].w * w.w); }
                d = wave_sum(d); if (F.lane == jj) mine = d; }
            if (F.lane < 8) { const float r = mine * rstd + bias; dt[(size_t)row * 8 + F.lane] = fmaxf(r, 0.f) + log1pf(expf(-fabsf(r))); }
            if (F.lane == 0) rstd1[row] = ssw;
        }
    }
    __syncthreads();
}

__device__ __forceinline__ void dt_rows_b(Frame& F, const bf16* xs, int l) {
    LAS float* wdt = (LAS float*)(F.lds + RING_OFF);
    const int gw = F.vcu * NWAVES + F.wave, NGW = F.G * NWAVES;
    static_assert(M == 8 * 256 * NWAVES, "dt_rows_b: 8 rows per wave on 256 workgroups");
    unsigned long long raw[8][4];
#pragma unroll
    for (int q = 0; q < 8; ++q)
#pragma unroll
        for (int j = 0; j < 4; ++j) raw[q][j] = *((const unsigned long long*)(xs + (size_t)(gw + q * NGW) * DM) + F.lane + 64 * j);
    const float* win = ARGF(2) + (size_t)l * DM * DIN; const float* nw = ARGF(1) + l * DM;
#pragma unroll
    for (int m = 0; m < 2; ++m) { const int k = F.tid + 512 * m; const float g = nw[k];
        const f32x4 a = *(const f32x4*)(win + (size_t)k * DIN + NPROJ), b = *(const f32x4*)(win + (size_t)k * DIN + NPROJ + 4);
        wdt[0 * DM + k] = g * a.x; wdt[1 * DM + k] = g * a.y; wdt[2 * DM + k] = g * a.z; wdt[3 * DM + k] = g * a.w; wdt[4 * DM + k] = g * b.x; wdt[5 * DM + k] = g * b.y; wdt[6 * DM + k] = g * b.z; wdt[7 * DM + k] = g * b.w; }
    float* dt = (float*)(ARGWS() + WS_DT);
    const float bias = (F.lane < 8) ? ARGF(9)[l * 8 + F.lane] : 0.f;
    __syncthreads();
#pragma unroll
    for (int q = 0; q < 8; ++q) {
        const int row = gw + q * NGW; f32x4 v[4]; float ss = 0.f;
#pragma unroll
        for (int j = 0; j < 4; ++j) { v[j].x = blo((unsigned)raw[q][j]); v[j].y = bhi((unsigned)raw[q][j]); v[j].z = blo((unsigned)(raw[q][j] >> 32)); v[j].w = bhi((unsigned)(raw[q][j] >> 32));
            ss += (v[j].x * v[j].x + v[j].y * v[j].y) + (v[j].z * v[j].z + v[j].w * v[j].w); }
        const float rstd = 1.0f / sqrtf(wave_sum(ss) * (1.0f / DM) + EPS);
        float mine = 0.f;
#pragma unroll
        for (int jj = 0; jj < 8; ++jj) { float d = 0.f;
#pragma unroll
            for (int j = 0; j < 4; ++j) { const f32x4 w = *(const LAS f32x4*)(wdt + jj * DM + 256 * j + 4 * F.lane); d += (v[j].x * w.x + v[j].y * w.y) + (v[j].z * w.z + v[j].w * w.w); }
            d = wave_sum(d); if (F.lane == jj) mine = d; }
        if (F.lane < 8) { const float r = mine * rstd + bias; dt[(size_t)row * 8 + F.lane] = fmaxf(r, 0.f) + log1pf(expf(-fabsf(r))); }
    }
    __syncthreads();
}
namespace att {
typedef float f32x16 __attribute__((ext_vector_type(16)));
typedef short v4i16_t __attribute__((ext_vector_type(4)));
typedef __bf16 bf16x2_t __attribute__((ext_vector_type(2)));
typedef float f32x2_t __attribute__((ext_vector_type(2)));
constexpr float C2 = 0.125f * 1.4426950408889634f;
constexpr int VROW = 192, VT_BYTES = 64 * VROW;
constexpr int BIGD = 1 << 28;
#define ATT_MFMA(a, b, c) __builtin_amdgcn_mfma_f32_32x32x16_bf16((a), (b), (c), 0, 0, 0)
__device__ __forceinline__ unsigned cvtpk(float lo, float hi) { f32x2_t v = {lo, hi}; return __builtin_bit_cast(unsigned, __builtin_convertvector(v, bf16x2_t)); }
__device__ __forceinline__ int clampt(int t) { return t < 0 ? 0 : (t > SEQ - 1 ? SEQ - 1 : t); }
__device__ __forceinline__ float half_max(float v) { auto rr = __builtin_amdgcn_permlane32_swap(__float_as_uint(v), __float_as_uint(v), false, false); return fmaxf(__uint_as_float(rr[0]), __uint_as_float(rr[1])); }
__device__ __forceinline__ float half_sum(float v) { auto rr = __builtin_amdgcn_permlane32_swap(__float_as_uint(v), __float_as_uint(v), false, false); return __uint_as_float(rr[0]) + __uint_as_float(rr[1]); }
struct St { f32x16 o0, o1; float m, l; };
template <int D> __device__ __forceinline__ void bias_vecs(f32x16& b0, f32x16& b1, float ns) {
#pragma unroll
    for (int r = 0; r < 16; ++r) { const int e0 = (r & 3) + 8 * (r >> 2); b0[r] = ns * (float)(D * e0); b1[r] = ns * (float)(D * (e0 + 32)); }
}
template <int MODE, int D, int VR>
__device__ __forceinline__ void tile_core(St& st, f32x16& u0, f32x16& u1, float zoff, bool okl, int D0, int maxd, LAS unsigned char* vrd) {
    if (MODE == 1) {
#pragma unroll
        for (int r = 0; r < 16; ++r) { const int e0 = (r & 3) + 8 * (r >> 2);
            u0[r] = ((unsigned)(D0 - D * e0) <= (unsigned)maxd) ? u0[r] : -INFINITY; u1[r] = ((unsigned)(D0 - D * (e0 + 32)) <= (unsigned)maxd) ? u1[r] : -INFINITY; }
    }
    float tmax = fmaxf(u0[0], u1[0]);
#pragma unroll
    for (int r = 1; r < 16; ++r) tmax = fmaxf(tmax, fmaxf(u0[r], u1[r]));
    tmax = (MODE == 0 && !okl) ? -INFINITY : tmax + zoff;
    tmax = half_max(tmax);
    if (__any(tmax > st.m)) { const float mn = fmaxf(st.m, tmax), al = __builtin_amdgcn_exp2f(C2 * (st.m - mn));
#pragma unroll
        for (int r = 0; r < 16; ++r) { st.o0[r] *= al; st.o1[r] *= al; }
        st.l *= al; st.m = mn; }
    const float off = (MODE == 0 && !okl) ? -INFINITY : C2 * (zoff - st.m);
    float ps = 0.f;
#pragma unroll
    for (int r = 0; r < 16; ++r) { u0[r] = __builtin_amdgcn_exp2f(fmaf(u0[r], C2, off)); u1[r] = __builtin_amdgcn_exp2f(fmaf(u1[r], C2, off)); ps += u0[r] + u1[r]; }
    st.l += ps;
#pragma unroll
    for (int sub = 0; sub < 2; ++sub)
#pragma unroll
        for (int s = 0; s < 2; ++s) {
            v4u pw;
            if (sub == 0) { pw.x = cvtpk(u0[8 * s], u0[8 * s + 1]); pw.y = cvtpk(u0[8 * s + 2], u0[8 * s + 3]); pw.z = cvtpk(u0[8 * s + 4], u0[8 * s + 5]); pw.w = cvtpk(u0[8 * s + 6], u0[8 * s + 7]); }
            else { pw.x = cvtpk(u1[8 * s], u1[8 * s + 1]); pw.y = cvtpk(u1[8 * s + 2], u1[8 * s + 3]); pw.z = cvtpk(u1[8 * s + 4], u1[8 * s + 5]); pw.w = cvtpk(u1[8 * s + 6], u1[8 * s + 7]); }
            const bf16x8 pb = __builtin_bit_cast(bf16x8, pw);
#pragma unroll
            for (int dblk = 0; dblk < 2; ++dblk) {
                const v4i16_t lo = __builtin_amdgcn_ds_read_tr16_b64_v4i16((LAS v4i16_t*)(vrd + (32 * sub + 16 * s) * VR + 64 * dblk));
                const v4i16_t hh = __builtin_amdgcn_ds_read_tr16_b64_v4i16((LAS v4i16_t*)(vrd + (32 * sub + 16 * s + 8) * VR + 64 * dblk));
                const bf16x8 va = __builtin_shufflevector(lo, hh, 0, 1, 2, 3, 4, 5, 6, 7);
                if (dblk == 0) st.o0 = ATT_MFMA(va, pb, st.o0); else st.o1 = ATT_MFMA(va, pb, st.o1);
            }
        }
}
template <int D>
__device__ __forceinline__ void run(St& st, const bf16x8 (&qf)[4], const unsigned char* Kb, const unsigned char* Vb, int tkb, int ntiles,
                                    int tq, int maxd, float ns, LAS unsigned char* vl, int lane) {
    const int r32 = lane & 31, hi = lane >> 5;
    LAS unsigned char* vrd = vl + (4 * hi + ((lane & 15) >> 2)) * VROW + (((lane >> 4) & 1) * 16 + (lane & 3) * 4) * 2;
    LAS unsigned char* vwr = vl + (lane >> 3) * VROW + 16 * (lane & 7);
    f32x16 b0, b1; bias_vecs<D>(b0, b1, ns);
    bf16x8 kf[2][4]; v4u vr[8];
#define ATT_LOADK(t) do { _Pragma("unroll") for (int sub = 0; sub < 2; ++sub) { const unsigned o_ = (unsigned)clampt(tkb + D * (64 * (t) + 32 * sub + r32)) * (unsigned)(NPROJ * 2) + 16u * hi; \
        _Pragma("unroll") for (int d0 = 0; d0 < 4; ++d0) kf[sub][d0] = *(const bf16x8*)(Kb + o_ + 32 * d0); } } while (0)
#define ATT_LOADV(t) do { _Pragma("unroll") for (int i2 = 0; i2 < 8; ++i2) { const unsigned o_ = (unsigned)clampt(tkb + D * (64 * (t) + (lane >> 3) + 8 * i2)) * (unsigned)(NPROJ * 2) + 16u * (lane & 7); \
        vr[i2] = *(const v4u*)(Vb + o_); } } while (0)
    ATT_LOADK(ntiles - 1); ATT_LOADV(ntiles - 1);
    for (int t = ntiles - 1; t >= 0; --t) {
#pragma unroll
        for (int i2 = 0; i2 < 8; ++i2) *(LAS v4u*)(vwr + 8 * i2 * VROW) = vr[i2];
        const int tn = (t > 0) ? t - 1 : 0;
        ATT_LOADV(tn);
        f32x16 s0 = b0, s1 = b1;
#pragma unroll
        for (int d0 = 0; d0 < 4; ++d0) { s0 = ATT_MFMA(kf[0][d0], qf[d0], s0); s1 = ATT_MFMA(kf[1][d0], qf[d0], s1); }
        ATT_LOADK(tn);
        const int tk0 = tkb + D * (64 * t + 4 * hi);
        tile_core<1, D, VROW>(st, s0, s1, ns * (float)tk0, true, tq - tk0, maxd, vrd);
    }
#undef ATT_LOADK
#undef ATT_LOADV
}
__device__ __forceinline__ void st_init(St& st) {
#pragma unroll
    for (int r = 0; r < 16; ++r) { st.o0[r] = 0.f; st.o1[r] = 0.f; }
    st.m = -1e30f; st.l = 0.f;
}
__device__ __forceinline__ void load_q(bf16x8 (&qf)[4], const bf16* qrow, int hi) {
#pragma unroll
    for (int d0 = 0; d0 < 4; ++d0) qf[d0] = *(const bf16x8*)(qrow + 16 * d0 + 8 * hi);
}
__device__ __forceinline__ void st_store(St& st, bf16* yrow, int hi) {
    const float lt = half_sum(st.l), inv = 1.0f / lt;
#pragma unroll
    for (int g = 0; g < 4; ++g) {
        unsigned long long w0 = (unsigned long long)cvtpk(st.o0[4 * g] * inv, st.o0[4 * g + 1] * inv) | ((unsigned long long)cvtpk(st.o0[4 * g + 2] * inv, st.o0[4 * g + 3] * inv) << 32);
        unsigned long long w1 = (unsigned long long)cvtpk(st.o1[4 * g] * inv, st.o1[4 * g + 1] * inv) | ((unsigned long long)cvtpk(st.o1[4 * g + 2] * inv, st.o1[4 * g + 3] * inv) << 32);
        *(unsigned long long*)(yrow + 8 * g + 4 * hi) = w0; *(unsigned long long*)(yrow + 32 + 8 * g + 4 * hi) = w1; }
}
__device__ __forceinline__ unsigned moba_select(const bf16x8 (&qf)[4], const float* kms, int b, int h, int blk, int r32, int hi, unsigned& picks) {
    f32x16 gt;
#pragma unroll
    for (int r = 0; r < 16; ++r) gt[r] = 0.f;
    { const float* kp = kms + ((size_t)((b * 16 + (r32 & 15)) * 4 + h)) * 64 + 8 * hi;
#pragma unroll
      for (int d0 = 0; d0 < 4; ++d0) { const f32x4 a = *(const f32x4*)(kp + 16 * d0) * (1.0f / 256.0f), c = *(const f32x4*)(kp + 16 * d0 + 4) * (1.0f / 256.0f);
          v4u hw, lw; hw.x = cvtpk(a.x, a.y); hw.y = cvtpk(a.z, a.w); hw.z = cvtpk(c.x, c.y); hw.w = cvtpk(c.z, c.w);
          lw.x = cvtpk(a.x - blo(hw.x), a.y - bhi(hw.x)); lw.y = cvtpk(a.z - blo(hw.y), a.w - bhi(hw.y)); lw.z = cvtpk(c.x - blo(hw.z), c.y - bhi(hw.z)); lw.w = cvtpk(c.z - blo(hw.w), c.w - bhi(hw.w));
          gt = ATT_MFMA(__builtin_bit_cast(bf16x8, hw), qf[d0], gt); gt = ATT_MFMA(__builtin_bit_cast(bf16x8, lw), qf[d0], gt); } }
    float og[8];
#pragma unroll
    for (int r = 0; r < 8; ++r) og[r] = __shfl_xor(gt[r], 32);
    float G[16];
#pragma unroll
    for (int n = 0; n < 16; ++n) { const int rn = (n & 3) + 4 * (n >> 3); G[n] = (((n >> 2) & 1) == hi) ? gt[rn] : og[rn]; }
    unsigned selmask = 0u; picks = 0xfffu;
#pragma unroll
    for (int s = 0; s < 3; ++s) { float bv = -INFINITY; int best = -1;
#pragma unroll
        for (int n = 0; n < 16; ++n) { if (n < blk && !((selmask >> n) & 1u) && G[n] > bv) { bv = G[n]; best = n; } }
        if (best >= 0) { selmask |= 1u << best; picks = (picks & ~(15u << (4 * s))) | ((unsigned)best << (4 * s)); } }
    return selmask;
}
}

constexpr size_t WS_PAO = 248 * MiB, WS_PAM = 54 * MiB, WS_PAL = 54 * MiB + 256 * 1024;
namespace attc {
constexpr int KROW = 144, VROWC = 192;
constexpr int KT_BYTES = 128 * KROW, VT_BYTES_C = 128 * VROWC, STAGE = KT_BYTES + VT_BYTES_C;
}
__device__ __forceinline__ void mixA1_coop(Frame& F) {
    using namespace att;
    unsigned char* ws = ARGWS();
    const bf16* proj = (const bf16*)(ws + WS_PROJ); bf16* pao = (bf16*)(ws + WS_PAO); float* pam = (float*)(ws + WS_PAM); float* pal = (float*)(ws + WS_PAL);
    const int lane = F.lane, r32 = lane & 31, hi = lane >> 5, w = F.wave, tid = F.tid;
    LAS unsigned char* L0 = F.lds + RING_OFF;
    const int bh = F.vcu >> 4, qb = F.vcu & 15, b = bh >> 2, h = bh & 3, rowb = b * SEQ, t0 = 256 * qb, tq = t0 + 32 * w + r32;
    const float ns = 8.0f * exp2f(-(float)(2 * h + 1));
    const bf16* Kg = proj + (size_t)rowb * NPROJ + OFF_KA + h * 64; const bf16* Vg = proj + (size_t)rowb * NPROJ + OFF_VA + h * 64;
    const int lrow0 = tid >> 3, lch = tid & 7;
    const int koff = lrow0 * attc::KROW + 16 * lch, voff = attc::KT_BYTES + lrow0 * attc::VROWC + 16 * lch;
    const int kfo = r32 * attc::KROW + 16 * hi;
    const int vfo = attc::KT_BYTES + (4 * hi + ((lane & 15) >> 2)) * attc::VROWC + (((lane >> 4) & 1) * 16 + (lane & 3) * 4) * 2;
    f32x16 b0, b1; bias_vecs<1>(b0, b1, ns);
    bf16x8 qf[4]; load_q(qf, proj + (size_t)(rowb + tq) * NPROJ + OFF_QA + h * 64, hi);
    St st; st_init(st);
    const int s_lo = (qb == 0) ? 1 : 0;
    v4u kr[2], vr[2];
#define MA_LOAD(s) do { _Pragma("unroll") for (int j = 0; j < 2; ++j) { const size_t o_ = (size_t)(t0 - 128 + 128 * (s) + 64 * j + lrow0) * NPROJ + 8 * lch; kr[j] = *(const v4u*)(Kg + o_); vr[j] = *(const v4u*)(Vg + o_); } } while (0)
#define MA_STORE(buf) do { LAS unsigned char* sb_ = L0 + (buf) * attc::STAGE; _Pragma("unroll") for (int j = 0; j < 2; ++j) { *(LAS v4u*)(sb_ + koff + 64 * j * attc::KROW) = kr[j]; *(LAS v4u*)(sb_ + voff + 64 * j * attc::VROWC) = vr[j]; } } while (0)
    __syncthreads();
    MA_LOAD(2); MA_STORE(0); MA_LOAD(1);
#pragma unroll 1
    for (int i = 0; i < 3 - s_lo; ++i) {
        const int s = 2 - i;
        __syncthreads();
        if (s - 1 >= s_lo) { MA_STORE((i + 1) & 1); if (s - 2 >= s_lo) MA_LOAD(s - 2); }
        LAS unsigned char* sb = L0 + (i & 1) * attc::STAGE;
#pragma unroll
        for (int u = 1; u >= 0; --u) {
            const int ta = t0 - 128 + 128 * s + 64 * u;
            if (ta <= t0 + 32 * w + 31 && ta + 63 >= t0 + 32 * w - 128) {
                bf16x8 kf[2][4];
#pragma unroll
                for (int sub = 0; sub < 2; ++sub)
#pragma unroll
                    for (int d0 = 0; d0 < 4; ++d0) kf[sub][d0] = *(const LAS bf16x8*)(sb + kfo + (64 * u + 32 * sub) * attc::KROW + 32 * d0);
                f32x16 s0 = b0, s1 = b1;
#pragma unroll
                for (int d0 = 0; d0 < 4; ++d0) { s0 = ATT_MFMA(kf[0][d0], qf[d0], s0); s1 = ATT_MFMA(kf[1][d0], qf[d0], s1); }
                const int tk0 = ta + 4 * hi;
                tile_core<1, 1, attc::VROWC>(st, s0, s1, ns * (float)tk0, true, tq - tk0, tq < 128 ? tq : 128, sb + vfo + 64 * u * attc::VROWC);
            }
        }
    }
#undef MA_LOAD
#undef MA_STORE
    const float lt = half_sum(st.l), inv = 1.0f / lt;
    bf16* orow = pao + ((size_t)(rowb + tq) * 4 + h) * 64;
#pragma unroll
    for (int g = 0; g < 4; ++g) {
        unsigned long long w0 = (unsigned long long)cvtpk(st.o0[4 * g] * inv, st.o0[4 * g + 1] * inv) | ((unsigned long long)cvtpk(st.o0[4 * g + 2] * inv, st.o0[4 * g + 3] * inv) << 32);
        unsigned long long w1 = (unsigned long long)cvtpk(st.o1[4 * g] * inv, st.o1[4 * g + 1] * inv) | ((unsigned long long)cvtpk(st.o1[4 * g + 2] * inv, st.o1[4 * g + 3] * inv) << 32);
        *(unsigned long long*)(orow + 8 * g + 4 * hi) = w0; *(unsigned long long*)(orow + 32 + 8 * g + 4 * hi) = w1; }
    if (hi == 0) { pam[(size_t)(rowb + tq) * 4 + h] = st.m; pal[(size_t)(rowb + tq) * 4 + h] = lt; }
    __syncthreads();
}
__device__ __forceinline__ void mixA23_mfma(Frame& F) {
    unsigned char* ws = ARGWS();
    const bf16* proj = (const bf16*)(ws + WS_PROJ); bf16* y = (bf16*)(ws + WS_Y);
    const bf16* pao = (const bf16*)(ws + WS_PAO); const float* pam = (const float*)(ws + WS_PAM); const float* pal = (const float*)(ws + WS_PAL);
    const int lane = F.lane, r32 = lane & 31, hi = lane >> 5, w = F.wave;
    LAS unsigned char* vl = F.lds + RING_OFF + w * att::VT_BYTES;
    const int gw = F.vcu * NWAVES + w;
    const int bh = gw >> 7, r16 = (gw >> 3) & 15, ig = gw & 7;
    const int b = bh >> 2, h = bh & 3, rowb = b * SEQ, tq0 = r16 + 512 * ig, tq = tq0 + 16 * r32;
    bf16x8 qf[4]; att::load_q(qf, proj + (size_t)(rowb + tq) * NPROJ + OFF_QA + h * 64, hi);
    att::St st; att::st_init(st);
    const float ns = 8.0f * exp2f(-(float)(2 * h + 1));
    const unsigned char* Kb = (const unsigned char*)(proj + (size_t)rowb * NPROJ + OFF_KA + h * 64); const unsigned char* Vb = (const unsigned char*)(proj + (size_t)rowb * NPROJ + OFF_VA + h * 64);
    att::run<4>(st, qf, Kb, Vb, tq0 - 512, 4, tq, tq < 512 ? tq : 512, ns, vl, lane);
    att::run<16>(st, qf, Kb, Vb, tq0 - 2048, 3, tq, tq < 2048 ? tq : 2048, ns, vl, lane);
    const size_t pidx = (size_t)(rowb + tq) * 4 + h;
    const float m1 = pam[pidx], l1 = pal[pidx], l2 = att::half_sum(st.l), mm = fmaxf(st.m, m1);
    const float a2 = __builtin_amdgcn_exp2f(att::C2 * (st.m - mm)), a1 = __builtin_amdgcn_exp2f(att::C2 * (m1 - mm)) * l1;
    const float inv = 1.0f / (l2 * a2 + a1);
    const bf16* orow = pao + pidx * 64; bf16* yrow = y + (size_t)(rowb + tq) * DM + h * 64;
#pragma unroll
    for (int g = 0; g < 4; ++g) {
        const unsigned long long p0 = *(const unsigned long long*)(orow + 8 * g + 4 * hi), p1 = *(const unsigned long long*)(orow + 32 + 8 * g + 4 * hi);
        const float q0[4] = {blo((unsigned)p0), bhi((unsigned)p0), blo((unsigned)(p0 >> 32)), bhi((unsigned)(p0 >> 32))};
        const float q1[4] = {blo((unsigned)p1), bhi((unsigned)p1), blo((unsigned)(p1 >> 32)), bhi((unsigned)(p1 >> 32))};
        float r0[4], r1[4];
#pragma unroll
        for (int e = 0; e < 4; ++e) { r0[e] = (st.o0[4 * g + e] * a2 + q0[e] * a1) * inv; r1[e] = (st.o1[4 * g + e] * a2 + q1[e] * a1) * inv; }
        *(unsigned long long*)(yrow + 8 * g + 4 * hi) = (unsigned long long)att::cvtpk(r0[0], r0[1]) | ((unsigned long long)att::cvtpk(r0[2], r0[3]) << 32);
        *(unsigned long long*)(yrow + 32 + 8 * g + 4 * hi) = (unsigned long long)att::cvtpk(r1[0], r1[1]) | ((unsigned long long)att::cvtpk(r1[2], r1[3]) << 32); }
}
constexpr size_t WS_MCNT = 768 * 1024;
constexpr size_t WS_MLIST = 51 * MiB + 512 * 1024;
constexpr size_t WS_MPM = 52 * MiB + 512 * 1024, WS_MPL = 53 * MiB + 256 * 1024;
__device__ __forceinline__ int moba_list_base(int b, int h, int j) { return (b * 4 + h) * 30720 + 256 * (15 * j - ((j * (j - 1)) >> 1)); }
__device__ __forceinline__ void moba_build(Frame& F, int l) {
    using namespace att;
    unsigned char* ws = ARGWS();
    const bf16* proj = (const bf16*)(ws + WS_PROJ); const float* kms = (const float*)(ws + WS_KMS) + (size_t)l * (BATCH * 16 * 4 * 64);
    unsigned* cnt = (unsigned*)(ws + WS_MCNT) + l * 256; unsigned short* list = (unsigned short*)(ws + WS_MLIST);
    const int lane = F.lane, r32 = lane & 31, hi = lane >> 5, w = F.wave;
    const int bh = F.vcu >> 4, blk = F.vcu & 15, b = bh >> 2, h = bh & 3, rowb = b * SEQ, tq = 256 * blk + 32 * w + r32;
    if (blk == 0) return;
    bf16x8 qf[4]; load_q(qf, proj + (size_t)(rowb + tq) * NPROJ + OFF_QC + h * 64, hi);
    unsigned picks; (void)moba_select(qf, kms, b, h, blk, r32, hi, picks);
    const int p0 = picks & 15, p1 = (picks >> 4) & 15, p2 = (picks >> 8) & 15;
    unsigned cntv = 0u;
#pragma unroll 1
    for (int j = 0; j < blk; ++j) { const bool pr = (hi == 0) && (p0 == j || p1 == j || p2 == j); const unsigned long long bal = __ballot(pr); if (lane == j) cntv = (unsigned)__popcll(bal); }
    unsigned basev = 0u;
    if (lane < 15 && cntv > 0u) basev = atomicAdd(cnt + (b * 4 + h) * 16 + lane, cntv);
#pragma unroll 1
    for (int j = 0; j < blk; ++j) { {
        const bool pr = (hi == 0) && (p0 == j || p1 == j || p2 == j); const unsigned long long bal = __ballot(pr);
        if (bal) { const unsigned bj = (unsigned)__shfl((int)basev, j);
            if (pr) { const unsigned pos = bj + (unsigned)__popcll(bal & ((1ull << lane) - 1ull)); const unsigned slot = (p0 == j) ? 0u : (p1 == j) ? 1u : 2u;
                list[moba_list_base(b, h, j) + pos] = (unsigned short)((unsigned)tq | (slot << 12)); } } } }
}
__device__ __forceinline__ void moba_lists(Frame& F, int l) {
    using namespace att;
    unsigned char* ws = ARGWS();
    const bf16* proj = (const bf16*)(ws + WS_PROJ);
    const unsigned* cnt = (const unsigned*)(ws + WS_MCNT) + l * 256; const unsigned short* list = (const unsigned short*)(ws + WS_MLIST);
    unsigned char* PB = (l == 0) ? (unsigned char*)ARGOUT() : ws + WS_W;
    float* pm = (float*)(ws + WS_MPM); float* pl = (float*)(ws + WS_MPL);
    asm volatile("" : "+v"(pm), "+v"(pl), "+v"(PB));
    const int lane = F.lane, r32 = lane & 31, hi = lane >> 5, w = F.wave, tid = F.tid;
    LAS unsigned char* L0 = F.lds + RING_OFF;
    constexpr int KB_BYTES = 256 * attc::KROW, VB_BYTES = 256 * attc::VROWC;
    LAS unsigned* cin = (LAS unsigned*)(L0 + KB_BYTES + VB_BYTES); LAS unsigned* pre = cin + 256;
    __syncthreads();
    unsigned cmine = 0u, cinc = 0u;
    constexpr unsigned SEGW = 256u;
    if (tid < 256) { cmine = cnt[tid]; cmine = cmine ? cmine + SEGW : 0u; cinc = cmine;
#pragma unroll
        for (int o = 1; o < 64; o <<= 1) { const unsigned t_ = (unsigned)__shfl_up((int)cinc, o); if (lane >= o) cinc += t_; }
        if (lane == 63) cin[w] = cinc; }
    __syncthreads();
    if (tid < 256) { unsigned off = 0u;
#pragma unroll
        for (int i = 0; i < 3; ++i) if (i < w) off += cin[i];
        pre[tid] = off + cinc - cmine; if (tid == 255) pre[256] = off + cinc; }
    __syncthreads();
    const unsigned T = pre[256];
    const unsigned lo = (unsigned)(((unsigned long long)T * (unsigned)F.vcu) >> 8), hi_ = (unsigned)(((unsigned long long)T * (unsigned)(F.vcu + 1)) >> 8);
    LAS unsigned* lrng = pre + 260;
    if (tid == 0) { lrng[0] = 256u; lrng[1] = 0u; }
    __syncthreads();
    if (tid < 256) { const unsigned sL = pre[tid] + SEGW, eL = pre[tid + 1]; if (eL > sL && sL < hi_ && eL > lo) { atomicMin((unsigned*)lrng, (unsigned)tid); atomicMax((unsigned*)lrng + 1, (unsigned)tid); } }
    __syncthreads();
    const int Lfirst = (int)lrng[0], Llast = (int)lrng[1];
    const int kfo = r32 * attc::KROW + 16 * hi;
    const int vfo = KB_BYTES + (4 * hi + ((lane & 15) >> 2)) * attc::VROWC + (((lane >> 4) & 1) * 16 + (lane & 3) * 4) * 2;
#pragma unroll 1
    for (int L = Lfirst; L <= Llast; ++L) {
        const unsigned sL = pre[L] + SEGW, eL = pre[L + 1]; const unsigned a = lo > sL ? lo : sL, e = hi_ < eL ? hi_ : eL;
        if (a >= e) continue;
        const int bh = L >> 4, j = L & 15, b = bh >> 2, h = bh & 3, rowb = b * SEQ;
        const float ns = 8.0f * exp2f(-(float)(2 * h + 2));
        const int lb = moba_list_base(b, h, j) - (int)sL;
        const int nt = (int)((e - a + 31u) >> 5);
        unsigned ent_n = 0u;
        if (w < nt) { const unsigned idx0 = a + 32u * (unsigned)w + (unsigned)r32; ent_n = list[lb + (int)(idx0 < e ? idx0 : a)]; }
        __syncthreads();
        { const bf16* Kg = proj + (size_t)(rowb + 256 * j) * NPROJ + OFF_KC + h * 64; const bf16* Vg = proj + (size_t)(rowb + 256 * j) * NPROJ + OFF_VC + h * 64;
          v4u kr[4], vr[4];
#pragma unroll
          for (int i = 0; i < 4; ++i) { const int c = tid + 512 * i, row = c >> 3, ch = c & 7; kr[i] = *(const v4u*)(Kg + (size_t)row * NPROJ + 8 * ch); vr[i] = *(const v4u*)(Vg + (size_t)row * NPROJ + 8 * ch); }
#pragma unroll
          for (int i = 0; i < 4; ++i) { const int c = tid + 512 * i, row = c >> 3, ch = c & 7; *(LAS v4u*)(L0 + row * attc::KROW + 16 * ch) = kr[i]; *(LAS v4u*)(L0 + KB_BYTES + row * attc::VROWC + 16 * ch) = vr[i]; } }
        __syncthreads();
#pragma unroll 1
        for (int t = w; t < nt; t += NWAVES) {
            const unsigned idx = a + 32u * (unsigned)t + (unsigned)r32; const bool valid = idx < e;
            const unsigned ent = ent_n; const int tq = (int)(ent & 4095u); const unsigned slot = ent >> 12;
            bf16x8 qf[4]; load_q(qf, proj + (size_t)(rowb + tq) * NPROJ + OFF_QC + h * 64, hi);
            if (t + NWAVES < nt) { const unsigned idx1 = idx + 32u * NWAVES; ent_n = list[lb + (int)(idx1 < e ? idx1 : a)]; }
            St st; st_init(st);
#pragma unroll 1
            for (int kt = 3; kt >= 0; --kt) {
                bf16x8 kf[2][4];
#pragma unroll
                for (int sub = 0; sub < 2; ++sub)
#pragma unroll
                    for (int d0 = 0; d0 < 4; ++d0) kf[sub][d0] = *(const LAS bf16x8*)(L0 + kfo + (64 * kt + 32 * sub) * attc::KROW + 32 * d0);
                f32x16 s0, s1; bias_vecs<1>(s0, s1, ns);
#pragma unroll
                for (int d0 = 0; d0 < 4; ++d0) { s0 = ATT_MFMA(kf[0][d0], qf[d0], s0); s1 = ATT_MFMA(kf[1][d0], qf[d0], s1); }
                tile_core<0, 1, attc::VROWC>(st, s0, s1, ns * (float)(256 * j + 64 * kt + 4 * hi), valid, 0, 0, L0 + vfo + 64 * kt * attc::VROWC);
            }
            const float lt = half_sum(st.l), inv = 1.0f / lt;
            if (valid) {
                const size_t pidx = (size_t)(rowb + tq) * 4 + h;
                bf16* orow = (bf16*)(PB + (size_t)slot * (8 * MiB)) + pidx * 64;
#pragma unroll
                for (int g = 0; g < 4; ++g) {
                    unsigned long long w0 = (unsigned long long)cvtpk(st.o0[4 * g] * inv, st.o0[4 * g + 1] * inv) | ((unsigned long long)cvtpk(st.o0[4 * g + 2] * inv, st.o0[4 * g + 3] * inv) << 32);
                    unsigned long long w1 = (unsigned long long)cvtpk(st.o1[4 * g] * inv, st.o1[4 * g + 1] * inv) | ((unsigned long long)cvtpk(st.o1[4 * g + 2] * inv, st.o1[4 * g + 3] * inv) << 32);
                    *(unsigned long long*)(orow + 8 * g + 4 * hi) = w0; *(unsigned long long*)(orow + 32 + 8 * g + 4 * hi) = w1; }
                if (hi == 0) { pm[(size_t)slot * (M * 4) + pidx] = st.m; pl[(size_t)slot * (M * 4) + pidx] = lt; }
            }
        }
    }
    __syncthreads();
}
__device__ __forceinline__ void moba_own256_merge(Frame& F, int l) {
    using namespace att;
    unsigned char* ws = ARGWS();
    const bf16* proj = (const bf16*)(ws + WS_PROJ); bf16* y = (bf16*)(ws + WS_Y);
    const unsigned char* PB = (l == 0) ? (const unsigned char*)ARGOUT() : ws + WS_W;
    const float* pm = (const float*)(ws + WS_MPM); const float* pl = (const float*)(ws + WS_MPL);
    const int lane = F.lane, r32 = lane & 31, hi = lane >> 5, w = F.wave, tid = F.tid;
    LAS unsigned char* L0 = F.lds + RING_OFF;
    constexpr int KB_BYTES = 256 * attc::KROW;
    const int bh = F.vcu >> 4, blk = F.vcu & 15, b = bh >> 2, h = bh & 3, rowb = b * SEQ, tq = 256 * blk + 32 * w + r32;
    const float ns = 8.0f * exp2f(-(float)(2 * h + 2));
    const int kfo = r32 * attc::KROW + 16 * hi;
    const int vfo = KB_BYTES + (4 * hi + ((lane & 15) >> 2)) * attc::VROWC + (((lane >> 4) & 1) * 16 + (lane & 3) * 4) * 2;
    bf16x8 qf[4]; load_q(qf, proj + (size_t)(rowb + tq) * NPROJ + OFF_QC + h * 64, hi);
    __syncthreads();
    { const bf16* Kg = proj + (size_t)(rowb + 256 * blk) * NPROJ + OFF_KC + h * 64; const bf16* Vg = proj + (size_t)(rowb + 256 * blk) * NPROJ + OFF_VC + h * 64;
      v4u kr[4], vr[4];
#pragma unroll
      for (int i = 0; i < 4; ++i) { const int c = tid + 512 * i, row = c >> 3, ch = c & 7; kr[i] = *(const v4u*)(Kg + (size_t)row * NPROJ + 8 * ch); vr[i] = *(const v4u*)(Vg + (size_t)row * NPROJ + 8 * ch); }
#pragma unroll
      for (int i = 0; i < 4; ++i) { const int c = tid + 512 * i, row = c >> 3, ch = c & 7; *(LAS v4u*)(L0 + row * attc::KROW + 16 * ch) = kr[i]; *(LAS v4u*)(L0 + KB_BYTES + row * attc::VROWC + 16 * ch) = vr[i]; } }
    const size_t pidx = (size_t)(rowb + tq) * 4 + h; const int nsel = blk < 3 ? blk : 3;
    float mp[3], lp[3];
#pragma unroll
    for (int s = 0; s < 3; ++s) { mp[s] = -1e30f; lp[s] = 0.f; if (s < nsel) { mp[s] = pm[(size_t)s * (M * 4) + pidx]; lp[s] = pl[(size_t)s * (M * 4) + pidx]; } }
    __syncthreads();
    St st; st_init(st);
    const int ktl = w >> 1;
#pragma unroll 1
    for (int kt = ktl; kt >= 0; --kt) {
        bf16x8 kf[2][4];
#pragma unroll
        for (int sub = 0; sub < 2; ++sub)
#pragma unroll
            for (int d0 = 0; d0 < 4; ++d0) kf[sub][d0] = *(const LAS bf16x8*)(L0 + kfo + (64 * kt + 32 * sub) * attc::KROW + 32 * d0);
        f32x16 s0, s1; bias_vecs<1>(s0, s1, ns);
#pragma unroll
        for (int d0 = 0; d0 < 4; ++d0) { s0 = ATT_MFMA(kf[0][d0], qf[d0], s0); s1 = ATT_MFMA(kf[1][d0], qf[d0], s1); }
        const int tk0 = 256 * blk + 64 * kt + 4 * hi;
        if (kt == ktl) tile_core<1, 1, attc::VROWC>(st, s0, s1, ns * (float)tk0, true, tq - tk0, BIGD, L0 + vfo + 64 * kt * attc::VROWC);
        else tile_core<0, 1, attc::VROWC>(st, s0, s1, ns * (float)tk0, true, 0, 0, L0 + vfo + 64 * kt * attc::VROWC);
    }
    float mm = st.m;
#pragma unroll
    for (int s = 0; s < 3; ++s) mm = fmaxf(mm, mp[s]);
    const float a1 = __builtin_amdgcn_exp2f(C2 * (st.m - mm));
    float ap[3];
#pragma unroll
    for (int s = 0; s < 3; ++s) ap[s] = __builtin_amdgcn_exp2f(C2 * (mp[s] - mm)) * lp[s];
    const float inv = 1.0f / (half_sum(st.l) * a1 + ap[0] + ap[1] + ap[2]);
    bf16* yrow = y + (size_t)(rowb + tq) * DM + 768 + h * 64;
#pragma unroll
    for (int g = 0; g < 4; ++g) {
        float r0[4], r1[4];
#pragma unroll
        for (int e = 0; e < 4; ++e) { r0[e] = st.o0[4 * g + e] * a1; r1[e] = st.o1[4 * g + e] * a1; }
#pragma unroll
        for (int s = 0; s < 3; ++s) { if (s < nsel) {
            const bf16* orow = (const bf16*)(PB + (size_t)s * (8 * MiB)) + pidx * 64;
            const unsigned long long p0 = *(const unsigned long long*)(orow + 8 * g + 4 * hi), p1 = *(const unsigned long long*)(orow + 32 + 8 * g + 4 * hi);
            r0[0] += blo((unsigned)p0) * ap[s]; r0[1] += bhi((unsigned)p0) * ap[s]; r0[2] += blo((unsigned)(p0 >> 32)) * ap[s]; r0[3] += bhi((unsigned)(p0 >> 32)) * ap[s];
            r1[0] += blo((unsigned)p1) * ap[s]; r1[1] += bhi((unsigned)p1) * ap[s]; r1[2] += blo((unsigned)(p1 >> 32)) * ap[s]; r1[3] += bhi((unsigned)(p1 >> 32)) * ap[s]; } }
        *(unsigned long long*)(yrow + 8 * g + 4 * hi) = (unsigned long long)cvtpk(r0[0] * inv, r0[1] * inv) | ((unsigned long long)cvtpk(r0[2] * inv, r0[3] * inv) << 32);
        *(unsigned long long*)(yrow + 32 + 8 * g + 4 * hi) = (unsigned long long)cvtpk(r1[0] * inv, r1[1] * inv) | ((unsigned long long)cvtpk(r1[2] * inv, r1[3] * inv) << 32); }
    __syncthreads();
}

namespace ssd {
typedef float f32x16 __attribute__((ext_vector_type(16)));
typedef short v4i16_t __attribute__((ext_vector_type(4)));
constexpr int RS_BTR = 320, RS_XTR = 576;
constexpr int RS_ROW = 272;
constexpr int RS_XH = 192;
#define SSD_MFMA(a, b, c) __builtin_amdgcn_mfma_f32_32x32x16_bf16((a), (b), (c), 0, 0, 0)
__device__ __forceinline__ bf16x8 trpair(LAS unsigned char* p, int rs4  ) {
    const v4i16_t lo = __builtin_amdgcn_ds_read_tr16_b64_v4i16((LAS v4i16_t*)p);
    const v4i16_t hh = __builtin_amdgcn_ds_read_tr16_b64_v4i16((LAS v4i16_t*)(p + rs4));
    return __builtin_shufflevector(lo, hh, 0, 1, 2, 3, 4, 5, 6, 7);
}
__device__ __forceinline__ float chunk_acs(float d0, float d1  , float A, LAS float* acs, LAS float* dts, int lane) {
    float s0 = d0 * A, s1 = d1 * A;
#pragma unroll
    for (int o = 1; o < 64; o <<= 1) { const float t0 = __shfl_up(s0, o), t1 = __shfl_up(s1, o); if (lane >= o) { s0 += t0; s1 += t1; } }
    const float tot0 = __shfl(s0, 63); s1 += tot0;
    acs[lane] = s0; acs[64 + lane] = s1; dts[lane] = d0; dts[64 + lane] = d1;
    return __shfl(s1, 63);
}
__device__ __forceinline__ void conv_load(v4u (&raw)[11], const bf16* proj, int rowg0, bool first_chunk, int rb, int c0) {
#pragma unroll
    for (int j = 0; j < 11; ++j) { const int rr = 8 * rb - 3 + j;
        if (first_chunk && rr < 0) raw[j] = (v4u){0u, 0u, 0u, 0u}; else raw[j] = *(const v4u*)(proj + (size_t)(rowg0 + rr) * NPROJ + OFF_XBC + c0); }
}
__device__ __forceinline__ void conv_compute(const v4u (&raw)[11], const float* cw, const float* cb, int rb, int c0, LAS unsigned char* dst, int rs, const LAS float* rowscale) {
    float w[4][8], bs[8];
#pragma unroll
    for (int j = 0; j < 4; ++j) { const f32x4 a = *(const f32x4*)(cw + j * 1024 + c0), b = *(const f32x4*)(cw + j * 1024 + c0 + 4);
        w[j][0] = a.x; w[j][1] = a.y; w[j][2] = a.z; w[j][3] = a.w; w[j][4] = b.x; w[j][5] = b.y; w[j][6] = b.z; w[j][7] = b.w; }
    { const f32x4 a = *(const f32x4*)(cb + c0), b = *(const f32x4*)(cb + c0 + 4); bs[0] = a.x; bs[1] = a.y; bs[2] = a.z; bs[3] = a.w; bs[4] = b.x; bs[5] = b.y; bs[6] = b.z; bs[7] = b.w; }
#pragma unroll
    for (int r = 0; r < 8; ++r) {
        float o[8];
#pragma unroll
        for (int e = 0; e < 8; ++e) o[e] = bs[e];
#pragma unroll
        for (int j = 0; j < 4; ++j) { const v4u u = raw[r + j];
            o[0] += w[j][0] * blo(u.x); o[1] += w[j][1] * bhi(u.x); o[2] += w[j][2] * blo(u.y); o[3] += w[j][3] * bhi(u.y);
            o[4] += w[j][4] * blo(u.z); o[5] += w[j][5] * bhi(u.z); o[6] += w[j][6] * blo(u.w); o[7] += w[j][7] * bhi(u.w); }
        const float sc = rowscale ? rowscale[8 * rb + r] : 1.0f;
#pragma unroll
        for (int e = 0; e < 8; ++e) o[e] = o[e] * __builtin_amdgcn_rcpf(1.0f + __builtin_amdgcn_exp2f(-1.4426950408889634f * o[e])) * sc;
        v4u q; q.x = pk2(o[0], o[1]); q.y = pk2(o[2], o[3]); q.z = pk2(o[4], o[5]); q.w = pk2(o[6], o[7]);
        *(LAS v4u*)(dst + (8 * rb + r) * rs) = q;
    }
}
}
constexpr size_t WS_CDEC = 50 * MiB + 512 * 1024;

__device__ __forceinline__ void ssd_states(Frame& F, int l) {
    unsigned char* ws = ARGWS();
    const bf16* proj = (const bf16*)(ws + WS_PROJ); const float* dt = (const float*)(ws + WS_DT); float* states = (float*)(ws + WS_ST); float* cdec = (float*)(ws + WS_CDEC);
    const float* cw = ARGF(7) + (size_t)l * 4 * 1024; const float* cb = ARGF(8) + (size_t)l * 1024; const float* alog = ARGF(10) + l * 8;
    const int lane = F.lane, w = F.wave, tid = F.tid, hi = lane >> 5;
    LAS float* acs = (LAS float*)(F.lds + RING_OFF);
    LAS float* wl = acs + 512;
    LAS unsigned char* Bt = F.lds + RING_OFF + 4096;
    LAS unsigned char* Xt = Bt + 128 * ssd::RS_BTR;
    for (int u = F.vcu; u < BATCH * 32 * 2; u += F.G) {
        const int b = u >> 6, c = (u >> 1) & 31, g = u & 1, rowg0 = b * SEQ + c * 128;
        v4u rawx[11], rawb[11];
        ssd::conv_load(rawx, proj, rowg0, c == 0, tid >> 5, g * 256 + 8 * (tid & 31));
        if (tid < 256) ssd::conv_load(rawb, proj, rowg0, c == 0, tid >> 4, 512 + g * 128 + 8 * (tid & 15));
        float dta = 0.f, dtb = 0.f, Ah = 0.f;
        if (w < 4) { dta = dt[(size_t)(rowg0 + lane) * 8 + 4 * g + w]; dtb = dt[(size_t)(rowg0 + 64 + lane) * 8 + 4 * g + w]; Ah = alog[4 * g + w]; }
        __syncthreads();
        if (w < 4) { const int hh = 4 * g + w; const float A = -__expf(Ah);
            const float last = ssd::chunk_acs(dta, dtb, A, acs + 128 * w, wl + 128 * w, lane);
            const float a0 = acs[128 * w + lane], a1 = acs[128 * w + 64 + lane];
            wl[128 * w + lane] = wl[128 * w + lane] * __expf(last - a0); wl[128 * w + 64 + lane] = wl[128 * w + 64 + lane] * __expf(last - a1);
            if (lane == 0) cdec[(size_t)(b * 32 + c) * 8 + hh] = __expf(last); }
        __syncthreads();
        { const int rb = tid >> 5, ch = tid & 31, c0 = g * 256 + 8 * ch;
          ssd::conv_compute(rawx, cw, cb, rb, c0, Xt + 16 * ch, ssd::RS_XTR, wl + 128 * (ch >> 3)); }
        if (tid < 256) { const int rb = tid >> 4, ch = tid & 15, c0 = 512 + g * 128 + 8 * ch;
          ssd::conv_compute(rawb, cw, cb, rb, c0, Bt + 16 * ch, ssd::RS_BTR, nullptr); }
        __syncthreads();
        { const int hl = w >> 1, ph = w & 1, hh = 4 * g + hl;
          LAS unsigned char* xa = Xt + (8 * hi + ((lane & 15) >> 2)) * ssd::RS_XTR + (hl * 64 + 32 * ph + 16 * ((lane >> 4) & 1) + 4 * (lane & 3)) * 2;
          LAS unsigned char* ba = Bt + (8 * hi + ((lane & 15) >> 2)) * ssd::RS_BTR + (16 * ((lane >> 4) & 1) + 4 * (lane & 3)) * 2;
          float* sp = states + ((size_t)((b * 32 + c) * 8 + hh)) * 8192 + (size_t)(32 * ph) * 128 + (lane & 31);
#pragma unroll
          for (int nt = 0; nt < 4; ++nt) {
              ssd::f32x16 acc;
#pragma unroll
              for (int r = 0; r < 16; ++r) acc[r] = 0.f;
#pragma unroll
              for (int kk = 0; kk < 8; ++kk) {
                  const bf16x8 af = ssd::trpair(xa + 16 * kk * ssd::RS_XTR, 4 * ssd::RS_XTR);
                  const bf16x8 bfr = ssd::trpair(ba + 16 * kk * ssd::RS_BTR + 64 * nt, 4 * ssd::RS_BTR);
                  acc = SSD_MFMA(af, bfr, acc); }
#pragma unroll
              for (int r = 0; r < 16; ++r) sp[(size_t)((r & 3) + 8 * (r >> 2) + 4 * hi) * 128 + 32 * nt] = acc[r];
          } }
    }
    __syncthreads();
}
__device__ __forceinline__ void ssd_scan(Frame& F) {
    unsigned char* ws = ARGWS();
    const float* states = (const float*)(ws + WS_ST); const float* cdec = (const float*)(ws + WS_CDEC); unsigned* stb = (unsigned*)((unsigned char*)ARGOUT() + 32 * MiB);
    const int gt = F.vcu * (NWAVES * 64) + F.tid;
    if (gt < BATCH * 8 * 4096) {
        const int b = gt >> 15, h = (gt >> 12) & 7, e = gt & 4095;
        typedef float f32x2 __attribute__((ext_vector_type(2)));
        f32x2 v[32]; float dc[32];
#pragma unroll
        for (int c = 0; c < 32; ++c) { v[c] = *(const f32x2*)(states + ((size_t)((b * 32 + c) * 8 + h)) * 8192 + 2 * e); dc[c] = cdec[(size_t)(b * 32 + c) * 8 + h]; }
        f32x2 run = {0.f, 0.f};
#pragma unroll
        for (int c = 0; c < 32; ++c) { const f32x2 t = v[c]; stb[((size_t)((b * 32 + c) * 8 + h)) * 4096 + e] = pk2(run.x, run.y); run = run * dc[c] + t; }
    }
}
__device__ __forceinline__ void ssd_out(Frame& F, int l) {
    unsigned char* ws = ARGWS();
    const bf16* proj = (const bf16*)(ws + WS_PROJ); const float* dt = (const float*)(ws + WS_DT); const bf16* stb = (const bf16*)((unsigned char*)ARGOUT() + 32 * MiB); bf16* y = (bf16*)(ws + WS_Y);
    const float* cw = ARGF(7) + (size_t)l * 4 * 1024; const float* cb = ARGF(8) + (size_t)l * 1024; const float* alog = ARGF(10) + l * 8;
    const float* dsk = ARGF(11) + l * 8; const float* nw = ARGF(12) + (size_t)l * 512;
    const int lane = F.lane, w = F.wave, tid = F.tid, hi = lane >> 5, r32 = lane & 31;
    LAS float* acs = (LAS float*)(F.lds + RING_OFF);
    LAS float* dts = acs + 512;
    LAS float* rss = dts + 512;
    LAS unsigned* CBT = (LAS unsigned*)(F.lds + RING_OFF + 8192);
    LAS unsigned char* Ct = F.lds + RING_OFF + 8192 + 20480;
    LAS unsigned char* Bt = Ct + 128 * ssd::RS_ROW;
    LAS unsigned char* Xh = Bt;
    static_assert(8192 + 20480 + 128 * ssd::RS_ROW + 128 * ssd::RS_XTR <= RING_BYTES, "stage Z LDS map");
    const int wq = w & 3, pt = w >> 2;
    for (int u = F.vcu; u < BATCH * 32 * 2; u += F.G) {
        const int b = u >> 6, c = (u >> 1) & 31, g = u & 1, rowg0 = b * SEQ + c * 128;
        v4u rawbc[11], rawx[11];
        ssd::conv_load(rawbc, proj, rowg0, c == 0, (tid & 255) >> 4, 512 + (tid >> 8) * 256 + g * 128 + 8 * (tid & 15));
        ssd::conv_load(rawx, proj, rowg0, c == 0, tid >> 5, g * 256 + 8 * (tid & 31));
        float dta = 0.f, dtb = 0.f, Ah = 0.f;
        if (w < 4) { dta = dt[(size_t)(rowg0 + lane) * 8 + 4 * g + w]; dtb = dt[(size_t)(rowg0 + 64 + lane) * 8 + 4 * g + w]; Ah = alog[4 * g + w]; }
        __syncthreads();
        if (tid < 128) rss[tid] = 0.f;
        if (w < 4) { const float A = -__expf(Ah); (void)ssd::chunk_acs(dta, dtb, A, acs + 128 * w, dts + 128 * w, lane); }
        { const int rb = (tid & 255) >> 4, ch = tid & 15, which = tid >> 8, c0 = 512 + which * 256 + g * 128 + 8 * ch;
          ssd::conv_compute(rawbc, cw, cb, rb, c0, (which ? Ct : Bt) + 16 * ch, ssd::RS_ROW, nullptr); }
        __syncthreads();
#pragma unroll 1
        for (int id = w; id < 10; id += NWAVES) {
            const int tl = (id >= 6) ? 3 : (id >= 3) ? 2 : (id >= 1) ? 1 : 0, ts = id - ((tl * (tl + 1)) >> 1);
            ssd::f32x16 t16;
#pragma unroll
            for (int r = 0; r < 16; ++r) t16[r] = 0.f;
#pragma unroll
            for (int k0 = 0; k0 < 8; ++k0) { const bf16x8 bfr = *(const LAS bf16x8*)(Bt + (32 * ts + r32) * ssd::RS_ROW + (16 * k0 + 8 * hi) * 2);
                const bf16x8 cfr = *(const LAS bf16x8*)(Ct + (32 * tl + r32) * ssd::RS_ROW + (16 * k0 + 8 * hi) * 2);
                t16 = SSD_MFMA(bfr, cfr, t16); }
#pragma unroll
            for (int q = 0; q < 8; ++q) CBT[(id * 8 + q) * 64 + lane] = att::cvtpk(t16[2 * q], t16[2 * q + 1]);
        }
        __syncthreads();
        { const int rb = tid >> 5, ch = tid & 31; ssd::conv_compute(rawx, cw, cb, rb, g * 256 + 8 * ch, Xh + 16 * ch, ssd::RS_XTR, nullptr); }
        __syncthreads();
        unsigned dmask = 0u;
#pragma unroll
        for (int r = 0; r < 16; ++r) dmask |= ((((r & 3) + 8 * (r >> 2) + 4 * hi) <= r32) ? 1u : 0u) << r;
        asm volatile("" : "+v"(dmask));
        bf16x8 sfr[8];
#pragma unroll
        for (int k0 = 0; k0 < 8; ++k0) sfr[k0] = *(const bf16x8*)(stb + ((size_t)((b * 32 + c) * 8 + 4 * g)) * 8192 + (size_t)(32 * pt + r32) * 128 + 8 * hi + 16 * k0);
        ssd::f32x16 yg0, yg1, yg2, yg3;
#pragma unroll
        for (int hl = 0; hl < 4; ++hl) {
            const int hh = 4 * g + hl, lt = (wq + hl) & 3, lrow = 32 * lt + r32;
            bf16x8 cf[8];
#pragma unroll
            for (int k0 = 0; k0 < 8; ++k0) cf[k0] = *(const LAS bf16x8*)(Ct + lrow * ssd::RS_ROW + (16 * k0 + 8 * hi) * 2);
            ssd::f32x16 acc;
#pragma unroll
            for (int r = 0; r < 16; ++r) acc[r] = 0.f;
#pragma unroll
            for (int k0 = 0; k0 < 8; ++k0) acc = SSD_MFMA(sfr[k0], cf[k0], acc);
            if (hl < 3) {
#pragma unroll
                for (int k0 = 0; k0 < 8; ++k0) sfr[k0] = *(const bf16x8*)(stb + ((size_t)((b * 32 + c) * 8 + hh + 1)) * 8192 + (size_t)(32 * pt + r32) * 128 + 8 * hi + 16 * k0); }
            const float al = acs[128 * hl + lrow]; const float el = __expf(al);
#pragma unroll
            for (int r = 0; r < 16; ++r) acc[r] *= el;
            LAS unsigned char* xa = Xh + (4 * hi + ((lane & 15) >> 2)) * ssd::RS_XTR + (hl * 64 + 32 * pt + 16 * ((lane >> 4) & 1) + 4 * (lane & 3)) * 2;
            const int tid0 = (lt * (lt + 1)) >> 1;
#pragma unroll
            for (int st = 0; st < 4; ++st) { if (st <= lt) {
                float sc[16];
#pragma unroll
                for (int g4 = 0; g4 < 4; ++g4) { const int s0 = 32 * st + 8 * g4 + 4 * hi;
                    const f32x4 as = *(const LAS f32x4*)(acs + 128 * hl + s0), ds = *(const LAS f32x4*)(dts + 128 * hl + s0);
                    const unsigned c01 = CBT[((tid0 + st) * 8 + 2 * g4) * 64 + lane], c23 = CBT[((tid0 + st) * 8 + 2 * g4 + 1) * 64 + lane];
                    const float cv[4] = {blo(c01), bhi(c01), blo(c23), bhi(c23)};
#pragma unroll
                    for (int e = 0; e < 4; ++e) sc[4 * g4 + e] = cv[e] * __expf(fminf(al - as[e], 0.f)) * ds[e]; }
                if (st == lt) {
#pragma unroll
                    for (int r = 0; r < 16; ++r) sc[r] = ((dmask >> r) & 1u) ? sc[r] : 0.f; }
#pragma unroll
                for (int s2 = 0; s2 < 2; ++s2) { v4u pw; pw.x = att::cvtpk(sc[8 * s2], sc[8 * s2 + 1]); pw.y = att::cvtpk(sc[8 * s2 + 2], sc[8 * s2 + 3]); pw.z = att::cvtpk(sc[8 * s2 + 4], sc[8 * s2 + 5]); pw.w = att::cvtpk(sc[8 * s2 + 6], sc[8 * s2 + 7]);
                    const bf16x8 xf = ssd::trpair(xa + (32 * st + 16 * s2) * ssd::RS_XTR, 8 * ssd::RS_XTR);
                    acc = SSD_MFMA(xf, __builtin_bit_cast(bf16x8, pw), acc); } } }
            const float Dk = dsk[hh]; float ssq = 0.f; ssd::f32x16 yv16;
#pragma unroll
            for (int g4 = 0; g4 < 4; ++g4) { float yv[4]; const unsigned long long zz = *(const unsigned long long*)(proj + (size_t)(rowg0 + lrow) * NPROJ + OFF_Z + hh * 64 + 32 * pt + 4 * hi + 8 * g4);
                const unsigned long long xx = *(const LAS unsigned long long*)(Xh + lrow * ssd::RS_XTR + (hl * 64 + 32 * pt + 8 * g4 + 4 * hi) * 2);
                const float zf[4] = {blo((unsigned)zz), bhi((unsigned)zz), blo((unsigned)(zz >> 32)), bhi((unsigned)(zz >> 32))};
                const float xf[4] = {blo((unsigned)xx), bhi((unsigned)xx), blo((unsigned)(xx >> 32)), bhi((unsigned)(xx >> 32))};
#pragma unroll
                for (int e = 0; e < 4; ++e) { const float v = (acc[4 * g4 + e] + Dk * xf[e]) * (zf[e] * __builtin_amdgcn_rcpf(1.0f + __builtin_amdgcn_exp2f(-1.4426950408889634f * zf[e]))); yv[e] = v; ssq += v * v; yv16[4 * g4 + e] = v; } }
            if (hl == 0) yg0 = yv16; else if (hl == 1) yg1 = yv16; else if (hl == 2) yg2 = yv16; else yg3 = yv16;
            ssq += __shfl_xor(ssq, 32);
            if (hi == 0) (void)__hip_atomic_fetch_add(rss + lrow, ssq, __ATOMIC_RELAXED, __HIP_MEMORY_SCOPE_WORKGROUP);
        }
        __syncthreads();
#pragma unroll
        for (int hl = 0; hl < 4; ++hl) {
            const int lrow = 32 * ((wq + hl) & 3) + r32;
            const float rstd = 1.0f / sqrtf(rss[lrow] * (1.0f / 256.0f) + EPS);
            bf16* yr = y + (size_t)(rowg0 + lrow) * DM + 256 + g * 256 + hl * 64 + 32 * pt + 4 * hi;
            const float* nwp = nw + g * 256 + hl * 64 + 32 * pt + 4 * hi;
            const ssd::f32x16 yv = (hl == 0) ? yg0 : (hl == 1) ? yg1 : (hl == 2) ? yg2 : yg3;
#pragma unroll
            for (int g4 = 0; g4 < 4; ++g4) { const f32x4 wv = *(const f32x4*)(nwp + 8 * g4);
                *(unsigned long long*)(yr + 8 * g4) = (unsigned long long)att::cvtpk(yv[4 * g4] * rstd * wv.x, yv[4 * g4 + 1] * rstd * wv.y) | ((unsigned long long)att::cvtpk(yv[4 * g4 + 2] * rstd * wv.z, yv[4 * g4 + 3] * rstd * wv.w) << 32); } }
    }
    __syncthreads();
}

constexpr int PH_PER_LAYER = 7, N_PHASES = 1 + DEPTH * PH_PER_LAYER;
#define IN(k) (lo <= (k) && (k) < hi)
#define FRESH() do { asm volatile("" : "+s"(F.wave), "+s"(F.vcu), "+s"(F.G)); F.lane = lane_id(); asm volatile("" : "+v"(F.lane)); F.tid = F.wave * 64 + F.lane; bx = (int)blockIdx.x; asm volatile("" : "+s"(bx)); } while (0)
#define SEAM(k) do { if (IN(k) && IN((k) + 1)) { int w0_ = F.wave; asm volatile("" : "+s"(w0_)); xcd_barrier(bar, w0_ == 0 && lane_id() == 0); } } while (0)

template <int l> __device__ __forceinline__ void layer_phases(Frame& F, const int lo, const int hi, const XcdBarrier& bar) {
    int bx;
        const int pb = 1 + l * PH_PER_LAYER;
        if (IN(pb + 0)) { FRESH();
            if (l > 0) { dt_rows_b(F, (const bf16*)ARGOUT(), l); FRESH(); }
            unsigned char* ws = ARGWS(); unsigned char* wb = ws + WS_W + (size_t)l * W_LAYER;
            pg8::Gemm g{l == 0 ? (const bf16*)(ws + WS_XB) : (const bf16*)ARGOUT(), (const bf16*)(wb + W_IN), M, NPROJ, DM}; pg8::StaticOrder S; S.init(M, NPROJ, F.G, bx);
            pg8::EpiProj E{(bf16*)(ws + WS_PROJ), l == 0 ? (const float*)(ws + WS_RSTD) : (const float*)(ws + WS_SSQ2), ARGF(3) + l * 64, ARGF(4) + l * 64, ARGF(5) + l * 64, ARGF(6) + l * 64, (float*)(ws + WS_KMS) + (size_t)l * (BATCH * 16 * 4 * 64)};
            pg8::gemm_phase<pg8::EpiProj, pg8::StaticOrder, true, true>(F.lds + RING_OFF, g, S, E, F.wave);
        }
        SEAM(pb + 0);
        if (IN(pb + 1)) { FRESH(); ssd_states(F, l); FRESH(); mixA1_coop(F); FRESH(); moba_build(F, l); }
        SEAM(pb + 1);
        if (IN(pb + 2)) { FRESH(); ssd_scan(F); FRESH(); moba_lists(F, l); FRESH(); mixA23_mfma(F); }
        SEAM(pb + 2);
        if (IN(pb + 3)) { FRESH(); ssd_out(F, l); FRESH(); moba_own256_merge(F, l); }
        SEAM(pb + 3);
        if (IN(pb + 4)) { FRESH();
            unsigned char* ws = ARGWS(); unsigned char* wb = ws + WS_W + (size_t)l * W_LAYER; float* out = ARGOUT();
            pg8::Gemm g{(const bf16*)(ws + WS_Y), (const bf16*)(wb + W_OUT), M, DM, DM}; pg8::StaticOrder S; S.init(M, DM, F.G, bx);
            pg8::EpiRes1 E{l == 0 ? (const bf16*)(ws + WS_XB) : (const bf16*)out, (bf16*)(ws + WS_XB), (float*)(ws + WS_SSQ) + (size_t)l * M};
            pg8::gemm_phase<pg8::EpiRes1, pg8::StaticOrder, true, false>(F.lds + RING_OFF, g, S, E, F.wave);
        }
        SEAM(pb + 4);
        if (IN(pb + 5)) { FRESH();
            unsigned char* ws = ARGWS(); unsigned char* wb = ws + WS_W + (size_t)l * W_LAYER;
            pg8::Gemm g{(const bf16*)(ws + WS_XB), (const bf16*)(wb + W_1), M, FF, DM}; pg8::StaticOrder S; S.init(M, FF, F.G, bx);
            pg8::EpiRelu2 E{(bf16*)(ws + WS_H), (const float*)(ws + WS_SSQ) + (size_t)l * M};
            pg8::gemm_phase<pg8::EpiRelu2, pg8::StaticOrder, true, true>(F.lds + RING_OFF, g, S, E, F.wave);
        }
        SEAM(pb + 5);
        if (IN(pb + 6)) { FRESH();
            unsigned char* ws = ARGWS(); unsigned char* wb = ws + WS_W + (size_t)l * W_LAYER;
            pg8::Gemm g{(const bf16*)(ws + WS_H), (const bf16*)(wb + W_2), M, DM, FF}; pg8::StaticOrder S; S.init(M, DM, F.G, bx);
            pg8::EpiRes2 E{ARGOUT(), (const bf16*)(ws + WS_XB), (l + 1 < DEPTH) ? (bf16*)ARGOUT() : (bf16*)nullptr, (float*)(ws + WS_SSQ2)};
            pg8::gemm_phase<pg8::EpiRes2, pg8::StaticOrder, true, true>(F.lds + RING_OFF, g, S, E, F.wave);
        }
        SEAM(pb + 6);
}

struct Args { const float* in[17]; float* out; unsigned char* ws; int ph_lo, ph_hi; };
__global__ void __launch_bounds__(NWAVES * 64, 2) mk_fwd(Args args) {
    extern __shared__ __attribute__((aligned(16))) unsigned char lds[];
    Frame F;
    F.lds = (LAS unsigned char*)lds;
    F.MISC = (volatile LAS unsigned*)(F.lds + MISC_OFF);
    F.tid = threadIdx.x; F.lane = F.tid & 63; F.wave = __builtin_amdgcn_readfirstlane(F.tid >> 6);
    F.G = gridDim.x; { const int bx = blockIdx.x; F.vcu = (F.G % 8 == 0) ? (bx % 8) * (F.G / 8) + bx / 8 : bx; }
    for (int u = F.tid; u < (LDS_BYTES - LDSCTL_OFF) / 4; u += NWAVES * 64) ((LAS unsigned*)(F.lds + LDSCTL_OFF))[u] = 0u;
    __syncthreads();
    const int lo = args.ph_lo, hi = args.ph_hi;
    XcdBarrier bar; bar.bar = (unsigned*)(ARGWS() + WS_CTL) + CW_BAR; bar.x = 0; bar.st = nullptr;
    if (hi - lo > 1) bar = xcd_barrier_post((unsigned*)(ARGWS() + WS_CTL) + CW_BAR, F.MISC + 8);
    int bx;
    if (IN(0)) { FRESH(); p0_weights(F); __syncthreads(); pre_rows(F, ARGF(0), 0); }
    SEAM(0);
    layer_phases<0>(F, lo, hi, bar);
    layer_phases<1>(F, lo, hi, bar);
#undef IN
#undef SEAM
}

#ifndef MK_N_LAUNCHES
#define MK_N_LAUNCHES 1
#endif
extern "C" void kernel_launch(void* const* d_in, const int* in_sizes, int n_in, void* d_out, int out_size, void* d_ws, size_t ws_size, hipStream_t stream) {
    static int grid = 0;
    if (grid == 0) {
        if (n_in != 17 || in_sizes[0] != M * DM || out_size != M * DM || ws_size < WS_END) { fprintf(stderr, "kernel_launch: unexpected shapes (n_in %d, in0 %d, out %d, ws %zu)\n", n_in, n_in > 0 ? in_sizes[0] : -1, out_size, ws_size); grid = -1; return; }
        int dev = 0, cus = 0, per_cu = 0;
        if (hipGetDevice(&dev) != hipSuccess || hipDeviceGetAttribute(&cus, hipDeviceAttributeMultiprocessorCount, dev) != hipSuccess) { grid = -1; return; }
        if (hipFuncSetAttribute((const void*)mk_fwd, hipFuncAttributeMaxDynamicSharedMemorySize, LDS_BYTES) != hipSuccess) { fprintf(stderr, "kernel_launch: hipFuncSetAttribute failed\n"); grid = -1; return; }
        if (hipOccupancyMaxActiveBlocksPerMultiprocessor(&per_cu, (const void*)mk_fwd, NWAVES * 64, LDS_BYTES) != hipSuccess || per_cu < 1) { fprintf(stderr, "kernel_launch: occupancy query says %d blocks per CU\n", per_cu); }
        (void)hipGetLastError();
        if (cus < 256) { fprintf(stderr, "kernel_launch: built for 256 CUs, device has %d\n", cus); grid = -1; return; }
        grid = 256;
    }
    if (grid < 0) return;
    if (hipMemsetAsync((char*)d_ws + WS_CTL, 0, CTL_ZERO_BYTES, stream) != hipSuccess) { fprintf(stderr, "kernel_launch: memset failed\n"); return; }
    Args a{};
    for (int i = 0; i < 17; ++i) a.in[i] = (const float*)d_in[i];
    a.out = (float*)d_out; a.ws = (unsigned char*)d_ws;
    const int NL = MK_N_LAUNCHES;
    if (NL == 1) { a.ph_lo = 0; a.ph_hi = N_PHASES; hipLaunchKernelGGL(mk_fwd, dim3(grid), dim3(NWAVES * 64), LDS_BYTES, stream, a); }
    else { for (int p = 0; p < N_PHASES; ++p) { a.ph_lo = p; a.ph_hi = p + 1; hipLaunchKernelGGL(mk_fwd, dim3(grid), dim3(NWAVES * 64), LDS_BYTES, stream, a); } }
    const hipError_t le = hipPeekAtLastError();
    if (le != hipSuccess) fprintf(stderr, "kernel_launch: launch failed: %s\n", hipGetErrorName(le));
}
```

```cpp
#include <hip/hip_runtime.h>
#include <cstdio>
#include <cstdint>
#include <cmath>
__device__ __forceinline__ int lane_id() { return (int)__builtin_amdgcn_mbcnt_hi(~0u, __builtin_amdgcn_mbcnt_lo(~0u, 0u)); }
namespace pg8 {
#define PG8_LAS __attribute__((address_space(3)))
typedef unsigned short bf16_t;
typedef short bf16x8 __attribute__((ext_vector_type(8)));
typedef float f32x4 __attribute__((ext_vector_type(4)));
typedef unsigned u32x4 __attribute__((ext_vector_type(4)));
constexpr int BM = 256, BK = 64, HALF = 128, HTB = HALF * BK * 2  , STAGE_BYTES = 8 * HTB, NXCD = 8, WGM = 4;

__host__ __device__ __forceinline__ int lds_byte(int r, int c) { const int st = (r >> 4) * 2 + (c >> 5), rr = r & 15, cc = c & 31, ob = rr * 64 + cc * 2; return st * 1024 + (ob ^ (((ob >> 9) & 1) << 5)); }
__host__ __device__ __forceinline__ void stage_rc(int b, int& R, int& C) { const int st = b / 1024, sb = b % 1024, swz = sb ^ (((sb >> 9) & 1) << 5); R = (st >> 1) * 16 + swz / 64; C = (st & 1) * 32 + (swz % 64) / 2; }
__host__ __device__ __forceinline__ int perm32(int rho) { const int n = rho >> 4, i = rho & 15; return 8 * (i >> 2) + 4 * n + (i & 3); }

struct Unit { int pm, pn; };
struct Gemm { const bf16_t* A; const bf16_t* Bt; int M, N, K; };

struct StaticOrder {
    int nM, nN, nwg, G, c;
    __host__ __device__ void init(int M, int N, int G_, int c_) { nM = M / BM; nN = N / BM; nwg = nM * nN; G = G_; c = c_; }
    __host__ __device__ bool next(int i, Unit& u) const {
        const long L = (long)i * G + c; if (L >= nwg) return false;
        int wgid = (int)L; { const int q = nwg / NXCD, r = nwg % NXCD, xcd = wgid % NXCD, off = wgid / NXCD; wgid = (xcd < r ? xcd * (q + 1) : r * (q + 1) + (xcd - r) * q) + off; }
        const int nig = WGM * nN, gid = wgid / nig, fm = gid * WGM, gsz = (nM - fm) < WGM ? (nM - fm) : WGM;
        u.pm = fm + ((wgid % nig) % gsz); u.pn = (wgid % nig) / gsz; return true;
    }
    __device__ __forceinline__ void a_ready(const Unit&) const {}
    __device__ __forceinline__ void done(const Unit&) const {}
};

__device__ __forceinline__ unsigned cvt_pk_bf16(float lo, float hi) { unsigned r; asm volatile("v_cvt_pk_bf16_f32 %0, %1, %2" : "=v"(r) : "v"(lo), "v"(hi)); return r; }
typedef float f32x2 __attribute__((ext_vector_type(2)));
typedef unsigned u32x2 __attribute__((ext_vector_type(2)));
struct EpiProj {
    static constexpr bool PERM = true, AFTER_DRAIN = false;
    bf16_t* P; const float* rss; const float *g0, *g1, *g2, *g3;
    float* kms;
    __device__ __forceinline__ void operator()(const f32x4 (&acc)[2][2][4][2], const Unit& u, int wr, int wc, int fr, int fq) const {
        const int pn = u.pn; const int nsel = (pn == 0) ? 0 : (pn == 1) ? 1 : (pn == 3) ? 2 : (pn == 4) ? 3 : -1;
        const int row0 = u.pm * BM + wr * 64 + fr;
        const float* nw = (nsel == 0) ? g0 : (nsel == 1) ? g1 : (nsel == 2) ? g2 : g3;
        f32x4 g[2][2];
#pragma unroll
        for (int bj = 0; bj < 2; ++bj)
#pragma unroll
            for (int n = 0; n < 2; ++n) g[bj][n] = (nsel >= 0) ? *(const f32x4*)(nw + 32 * bj + 8 * fq + 4 * n) : (f32x4){1.f, 1.f, 1.f, 1.f};
        f32x4 cs[2][2];
#pragma unroll
        for (int bj = 0; bj < 2; ++bj)
#pragma unroll
            for (int n = 0; n < 2; ++n) cs[bj][n] = (f32x4){0.f, 0.f, 0.f, 0.f};
#pragma unroll
        for (int ai = 0; ai < 2; ++ai)
#pragma unroll
            for (int m = 0; m < 4; ++m) {
                const int row = row0 + ai * HALF + m * 16; const float r = 1.0f / sqrtf(rss[row] * (1.0f / 1024.0f) + 1e-6f);
                f32x4 v[2][2]; float ss = 0.f;
#pragma unroll
                for (int bj = 0; bj < 2; ++bj)
#pragma unroll
                    for (int n = 0; n < 2; ++n) { v[bj][n] = acc[ai][bj][m][n] * r; const f32x4 x = v[bj][n]; ss += (x[0] * x[0] + x[1] * x[1]) + (x[2] * x[2] + x[3] * x[3]); }
                if (nsel >= 0) {
                    ss += __shfl_xor(ss, 16); ss += __shfl_xor(ss, 32);
                    const float hr = 1.0f / sqrtf(ss * (1.0f / 64.0f) + 1e-6f);
#pragma unroll
                    for (int bj = 0; bj < 2; ++bj)
#pragma unroll
                        for (int n = 0; n < 2; ++n) { v[bj][n] = v[bj][n] * hr * g[bj][n]; cs[bj][n] += v[bj][n]; }
                }
                bf16_t* rowp = P + (size_t)row * 3072 + pn * BM + wc * 64 + 8 * fq;
#pragma unroll
                for (int bj = 0; bj < 2; ++bj) { u32x4 w; w.x = cvt_pk_bf16(v[bj][0][0], v[bj][0][1]); w.y = cvt_pk_bf16(v[bj][0][2], v[bj][0][3]); w.z = cvt_pk_bf16(v[bj][1][0], v[bj][1][1]); w.w = cvt_pk_bf16(v[bj][1][2], v[bj][1][3]);
                    *(u32x4*)(rowp + 32 * bj) = w; }
            }
        if (nsel == 3) {
            float* dst = kms + ((size_t)(u.pm * 4 + wc)) * 64 + 8 * fq;
#pragma unroll
            for (int bj = 0; bj < 2; ++bj)
#pragma unroll
                for (int n = 0; n < 2; ++n)
#pragma unroll
                    for (int e = 0; e < 4; ++e) { float s = cs[bj][n][e]; s += __shfl_xor(s, 1); s += __shfl_xor(s, 2); s += __shfl_xor(s, 4); s += __shfl_xor(s, 8);
                        if (fr == 0) atomicAdd(dst + 32 * bj + 4 * n + e, s); }
        }
    }
};
struct EpiRes1 {
    static constexpr bool PERM = true, AFTER_DRAIN = false;
    const bf16_t* baseb; bf16_t* xb; float* ssq;
    __device__ __forceinline__ void operator()(const f32x4 (&acc)[2][2][4][2], const Unit& u, int wr, int wc, int fr, int fq) const {
        const int col0 = u.pn * BM + wc * 32 + 8 * fq;
#pragma unroll
        for (int ai = 0; ai < 2; ++ai)
#pragma unroll
            for (int m = 0; m < 4; ++m) {
                const int row = u.pm * BM + ai * HALF + wr * 64 + m * 16 + fr; const size_t off = (size_t)row * 1024 + col0; float ss = 0.f;
#pragma unroll
                for (int bj = 0; bj < 2; ++bj) { const size_t o2 = off + bj * HALF;
                    const u32x4 h = *(const u32x4*)(baseb + o2);
                    f32x4 o0, o1;
                    o0[0] = __uint_as_float(h.x << 16); o0[1] = __uint_as_float(h.x & 0xffff0000u); o0[2] = __uint_as_float(h.y << 16); o0[3] = __uint_as_float(h.y & 0xffff0000u);
                    o1[0] = __uint_as_float(h.z << 16); o1[1] = __uint_as_float(h.z & 0xffff0000u); o1[2] = __uint_as_float(h.w << 16); o1[3] = __uint_as_float(h.w & 0xffff0000u);
                    o0 = o0 + acc[ai][bj][m][0]; o1 = o1 + acc[ai][bj][m][1];
                    u32x4 w; w.x = cvt_pk_bf16(o0[0], o0[1]); w.y = cvt_pk_bf16(o0[2], o0[3]); w.z = cvt_pk_bf16(o1[0], o1[1]); w.w = cvt_pk_bf16(o1[2], o1[3]); *(u32x4*)(xb + o2) = w;
                    ss += ((o0[0] * o0[0] + o0[1] * o0[1]) + (o0[2] * o0[2] + o0[3] * o0[3])) + ((o1[0] * o1[0] + o1[1] * o1[1]) + (o1[2] * o1[2] + o1[3] * o1[3])); }
                ss += __shfl_xor(ss, 16); ss += __shfl_xor(ss, 32);
                if (fq == 0) atomicAdd(ssq + row, ss);
            }
    }
};
struct EpiRelu2 {
    static constexpr bool PERM = true, AFTER_DRAIN = false;
    bf16_t* H; const float* ssq;
    __device__ __forceinline__ void operator()(const f32x4 (&acc)[2][2][4][2], const Unit& u, int wr, int wc, int fr, int fq) const {
        const int col0 = u.pn * BM + wc * 32 + 8 * fq;
#pragma unroll
        for (int ai = 0; ai < 2; ++ai)
#pragma unroll
            for (int m = 0; m < 4; ++m) {
                const int row = u.pm * BM + ai * HALF + wr * 64 + m * 16 + fr; const float r = 1.0f / sqrtf(ssq[row] * (1.0f / 1024.0f) + 1e-6f);
                bf16_t* rowp = H + (size_t)row * 4096 + col0;
#pragma unroll
                for (int bj = 0; bj < 2; ++bj) { f32x4 v0 = acc[ai][bj][m][0] * r, v1 = acc[ai][bj][m][1] * r;
#pragma unroll
                    for (int e = 0; e < 4; ++e) { const float a = fmaxf(v0[e], 0.f), b = fmaxf(v1[e], 0.f); v0[e] = a * a; v1[e] = b * b; }
                    u32x4 w; w.x = cvt_pk_bf16(v0[0], v0[1]); w.y = cvt_pk_bf16(v0[2], v0[3]); w.z = cvt_pk_bf16(v1[0], v1[1]); w.w = cvt_pk_bf16(v1[2], v1[3]);
                    *(u32x4*)(rowp + bj * HALF) = w; }
            }
    }
};
struct EpiRes2 {
    static constexpr bool PERM = true, AFTER_DRAIN = false;
    float* out; const bf16_t* xhi; bf16_t* xnb; float* ssqn;
    __device__ __forceinline__ void operator()(const f32x4 (&acc)[2][2][4][2], const Unit& u, int wr, int wc, int fr, int fq) const {
        const int col0 = u.pn * BM + wc * 32 + 8 * fq;
#pragma unroll
        for (int ai = 0; ai < 2; ++ai)
#pragma unroll
            for (int m = 0; m < 4; ++m) {
                const int row = u.pm * BM + ai * HALF + wr * 64 + m * 16 + fr; const size_t off = (size_t)row * 1024 + col0; float ss = 0.f;
#pragma unroll
                for (int bj = 0; bj < 2; ++bj) { const size_t o2 = off + bj * HALF;
                    const u32x4 h = *(const u32x4*)(xhi + o2);
                    f32x4 o0, o1;
                    o0[0] = __uint_as_float(h.x << 16); o0[1] = __uint_as_float(h.x & 0xffff0000u); o0[2] = __uint_as_float(h.y << 16); o0[3] = __uint_as_float(h.y & 0xffff0000u);
                    o1[0] = __uint_as_float(h.z << 16); o1[1] = __uint_as_float(h.z & 0xffff0000u); o1[2] = __uint_as_float(h.w << 16); o1[3] = __uint_as_float(h.w & 0xffff0000u);
                    o0 = o0 + acc[ai][bj][m][0]; o1 = o1 + acc[ai][bj][m][1];
                    if (xnb) { u32x4 w; w.x = cvt_pk_bf16(o0[0], o0[1]); w.y = cvt_pk_bf16(o0[2], o0[3]); w.z = cvt_pk_bf16(o1[0], o1[1]); w.w = cvt_pk_bf16(o1[2], o1[3]); *(u32x4*)(xnb + o2) = w;
                        ss += ((o0[0] * o0[0] + o0[1] * o0[1]) + (o0[2] * o0[2] + o0[3] * o0[3])) + ((o1[0] * o1[0] + o1[1] * o1[1]) + (o1[2] * o1[2] + o1[3] * o1[3])); }
                    else { *(f32x4*)(out + o2) = o0; *(f32x4*)(out + o2 + 4) = o1; } }
                if (xnb) { ss += __shfl_xor(ss, 16); ss += __shfl_xor(ss, 32); if (fq == 0) atomicAdd(ssqn + row, ss); }
            }
    }
};
template <class Epi, class Sched, bool ALIGN_EPI = false, bool SP2 = false>
__device__ __forceinline__ void gemm_phase(PG8_LAS unsigned char* lds, const Gemm g, const Sched& S, const Epi& E, const int wave_in) {
    int tid_ = wave_in * 64 + lane_id(); asm volatile("" : "+v"(tid_));
    const int tid = tid_, wid = __builtin_amdgcn_readfirstlane(tid >> 6), lane = tid & 63, wr = wid >> 2, wc = wid & 3, fr = lane & 15, fq = lane >> 4;
    const int K = g.K, nt = K / BK;
    unsigned voffA[2], voffB[2];
#pragma unroll
    for (int i = 0; i < 2; ++i) { int R, C; stage_rc(tid * 16 + i * 8192, R, C); const int Rb = Epi::PERM ? ((R & ~31) + perm32(R & 31)) : R;
        voffA[i] = (unsigned)(R * K + C) * 2u; voffB[i] = (unsigned)(Rb * K + C) * 2u; }
    const size_t kstep = (size_t)(BK * 2);
    const size_t hstep = (size_t)HALF * K * 2;
    const size_t tstep = 2 * hstep;
    const unsigned ldsw = (unsigned)wid * 1024u;
    const int aoff = lds_byte(wr * 64 + fr, fq * 8), boff = lds_byte(wc * 32 + fr, fq * 8);
#define PG8_SA(b, h) (((b) * 2 + (h)) * HTB)
#define PG8_SB(b, h) ((4 + (b) * 2 + (h)) * HTB)
#define PG8_STAGE(bufoff, gbase, voff) do { _Pragma("unroll") for (int _i = 0; _i < 2; ++_i) \
        __builtin_amdgcn_global_load_lds((const unsigned*)((const char*)(gbase) + (voff)[_i]), (PG8_LAS unsigned*)(lds + (bufoff) + ldsw + _i * 8192), 16, 0, 0); } while (0)
#define PG8_LDA(dst, b, h) do { _Pragma("unroll") for (int m = 0; m < 4; ++m) _Pragma("unroll") for (int k = 0; k < 2; ++k) dst[m][k] = *(const PG8_LAS bf16x8*)(lds + PG8_SA(b, h) + aoff + m * 2048 + k * 1024); } while (0)
#define PG8_LDB(dst, b, h) do { _Pragma("unroll") for (int n = 0; n < 2; ++n) _Pragma("unroll") for (int k = 0; k < 2; ++k) dst[n][k] = *(const PG8_LAS bf16x8*)(lds + PG8_SB(b, h) + boff + n * 2048 + k * 1024); } while (0)
#define PG8_MMA(ai, bj, At, Bt) do { __builtin_amdgcn_s_setprio(1); _Pragma("unroll") for (int m = 0; m < 4; ++m) _Pragma("unroll") for (int n = 0; n < 2; ++n) _Pragma("unroll") for (int k = 0; k < 2; ++k) \
        acc[ai][bj][m][n] = __builtin_amdgcn_mfma_f32_16x16x32_bf16(Bt[n][k], At[m][k], acc[ai][bj][m][n], 0, 0, 0); __builtin_amdgcn_s_setprio(0); } while (0)
#define PG8_WAIT_V(n) asm volatile("s_waitcnt vmcnt(" #n ")" ::: "memory")
#define PG8_WAIT_L(n) asm volatile("s_waitcnt lgkmcnt(" #n ")" ::: "memory")
#define PG8_BAR __builtin_amdgcn_s_barrier()
#define PG8_SCHED __builtin_amdgcn_sched_barrier(0)
    Unit cur, nxt; int ui = 0;
    if (!S.next(0, cur)) return;
    f32x4 acc[2][2][4][2];
#pragma unroll
    for (int a = 0; a < 2; ++a)
#pragma unroll
        for (int b = 0; b < 2; ++b)
#pragma unroll
            for (int m = 0; m < 4; ++m)
#pragma unroll
                for (int n = 0; n < 2; ++n) acc[a][b][m][n] = (f32x4){0.f, 0.f, 0.f, 0.f};
    bf16x8 At[4][2], B0[2][2], B1[2][2];
    const char* cA = (const char*)g.A + (size_t)cur.pm * tstep; const char* cB = (const char*)g.Bt + (size_t)cur.pn * tstep;
    S.a_ready(cur);
    if constexpr (SP2) {
        PG8_STAGE(PG8_SB(0, 0), cB, voffB); PG8_STAGE(PG8_SB(0, 1), cB + hstep, voffB); PG8_STAGE(PG8_SA(0, 0), cA, voffA); PG8_STAGE(PG8_SA(0, 1), cA + hstep, voffA);
        if (wr == 1) PG8_BAR;
        PG8_WAIT_V(2); PG8_BAR;
        PG8_STAGE(PG8_SB(1, 0), cB + kstep, voffB); PG8_STAGE(PG8_SA(1, 0), cA + kstep, voffA); PG8_STAGE(PG8_SB(1, 1), cB + hstep + kstep, voffB);
        PG8_WAIT_V(6); PG8_BAR;
    } else {
        PG8_STAGE(PG8_SB(0, 0), cB, voffB); PG8_STAGE(PG8_SA(0, 0), cA, voffA); PG8_STAGE(PG8_SB(0, 1), cB + hstep, voffB); PG8_STAGE(PG8_SA(0, 1), cA + hstep, voffA);
        if (wr == 1) PG8_BAR;
        PG8_WAIT_V(4); PG8_BAR;
        PG8_STAGE(PG8_SB(1, 0), cB + kstep, voffB); PG8_STAGE(PG8_SA(1, 0), cA + kstep, voffA); PG8_STAGE(PG8_SB(1, 1), cB + hstep + kstep, voffB);
        PG8_WAIT_V(6); PG8_BAR;
    }
    for (;;) {
        const bool has_next = S.next(ui + 1, nxt);
        const char* nA = has_next ? (const char*)g.A + (size_t)nxt.pm * tstep : cA; const char* nB = has_next ? (const char*)g.Bt + (size_t)nxt.pn * tstep : cB;
        for (int t = 0; t < nt; t += 2) {
            const bool last = (t == nt - 2);
            const char* a1 = cA + (size_t)(t + 1) * kstep;
            const char* a2 = last ? nA : cA + (size_t)(t + 2) * kstep; const char* b2 = last ? nB : cB + (size_t)(t + 2) * kstep;
            const char* a3 = a2 + kstep; const char* b3 = b2 + kstep;
            if (last && has_next) S.a_ready(nxt);
            if constexpr (SP2) {
            PG8_LDB(B0, 0, 0); PG8_LDB(B1, 0, 1); PG8_SCHED; PG8_LDA(At, 0, 0); PG8_STAGE(PG8_SA(1, 1), a1 + hstep, voffA);
            PG8_WAIT_V(8); PG8_WAIT_L(0); PG8_BAR; PG8_MMA(0, 0, At, B0); PG8_MMA(0, 1, At, B1); PG8_BAR; PG8_SCHED;
            PG8_LDA(At, 0, 1); PG8_STAGE(PG8_SB(0, 0), b2, voffB); PG8_STAGE(PG8_SB(0, 1), b2 + hstep, voffB); PG8_STAGE(PG8_SA(0, 0), a2, voffA);
            PG8_WAIT_V(8); PG8_WAIT_L(0); PG8_BAR; PG8_MMA(1, 0, At, B0); PG8_MMA(1, 1, At, B1); PG8_BAR; PG8_SCHED;
            PG8_LDB(B0, 1, 0); PG8_LDB(B1, 1, 1); PG8_SCHED; PG8_LDA(At, 1, 0); PG8_STAGE(PG8_SA(0, 1), a2 + hstep, voffA);
            PG8_WAIT_V(8); PG8_WAIT_L(0); PG8_BAR; PG8_MMA(0, 0, At, B0); PG8_MMA(0, 1, At, B1); PG8_BAR; PG8_SCHED;
            PG8_LDA(At, 1, 1); PG8_STAGE(PG8_SB(1, 0), b3, voffB); PG8_STAGE(PG8_SB(1, 1), b3 + hstep, voffB); PG8_STAGE(PG8_SA(1, 0), a3, voffA);
            PG8_WAIT_V(8); PG8_WAIT_L(0); PG8_BAR; PG8_MMA(1, 0, At, B0); PG8_MMA(1, 1, At, B1); PG8_BAR; PG8_SCHED;
            } else {
            PG8_LDB(B0, 0, 0); PG8_SCHED; PG8_LDA(At, 0, 0); PG8_STAGE(PG8_SA(1, 1), a1 + hstep, voffA);
            PG8_WAIT_L(8); PG8_BAR; PG8_WAIT_L(0); PG8_MMA(0, 0, At, B0); PG8_BAR; PG8_SCHED;
            PG8_LDB(B1, 0, 1); PG8_STAGE(PG8_SB(0, 0), b2, voffB);
            PG8_BAR; PG8_WAIT_L(0); PG8_MMA(0, 1, At, B1); PG8_BAR;
            PG8_LDA(At, 0, 1); PG8_STAGE(PG8_SA(0, 0), a2, voffA);
            PG8_BAR; PG8_WAIT_L(0); PG8_MMA(1, 0, At, B0); PG8_BAR; PG8_SCHED;
            PG8_STAGE(PG8_SB(0, 1), b2 + hstep, voffB);
            PG8_WAIT_V(6); PG8_BAR; PG8_MMA(1, 1, At, B1); PG8_BAR;
            PG8_LDB(B0, 1, 0); PG8_SCHED; PG8_LDA(At, 1, 0); PG8_STAGE(PG8_SA(0, 1), a2 + hstep, voffA);
            PG8_WAIT_L(8); PG8_BAR; PG8_WAIT_L(0); PG8_MMA(0, 0, At, B0); PG8_BAR; PG8_SCHED;
            PG8_LDB(B1, 1, 1); PG8_STAGE(PG8_SB(1, 0), b3, voffB);
            PG8_BAR; PG8_WAIT_L(0); PG8_MMA(0, 1, At, B1); PG8_BAR;
            PG8_LDA(At, 1, 1); PG8_STAGE(PG8_SA(1, 0), a3, voffA);
            PG8_BAR; PG8_WAIT_L(0); PG8_MMA(1, 0, At, B0); PG8_BAR; PG8_SCHED;
            PG8_STAGE(PG8_SB(1, 1), b3 + hstep, voffB);
            PG8_WAIT_V(6); PG8_BAR; PG8_MMA(1, 1, At, B1); PG8_BAR;
            }
        }
        if constexpr (ALIGN_EPI) { if (wr == 0) PG8_BAR; }
        if constexpr (!Epi::AFTER_DRAIN) { E(acc, cur, wr, wc, fr, fq); S.done(cur); }
        if (!has_next) break;
#pragma unroll
        for (int a = 0; a < 2; ++a)
#pragma unroll
            for (int b = 0; b < 2; ++b)
#pragma unroll
                for (int m = 0; m < 4; ++m)
#pragma unroll
                    for (int n = 0; n < 2; ++n) acc[a][b][m][n] = (f32x4){0.f, 0.f, 0.f, 0.f};
        cur = nxt; cA = nA; cB = nB; ++ui;
        if constexpr (ALIGN_EPI) { if (wr == 1) PG8_BAR; }
    }
    PG8_WAIT_V(0);
    if constexpr (!ALIGN_EPI) { if (wr == 0) PG8_BAR; }
    PG8_BAR;
    if constexpr (Epi::AFTER_DRAIN) { E.fused(acc, cur, wr, wc, fr, fq, lds, wid, lane); S.done(cur); }
#undef PG8_SA
#undef PG8_SB
#undef PG8_STAGE
#undef PG8_LDA
#undef PG8_LDB
#undef PG8_MMA
#undef PG8_WAIT_V
#undef PG8_WAIT_L
#undef PG8_BAR
#undef PG8_SCHED
}
}
#define GAS __attribute__((address_space(1)))
#define LAS __attribute__((address_space(3)))
typedef unsigned short bf16;
typedef unsigned v4u __attribute__((ext_vector_type(4)));
typedef float f32x4 __attribute__((ext_vector_type(4)));
typedef short bf16x8 __attribute__((ext_vector_type(8)));
typedef GAS unsigned gu32;
typedef GAS unsigned long long gu64;
#define RLX_AGENT __ATOMIC_RELAXED, __HIP_MEMORY_SCOPE_AGENT
#define LDS_WAIT() asm volatile("s_waitcnt lgkmcnt(0)" ::: "memory")
#define VM_WAIT() asm volatile("s_waitcnt vmcnt(0)" ::: "memory")
__device__ __forceinline__ unsigned long long rt() { return __builtin_amdgcn_s_memrealtime(); }
__device__ __forceinline__ unsigned f2bf(float f) { unsigned u = __builtin_bit_cast(unsigned, f); return (u + 0x7fffu + ((u >> 16) & 1u)) >> 16; }
__device__ __forceinline__ unsigned pk2(float lo, float hi) { typedef float f2_t __attribute__((ext_vector_type(2))); typedef __bf16 b2_t __attribute__((ext_vector_type(2))); const f2_t v = {lo, hi}; return __builtin_bit_cast(unsigned, __builtin_convertvector(v, b2_t)); }
#define XB_TMO      128
#define XB_XCNT(j)  (256  + 64 * (j))
#define XB_XSUB(j)  (1280 + 64 * (j))
#define XB_XGEN(j)  (2304 + 64 * (j))
#define XB_TOP      3328
#define XB_TOPGEN   3392
#define XCD_BAR_WORDS 3456
#define XB_SPIN_CAP (1u << 18)

__device__ __forceinline__ unsigned xb_ld(unsigned* p)              { return __hip_atomic_load(p, __ATOMIC_RELAXED, __HIP_MEMORY_SCOPE_AGENT); }
__device__ __forceinline__ unsigned xb_add(unsigned* p, unsigned v) { return __hip_atomic_fetch_add(p, v, __ATOMIC_RELAXED, __HIP_MEMORY_SCOPE_AGENT); }
__device__ __forceinline__ unsigned xb_xcc_id() { return (unsigned)__builtin_amdgcn_s_getreg((3 << 11) | 20) & 0xFu; }
#define XB_SPIN(cond, bar) do { unsigned _sp = 0; while (cond) { __builtin_amdgcn_s_sleep(1); \
    if ((++_sp & 255u) == 0u) { if (xb_ld(&(bar)[XB_TMO])) break; if (_sp > XB_SPIN_CAP) { atomicAdd(&(bar)[XB_TMO], 1u); break; } } } } while (0)

struct XcdBarrier {
    unsigned* bar; unsigned x;
    volatile LAS unsigned* st;
};

__device__ __forceinline__ XcdBarrier xcd_barrier_post(unsigned* bar, volatile LAS unsigned* st) {
    XcdBarrier b; b.bar = bar; b.x = xb_xcc_id(); b.st = st;
    if (threadIdx.x == 0) (void)xb_add(&bar[XB_XCNT(b.x)], 1u);
    return b;
}
__device__ __forceinline__ void xcd_barrier_complete(unsigned* bar, unsigned x, unsigned& nloc, unsigned& nx) {
    const unsigned G = gridDim.x * gridDim.y * gridDim.z;
    unsigned sum, cnt, mine, sp = 0u;
    for (;;) {
        sum = 0u; cnt = 0u; mine = 0u;
#pragma unroll
        for (unsigned j = 0; j < 16; ++j) { const unsigned c = xb_ld(&bar[XB_XCNT(j)]); sum += c; cnt += (c > 0u) ? 1u : 0u; mine = (j == x) ? c : mine; }
        if (sum == G) break;
        __builtin_amdgcn_s_sleep(1);
        if ((++sp & 255u) == 0u) { if (xb_ld(&bar[XB_TMO])) break; if (sp > XB_SPIN_CAP) { atomicAdd(&bar[XB_TMO], 1u); break; } }
    }
    nloc = mine > 0u ? mine : 1u; nx = cnt > 0u ? cnt : 1u;
}

__device__ __forceinline__ void xcd_barrier(const XcdBarrier& b, const bool leader  ) {
    asm volatile("s_waitcnt vmcnt(0)" ::: "memory");
    __syncthreads();
    unsigned zoff_ = 0u; asm volatile("s_mov_b32 %0, 0" : "=s"(zoff_)); unsigned* bar_ = b.bar + zoff_; const unsigned bx_ = b.x + zoff_;
    if (leader) {
        unsigned* bar = bar_;
        __builtin_amdgcn_s_waitcnt(0);
        unsigned nloc = b.st[0], nx = b.st[1];
        if (nloc == 0u) { xcd_barrier_complete(bar, bx_, nloc, nx); b.st[0] = nloc; b.st[1] = nx; }
        const unsigned old = xb_add(&bar[XB_XSUB(bx_)], 1u);
        const unsigned gen = old / nloc;
        if (old + 1u == (gen + 1u) * nloc) {
            __builtin_amdgcn_fence(__ATOMIC_RELEASE, "agent");
            asm volatile("s_waitcnt vmcnt(0)" ::: "memory");
            const unsigned og = xb_add(&bar[XB_TOP], 1u);
            const unsigned tg = og / nx;
            if (og + 1u == (tg + 1u) * nx) xb_add(&bar[XB_TOPGEN], 1u);
            else XB_SPIN(xb_ld(&bar[XB_TOPGEN]) == tg, bar);
            __builtin_amdgcn_fence(__ATOMIC_ACQUIRE, "agent");
            xb_add(&bar[XB_XGEN(bx_)], 1u);
            asm volatile("s_waitcnt vmcnt(0)" ::: "memory");
        } else {
            XB_SPIN(xb_ld(&bar[XB_XGEN(bx_)]) == gen, bar);
            __builtin_amdgcn_fence(__ATOMIC_ACQUIRE, "agent");
            asm volatile("s_waitcnt vmcnt(0)" ::: "memory");
        }
    }
    __syncthreads();
}
constexpr int NWAVES = 8;
constexpr int BATCH = 4, SEQ = 4096, DM = 1024, M = BATCH * SEQ, DIN = 3080, NPROJ = 3072, FF = 4096, DEPTH = 2;
constexpr int OFF_QA = 0, OFF_KA = 256, OFF_VA = 512, OFF_QC = 768, OFF_KC = 1024, OFF_VC = 1280, OFF_Z = 1536, OFF_XBC = 2048;
constexpr float EPS = 1e-6f;
constexpr size_t MiB = 1u << 20;
constexpr size_t WS_CTL = 0, CTL_ZERO_BYTES = 1 * MiB;
constexpr size_t WS_KMS = 512 * 1024;
constexpr size_t WS_SSQ2 = 384 * 1024;
constexpr size_t WS_SSQ = 256 * 1024;
constexpr size_t WS_W = 2 * MiB, W_LAYER = 24 * MiB, W_IN = 0, W_OUT = 6 * MiB, W_1 = 8 * MiB, W_2 = 16 * MiB;
constexpr size_t WS_RSTD = 50 * MiB, WS_DT = 51 * MiB, WS_KMEAN = 52 * MiB;
constexpr size_t WS_PROJ = 56 * MiB, WS_Y = 152 * MiB, WS_H = 56 * MiB, WS_XB = 184 * MiB, WS_ST = 216 * MiB, WS_END = 256 * MiB;
static_assert(WS_PROJ + (size_t)M * NPROJ * 2 <= WS_Y && WS_Y + (size_t)M * DM * 2 <= WS_XB && WS_H + (size_t)M * FF * 2 <= WS_XB && WS_XB + (size_t)M * DM * 2 <= WS_ST && WS_ST + 32 * MiB <= WS_END, "d_ws map");
constexpr int CW_BAR = 4096;
constexpr int RING_OFF = 0, RING_BYTES = 143360;
constexpr int LDSCTL_OFF = RING_BYTES, MISC_OFF = LDSCTL_OFF + 320;
constexpr int LDS_BYTES = 147456;

struct Frame {
    LAS unsigned char* lds; volatile LAS unsigned* MISC;
    int tid, lane, wave, vcu, G;
};
typedef const __attribute__((address_space(4))) unsigned char* kptr_t;
__device__ __forceinline__ kptr_t kargs() { kptr_t p = (kptr_t)__builtin_amdgcn_kernarg_segment_ptr(); asm volatile("" : "+s"(p)); return p; }
#define ARGF(i) (*(const float* const __attribute__((address_space(4)))*)(kargs() + 8 * (i)))
#define ARGOUT() (*(float* const __attribute__((address_space(4)))*)(kargs() + 8 * 17))
#define ARGWS() (*(unsigned char* const __attribute__((address_space(4)))*)(kargs() + 8 * 18))
__device__ __forceinline__ float wave_sum(float v) {
#pragma unroll
    for (int o = 1; o < 64; o <<= 1) v += __shfl_xor(v, o);
    return v;
}
__device__ __forceinline__ float wave_max(float v) {
#pragma unroll
    for (int o = 1; o < 64; o <<= 1) v = fmaxf(v, __shfl_xor(v, o));
    return v;
}
__device__ __forceinline__ float blo(unsigned w) { return __uint_as_float(w << 16); }
__device__ __forceinline__ float bhi(unsigned w) { return __uint_as_float(w & 0xffff0000u); }
__device__ __forceinline__ float bf2f(bf16 u) { return __uint_as_float((unsigned)u << 16); }

__device__ __forceinline__ void p0_transpose_item(const float* W, int ldw, int K, int nblk, bf16* WT, LAS float* scr, int item, int lane, const float* kscale, bool perm) {
    const int kb = item / nblk, nb = item % nblk, k0 = 64 * kb, n0 = 32 * nb;
#pragma unroll
    for (int i = 0; i < 8; ++i) { const int kk = 8 * i + (lane >> 3), c4 = 4 * (lane & 7); f32x4 v = __builtin_nontemporal_load((const f32x4*)(W + (size_t)(k0 + kk) * ldw + n0 + c4));
        if (kscale) v = v * kscale[k0 + kk]; LAS float* d = scr + kk * 33 + c4; d[0] = v.x; d[1] = v.y; d[2] = v.z; d[3] = v.w; }
    LDS_WAIT(); asm volatile("" ::: "memory");
    const int c = lane & 7;
#pragma unroll
    for (int j = 0; j < 4; ++j) { const int n = (lane >> 3) + 8 * j; const LAS float* s = scr + (8 * c) * 33 + n;
        v4u o; o.x = pk2(s[0 * 33], s[1 * 33]); o.y = pk2(s[2 * 33], s[3 * 33]); o.z = pk2(s[4 * 33], s[5 * 33]); o.w = pk2(s[6 * 33], s[7 * 33]);
        int cc = n0 + n; if (perm) { const int cl = cc & 255; cc = (cc & ~255) + 128 * ((cl >> 5) & 1) + 32 * (cl >> 6) + (cl & 31); }
        *(GAS v4u*)(WT + (size_t)cc * K + k0 + 8 * c) = o; }
    LDS_WAIT(); asm volatile("" ::: "memory");
}
__device__ __forceinline__ void p0_weights(Frame& F) {
    LAS float* scr = (LAS float*)(F.lds + RING_OFF + F.wave * 16384);
    const int gw = F.vcu * NWAVES + F.wave, NGW = F.G * NWAVES;
    constexpr int I_IN = (DM / 64) * (NPROJ / 32), I_O = (DM / 64) * (DM / 32), I_1 = (DM / 64) * (FF / 32), I_2 = (FF / 64) * (DM / 32);
    constexpr int PER_L = I_IN + I_O + I_1 + I_2;
    for (int it = gw; it < DEPTH * PER_L; it += NGW) {
        const int l = it / PER_L; int r = it % PER_L;
        unsigned char* wb = ARGWS() + WS_W + (size_t)l * W_LAYER;
        if (r < I_IN) { p0_transpose_item(ARGF(2) + (size_t)l * DM * DIN, DIN, DM, NPROJ / 32, (bf16*)(wb + W_IN), scr, r, F.lane, ARGF(1) + l * DM, true); continue; } r -= I_IN;
        if (r < I_O) { p0_transpose_item(ARGF(13) + (size_t)l * DM * DM, DM, DM, DM / 32, (bf16*)(wb + W_OUT), scr, r, F.lane, nullptr, false); continue; } r -= I_O;
        if (r < I_1) { p0_transpose_item(ARGF(15) + (size_t)l * DM * FF, FF, DM, FF / 32, (bf16*)(wb + W_1), scr, r, F.lane, ARGF(14) + l * DM, false); continue; } r -= I_1;
        p0_transpose_item(ARGF(16) + (size_t)l * FF * DM, DM, FF, DM / 32, (bf16*)(wb + W_2), scr, r, F.lane, nullptr, false);
    }
}
__device__ __forceinline__ void pre_rows(Frame& F, const float* xs, int l) {
    LAS float* wdt = (LAS float*)(F.lds + RING_OFF);
    const float* win = ARGF(2) + (size_t)l * DM * DIN; const float* nw = ARGF(1) + l * DM;
#pragma unroll
    for (int m = 0; m < 2; ++m) { const int k = F.tid + 512 * m; const float g = nw[k];
        const f32x4 a = *(const f32x4*)(win + (size_t)k * DIN + NPROJ), b = *(const f32x4*)(win + (size_t)k * DIN + NPROJ + 4);
        wdt[0 * DM + k] = g * a.x; wdt[1 * DM + k] = g * a.y; wdt[2 * DM + k] = g * a.z; wdt[3 * DM + k] = g * a.w; wdt[4 * DM + k] = g * b.x; wdt[5 * DM + k] = g * b.y; wdt[6 * DM + k] = g * b.z; wdt[7 * DM + k] = g * b.w; }
    __syncthreads();
    const int gw = F.vcu * NWAVES + F.wave, NGW = F.G * NWAVES;
    bf16* xb = (bf16*)(ARGWS() + WS_XB); float* rstd1 = (float*)(ARGWS() + WS_RSTD); float* dt = (float*)(ARGWS() + WS_DT);
    const float bias = (F.lane < 8) ? ARGF(9)[l * 8 + F.lane] : 0.f;
    for (int row0 = gw; row0 < M; row0 += 2 * NGW) {
        f32x4 v[2][4]; float ss[2] = {0.f, 0.f};
#pragma unroll
        for (int q = 0; q < 2; ++q) { const f32x4* xr = (const f32x4*)(xs + (size_t)(row0 + q * NGW) * DM) + F.lane;
#pragma unroll
            for (int j = 0; j < 4; ++j) v[q][j] = __builtin_nontemporal_load(xr + 64 * j); }
#pragma unroll
        for (int q = 0; q < 2; ++q) {
            const int row = row0 + q * NGW;
#pragma unroll
            for (int j = 0; j < 4; ++j) ss[q] += (v[q][j].x * v[q][j].x + v[q][j].y * v[q][j].y) + (v[q][j].z * v[q][j].z + v[q][j].w * v[q][j].w);
            const float ssw = wave_sum(ss[q]); const float rstd = 1.0f / sqrtf(ssw * (1.0f / DM) + EPS);
            unsigned long long* o8 = (unsigned long long*)(xb + (size_t)row * DM) + F.lane;
#pragma unroll
            for (int j = 0; j < 4; ++j) o8[64 * j] = (unsigned long long)pk2(v[q][j].x, v[q][j].y) | ((unsigned long long)pk2(v[q][j].z, v[q][j].w) << 32);
            float mine = 0.f;
#pragma unroll
            for (int jj = 0; jj < 8; ++jj) { float d = 0.f;
#pragma unroll
                for (int j = 0; j < 4; ++j) { const f32x4 w = *(const LAS f32x4*)(wdt + jj * DM + 256 * j + 4 * F.lane); d += (v[q][j].x * w.x + v[q][j].y * w.y) + (v[q][j].z * w.z + v[q][j].w * w.w); }
                d = wave_sum(d); if (F.lane == jj) mine = d; }
            if (F.lane < 8) { const float r = mine * rstd + bias; dt[(size_t)row * 8 + F.lane] = fmaxf(r, 0.f) + log1pf(expf(-fabsf(r))); }
            if (F.lane == 0) rstd1[row] = ssw;
        }
    }
    __syncthreads();
}

constexpr int DTW_RS = 2064;
__device__ __forceinline__ void dt_rows_b(Frame& F, const bf16* xs, int l) {
    LAS unsigned char* wdt = F.lds + RING_OFF;
    LAS float* part = (LAS float*)(F.lds + RING_OFF + 16 * DTW_RS);
    static_assert(M == 64 * 256, "dt_rows_b: 64 rows per workgroup on 256 workgroups");
    const int lane = F.lane, w = F.wave, r = lane & 15, q = lane >> 4, t = w >> 1, kh = w & 1;
    const int row0 = F.vcu * 64 + 16 * t;
    bf16x8 a[8][2];
    { const bf16* xr = xs + (size_t)(row0 + r) * DM + 512 * kh + 16 * q;
#pragma unroll
      for (int s = 0; s < 8; ++s) { a[s][0] = *(const bf16x8*)(xr + 64 * s); a[s][1] = *(const bf16x8*)(xr + 64 * s + 8); } }
    const float* win = ARGF(2) + (size_t)l * DM * DIN; const float* nw = ARGF(1) + l * DM;
#pragma unroll
    for (int m = 0; m < 2; ++m) { const int kk = F.tid + 512 * m; const float g = nw[kk];
        const f32x4 u0 = *(const f32x4*)(win + (size_t)kk * DIN + NPROJ), u1 = *(const f32x4*)(win + (size_t)kk * DIN + NPROJ + 4);
        const float v[8] = {g * u0.x, g * u0.y, g * u0.z, g * u0.w, g * u1.x, g * u1.y, g * u1.z, g * u1.w};
#pragma unroll
        for (int jj = 0; jj < 8; ++jj) { const unsigned h = f2bf(v[jj]); const unsigned lo = f2bf(v[jj] - __uint_as_float(h << 16));
            *(LAS unsigned short*)(wdt + jj * DTW_RS + 2 * kk) = (unsigned short)h; *(LAS unsigned short*)(wdt + (8 + jj) * DTW_RS + 2 * kk) = (unsigned short)lo; } }
    const float* ssq = (const float*)(ARGWS() + WS_SSQ2); float* dt = (float*)(ARGWS() + WS_DT);
    float ssr[4];
#pragma unroll
    for (int e = 0; e < 4; ++e) ssr[e] = ssq[row0 + 4 * q + e];
    const float bias = ARGF(9)[l * 8 + (r & 7)];
    __syncthreads();
    f32x4 acc = {0.f, 0.f, 0.f, 0.f};
    { LAS unsigned char* wb = wdt + r * DTW_RS + (512 * kh + 16 * q) * 2;
#pragma unroll
      for (int s = 0; s < 8; ++s)
#pragma unroll
          for (int h = 0; h < 2; ++h) acc = __builtin_amdgcn_mfma_f32_16x16x32_bf16(a[s][h], *(const LAS bf16x8*)(wb + (64 * s + 8 * h) * 2), acc, 0, 0, 0); }
    if (kh == 1) {
#pragma unroll
        for (int e = 0; e < 4; ++e) part[(t * 4 + e) * 64 + lane] = acc[e]; }
    __syncthreads();
    if (kh == 0) {
#pragma unroll
        for (int e = 0; e < 4; ++e) { float d = acc[e] + part[(t * 4 + e) * 64 + lane]; d += __shfl_xor(d, 8);
            const float rstd = 1.0f / sqrtf(ssr[e] * (1.0f / DM) + EPS); const float rr = d * rstd + bias;
            if (r < 8) dt[(size_t)(row0 + 4 * q + e) * 8 + r] = fmaxf(rr, 0.f) + log1pf(expf(-fabsf(rr))); } }
    __syncthreads();
}
namespace att {
typedef float f32x16 __attribute__((ext_vector_type(16)));
typedef short v4i16_t __attribute__((ext_vector_type(4)));
typedef __bf16 bf16x2_t __attribute__((ext_vector_type(2)));
typedef float f32x2_t __attribute__((ext_vector_type(2)));
constexpr float C2 = 0.125f * 1.4426950408889634f;
constexpr int VROW = 192, VT_BYTES = 64 * VROW;
constexpr int BIGD = 1 << 28;
#define ATT_MFMA(a, b, c) __builtin_amdgcn_mfma_f32_32x32x16_bf16((a), (b), (c), 0, 0, 0)
__device__ __forceinline__ unsigned cvtpk(float lo, float hi) { f32x2_t v = {lo, hi}; return __builtin_bit_cast(unsigned, __builtin_convertvector(v, bf16x2_t)); }
__device__ __forceinline__ int clampt(int t) { return t < 0 ? 0 : (t > SEQ - 1 ? SEQ - 1 : t); }
__device__ __forceinline__ float half_max(float v) { auto rr = __builtin_amdgcn_permlane32_swap(__float_as_uint(v), __float_as_uint(v), false, false); return fmaxf(__uint_as_float(rr[0]), __uint_as_float(rr[1])); }
__device__ __forceinline__ float half_sum(float v) { auto rr = __builtin_amdgcn_permlane32_swap(__float_as_uint(v), __float_as_uint(v), false, false); return __uint_as_float(rr[0]) + __uint_as_float(rr[1]); }
struct St { f32x16 o0, o1; float m, l; };
template <int D> __device__ __forceinline__ void bias_vecs(f32x16& b0, f32x16& b1, float ns) {
#pragma unroll
    for (int r = 0; r < 16; ++r) { const int e0 = (r & 3) + 8 * (r >> 2); b0[r] = ns * (float)(D * e0); b1[r] = ns * (float)(D * (e0 + 32)); }
}
template <int MODE, int D, int VR>
__device__ __forceinline__ void tile_core(St& st, f32x16& u0, f32x16& u1, float zoff, bool okl, int D0, int maxd, LAS unsigned char* vrd) {
    if (MODE == 1) {
#pragma unroll
        for (int r = 0; r < 16; ++r) { const int e0 = (r & 3) + 8 * (r >> 2);
            u0[r] = ((unsigned)(D0 - D * e0) <= (unsigned)maxd) ? u0[r] : -INFINITY; u1[r] = ((unsigned)(D0 - D * (e0 + 32)) <= (unsigned)maxd) ? u1[r] : -INFINITY; }
    }
    float tmax = fmaxf(u0[0], u1[0]);
#pragma unroll
    for (int r = 1; r < 16; ++r) tmax = fmaxf(tmax, fmaxf(u0[r], u1[r]));
    tmax = (MODE == 0 && !okl) ? -INFINITY : tmax + zoff;
    tmax = half_max(tmax);
    if (__any(tmax > st.m)) { const float mn = fmaxf(st.m, tmax), al = __builtin_amdgcn_exp2f(C2 * (st.m - mn));
#pragma unroll
        for (int r = 0; r < 16; ++r) { st.o0[r] *= al; st.o1[r] *= al; }
        st.l *= al; st.m = mn; }
    const float off = (MODE == 0 && !okl) ? -INFINITY : C2 * (zoff - st.m);
    float ps = 0.f;
#pragma unroll
    for (int r = 0; r < 16; ++r) { u0[r] = __builtin_amdgcn_exp2f(fmaf(u0[r], C2, off)); u1[r] = __builtin_amdgcn_exp2f(fmaf(u1[r], C2, off)); ps += u0[r] + u1[r]; }
    st.l += ps;
#pragma unroll
    for (int sub = 0; sub < 2; ++sub)
#pragma unroll
        for (int s = 0; s < 2; ++s) {
            v4u pw;
            if (sub == 0) { pw.x = cvtpk(u0[8 * s], u0[8 * s + 1]); pw.y = cvtpk(u0[8 * s + 2], u0[8 * s + 3]); pw.z = cvtpk(u0[8 * s + 4], u0[8 * s + 5]); pw.w = cvtpk(u0[8 * s + 6], u0[8 * s + 7]); }
            else { pw.x = cvtpk(u1[8 * s], u1[8 * s + 1]); pw.y = cvtpk(u1[8 * s + 2], u1[8 * s + 3]); pw.z = cvtpk(u1[8 * s + 4], u1[8 * s + 5]); pw.w = cvtpk(u1[8 * s + 6], u1[8 * s + 7]); }
            const bf16x8 pb = __builtin_bit_cast(bf16x8, pw);
#pragma unroll
            for (int dblk = 0; dblk < 2; ++dblk) {
                const v4i16_t lo = __builtin_amdgcn_ds_read_tr16_b64_v4i16((LAS v4i16_t*)(vrd + (32 * sub + 16 * s) * VR + 64 * dblk));
                const v4i16_t hh = __builtin_amdgcn_ds_read_tr16_b64_v4i16((LAS v4i16_t*)(vrd + (32 * sub + 16 * s + 8) * VR + 64 * dblk));
                const bf16x8 va = __builtin_shufflevector(lo, hh, 0, 1, 2, 3, 4, 5, 6, 7);
                if (dblk == 0) st.o0 = ATT_MFMA(va, pb, st.o0); else st.o1 = ATT_MFMA(va, pb, st.o1);
            }
        }
}
template <int D>
__device__ __forceinline__ void run(St& st, const bf16x8 (&qf)[4], const unsigned char* Kb, const unsigned char* Vb, int tkb, int ntiles,
                                    int tq, int maxd, float ns, LAS unsigned char* vl, int lane) {
    const int r32 = lane & 31, hi = lane >> 5;
    LAS unsigned char* vrd = vl + (4 * hi + ((lane & 15) >> 2)) * VROW + (((lane >> 4) & 1) * 16 + (lane & 3) * 4) * 2;
    LAS unsigned char* vwr = vl + (lane >> 3) * VROW + 16 * (lane & 7);
    f32x16 b0, b1; bias_vecs<D>(b0, b1, ns);
    bf16x8 kf[2][4]; v4u vr[8];
#define ATT_LOADK(t) do { _Pragma("unroll") for (int sub = 0; sub < 2; ++sub) { const unsigned o_ = (unsigned)clampt(tkb + D * (64 * (t) + 32 * sub + r32)) * (unsigned)(NPROJ * 2) + 16u * hi; \
        _Pragma("unroll") for (int d0 = 0; d0 < 4; ++d0) kf[sub][d0] = *(const bf16x8*)(Kb + o_ + 32 * d0); } } while (0)
#define ATT_LOADV(t) do { _Pragma("unroll") for (int i2 = 0; i2 < 8; ++i2) { const unsigned o_ = (unsigned)clampt(tkb + D * (64 * (t) + (lane >> 3) + 8 * i2)) * (unsigned)(NPROJ * 2) + 16u * (lane & 7); \
        vr[i2] = *(const v4u*)(Vb + o_); } } while (0)
    ATT_LOADK(ntiles - 1); ATT_LOADV(ntiles - 1);
    for (int t = ntiles - 1; t >= 0; --t) {
#pragma unroll
        for (int i2 = 0; i2 < 8; ++i2) *(LAS v4u*)(vwr + 8 * i2 * VROW) = vr[i2];
        const int tn = (t > 0) ? t - 1 : 0;
        ATT_LOADV(tn);
        f32x16 s0 = b0, s1 = b1;
#pragma unroll
        for (int d0 = 0; d0 < 4; ++d0) { s0 = ATT_MFMA(kf[0][d0], qf[d0], s0); s1 = ATT_MFMA(kf[1][d0], qf[d0], s1); }
        ATT_LOADK(tn);
        const int tk0 = tkb + D * (64 * t + 4 * hi);
        tile_core<1, D, VROW>(st, s0, s1, ns * (float)tk0, true, tq - tk0, maxd, vrd);
    }
#undef ATT_LOADK
#undef ATT_LOADV
}
__device__ __forceinline__ void st_init(St& st) {
#pragma unroll
    for (int r = 0; r < 16; ++r) { st.o0[r] = 0.f; st.o1[r] = 0.f; }
    st.m = -1e30f; st.l = 0.f;
}
__device__ __forceinline__ void load_q(bf16x8 (&qf)[4], const bf16* qrow, int hi) {
#pragma unroll
    for (int d0 = 0; d0 < 4; ++d0) qf[d0] = *(const bf16x8*)(qrow + 16 * d0 + 8 * hi);
}
__device__ __forceinline__ void st_store(St& st, bf16* yrow, int hi) {
    const float lt = half_sum(st.l), inv = 1.0f / lt;
#pragma unroll
    for (int g = 0; g < 4; ++g) {
        unsigned long long w0 = (unsigned long long)cvtpk(st.o0[4 * g] * inv, st.o0[4 * g + 1] * inv) | ((unsigned long long)cvtpk(st.o0[4 * g + 2] * inv, st.o0[4 * g + 3] * inv) << 32);
        unsigned long long w1 = (unsigned long long)cvtpk(st.o1[4 * g] * inv, st.o1[4 * g + 1] * inv) | ((unsigned long long)cvtpk(st.o1[4 * g + 2] * inv, st.o1[4 * g + 3] * inv) << 32);
        *(unsigned long long*)(yrow + 8 * g + 4 * hi) = w0; *(unsigned long long*)(yrow + 32 + 8 * g + 4 * hi) = w1; }
}
__device__ __forceinline__ unsigned moba_select(const bf16x8 (&qf)[4], const float* kms, int b, int h, int blk, int r32, int hi, unsigned& picks) {
    f32x16 gt;
#pragma unroll
    for (int r = 0; r < 16; ++r) gt[r] = 0.f;
    { const float* kp = kms + ((size_t)((b * 16 + (r32 & 15)) * 4 + h)) * 64 + 8 * hi;
#pragma unroll
      for (int d0 = 0; d0 < 4; ++d0) { const f32x4 a = *(const f32x4*)(kp + 16 * d0) * (1.0f / 256.0f), c = *(const f32x4*)(kp + 16 * d0 + 4) * (1.0f / 256.0f);
          v4u hw, lw; hw.x = cvtpk(a.x, a.y); hw.y = cvtpk(a.z, a.w); hw.z = cvtpk(c.x, c.y); hw.w = cvtpk(c.z, c.w);
          lw.x = cvtpk(a.x - blo(hw.x), a.y - bhi(hw.x)); lw.y = cvtpk(a.z - blo(hw.y), a.w - bhi(hw.y)); lw.z = cvtpk(c.x - blo(hw.z), c.y - bhi(hw.z)); lw.w = cvtpk(c.z - blo(hw.w), c.w - bhi(hw.w));
          gt = ATT_MFMA(__builtin_bit_cast(bf16x8, hw), qf[d0], gt); gt = ATT_MFMA(__builtin_bit_cast(bf16x8, lw), qf[d0], gt); } }
    float og[8];
#pragma unroll
    for (int r = 0; r < 8; ++r) og[r] = __shfl_xor(gt[r], 32);
    float G[16];
#pragma unroll
    for (int n = 0; n < 16; ++n) { const int rn = (n & 3) + 4 * (n >> 3); G[n] = (((n >> 2) & 1) == hi) ? gt[rn] : og[rn]; }
    unsigned selmask = 0u; picks = 0xfffu;
#pragma unroll
    for (int s = 0; s < 3; ++s) { float bv = -INFINITY; int best = -1;
#pragma unroll
        for (int n = 0; n < 16; ++n) { if (n < blk && !((selmask >> n) & 1u) && G[n] > bv) { bv = G[n]; best = n; } }
        if (best >= 0) { selmask |= 1u << best; picks = (picks & ~(15u << (4 * s))) | ((unsigned)best << (4 * s)); } }
    return selmask;
}
}

constexpr size_t WS_PAO = 248 * MiB, WS_PAM = 54 * MiB, WS_PAL = 54 * MiB + 256 * 1024;
namespace attc {
constexpr int KROW = 144, VROWC = 192;
constexpr int KT_BYTES = 128 * KROW, VT_BYTES_C = 128 * VROWC, STAGE = KT_BYTES + VT_BYTES_C;
}
__device__ __forceinline__ void mixA1_coop(Frame& F) {
    using namespace att;
    unsigned char* ws = ARGWS();
    const bf16* proj = (const bf16*)(ws + WS_PROJ); bf16* pao = (bf16*)(ws + WS_PAO); float* pam = (float*)(ws + WS_PAM); float* pal = (float*)(ws + WS_PAL);
    const int lane = F.lane, r32 = lane & 31, hi = lane >> 5, w = F.wave, tid = F.tid;
    LAS unsigned char* L0 = F.lds + RING_OFF;
    const int bh = F.vcu >> 4, qb = F.vcu & 15, b = bh >> 2, h = bh & 3, rowb = b * SEQ, t0 = 256 * qb, tq = t0 + 32 * w + r32;
    const float ns = 8.0f * exp2f(-(float)(2 * h + 1));
    const bf16* Kg = proj + (size_t)rowb * NPROJ + OFF_KA + h * 64; const bf16* Vg = proj + (size_t)rowb * NPROJ + OFF_VA + h * 64;
    const int lrow0 = tid >> 3, lch = tid & 7;
    const int koff = lrow0 * attc::KROW + 16 * lch, voff = attc::KT_BYTES + lrow0 * attc::VROWC + 16 * lch;
    const int kfo = r32 * attc::KROW + 16 * hi;
    const int vfo = attc::KT_BYTES + (4 * hi + ((lane & 15) >> 2)) * attc::VROWC + (((lane >> 4) & 1) * 16 + (lane & 3) * 4) * 2;
    f32x16 b0, b1; bias_vecs<1>(b0, b1, ns);
    bf16x8 qf[4]; load_q(qf, proj + (size_t)(rowb + tq) * NPROJ + OFF_QA + h * 64, hi);
    St st; st_init(st);
    const int s_lo = (qb == 0) ? 1 : 0;
    v4u kr[2], vr[2];
#define MA_LOAD(s) do { _Pragma("unroll") for (int j = 0; j < 2; ++j) { const size_t o_ = (size_t)(t0 - 128 + 128 * (s) + 64 * j + lrow0) * NPROJ + 8 * lch; kr[j] = *(const v4u*)(Kg + o_); vr[j] = *(const v4u*)(Vg + o_); } } while (0)
#define MA_STORE(buf) do { LAS unsigned char* sb_ = L0 + (buf) * attc::STAGE; _Pragma("unroll") for (int j = 0; j < 2; ++j) { *(LAS v4u*)(sb_ + koff + 64 * j * attc::KROW) = kr[j]; *(LAS v4u*)(sb_ + voff + 64 * j * attc::VROWC) = vr[j]; } } while (0)
    __syncthreads();
    MA_LOAD(2); MA_STORE(0); MA_LOAD(1);
#pragma unroll 1
    for (int i = 0; i < 3 - s_lo; ++i) {
        const int s = 2 - i;
        __syncthreads();
        if (s - 1 >= s_lo) { MA_STORE((i + 1) & 1); if (s - 2 >= s_lo) MA_LOAD(s - 2); }
        LAS unsigned char* sb = L0 + (i & 1) * attc::STAGE;
#pragma unroll
        for (int u = 1; u >= 0; --u) {
            const int ta = t0 - 128 + 128 * s + 64 * u;
            if (ta <= t0 + 32 * w + 31 && ta + 63 >= t0 + 32 * w - 128) {
                bf16x8 kf[2][4];
#pragma unroll
                for (int sub = 0; sub < 2; ++sub)
#pragma unroll
                    for (int d0 = 0; d0 < 4; ++d0) kf[sub][d0] = *(const LAS bf16x8*)(sb + kfo + (64 * u + 32 * sub) * attc::KROW + 32 * d0);
                f32x16 s0 = b0, s1 = b1;
#pragma unroll
                for (int d0 = 0; d0 < 4; ++d0) { s0 = ATT_MFMA(kf[0][d0], qf[d0], s0); s1 = ATT_MFMA(kf[1][d0], qf[d0], s1); }
                const int tk0 = ta + 4 * hi;
                tile_core<1, 1, attc::VROWC>(st, s0, s1, ns * (float)tk0, true, tq - tk0, tq < 128 ? tq : 128, sb + vfo + 64 * u * attc::VROWC);
            }
        }
    }
#undef MA_LOAD
#undef MA_STORE
    const float lt = half_sum(st.l), inv = 1.0f / lt;
    bf16* orow = pao + ((size_t)(rowb + tq) * 4 + h) * 64;
#pragma unroll
    for (int g = 0; g < 4; ++g) {
        unsigned long long w0 = (unsigned long long)cvtpk(st.o0[4 * g] * inv, st.o0[4 * g + 1] * inv) | ((unsigned long long)cvtpk(st.o0[4 * g + 2] * inv, st.o0[4 * g + 3] * inv) << 32);
        unsigned long long w1 = (unsigned long long)cvtpk(st.o1[4 * g] * inv, st.o1[4 * g + 1] * inv) | ((unsigned long long)cvtpk(st.o1[4 * g + 2] * inv, st.o1[4 * g + 3] * inv) << 32);
        *(unsigned long long*)(orow + 8 * g + 4 * hi) = w0; *(unsigned long long*)(orow + 32 + 8 * g + 4 * hi) = w1; }
    if (hi == 0) { pam[(size_t)(rowb + tq) * 4 + h] = st.m; pal[(size_t)(rowb + tq) * 4 + h] = lt; }
    __syncthreads();
}
__device__ __forceinline__ void mixA23_mfma(Frame& F) {
    unsigned char* ws = ARGWS();
    const bf16* proj = (const bf16*)(ws + WS_PROJ); bf16* y = (bf16*)(ws + WS_Y);
    const bf16* pao = (const bf16*)(ws + WS_PAO); const float* pam = (const float*)(ws + WS_PAM); const float* pal = (const float*)(ws + WS_PAL);
    const int lane = F.lane, r32 = lane & 31, hi = lane >> 5, w = F.wave;
    LAS unsigned char* vl = F.lds + RING_OFF + w * att::VT_BYTES;
    const int gw = F.vcu * NWAVES + w;
    const int bh = gw >> 7, r16 = (gw >> 3) & 15, ig = gw & 7;
    const int b = bh >> 2, h = bh & 3, rowb = b * SEQ, tq0 = r16 + 512 * ig, tq = tq0 + 16 * r32;
    bf16x8 qf[4]; att::load_q(qf, proj + (size_t)(rowb + tq) * NPROJ + OFF_QA + h * 64, hi);
    att::St st; att::st_init(st);
    const float ns = 8.0f * exp2f(-(float)(2 * h + 1));
    const unsigned char* Kb = (const unsigned char*)(proj + (size_t)rowb * NPROJ + OFF_KA + h * 64); const unsigned char* Vb = (const unsigned char*)(proj + (size_t)rowb * NPROJ + OFF_VA + h * 64);
    att::run<4>(st, qf, Kb, Vb, tq0 - 512, 4, tq, tq < 512 ? tq : 512, ns, vl, lane);
    att::run<16>(st, qf, Kb, Vb, tq0 - 2048, 3, tq, tq < 2048 ? tq : 2048, ns, vl, lane);
    const size_t pidx = (size_t)(rowb + tq) * 4 + h;
    const float m1 = pam[pidx], l1 = pal[pidx], l2 = att::half_sum(st.l), mm = fmaxf(st.m, m1);
    const float a2 = __builtin_amdgcn_exp2f(att::C2 * (st.m - mm)), a1 = __builtin_amdgcn_exp2f(att::C2 * (m1 - mm)) * l1;
    const float inv = 1.0f / (l2 * a2 + a1);
    const bf16* orow = pao + pidx * 64; bf16* yrow = y + (size_t)(rowb + tq) * DM + h * 64;
#pragma unroll
    for (int g = 0; g < 4; ++g) {
        const unsigned long long p0 = *(const unsigned long long*)(orow + 8 * g + 4 * hi), p1 = *(const unsigned long long*)(orow + 32 + 8 * g + 4 * hi);
        const float q0[4] = {blo((unsigned)p0), bhi((unsigned)p0), blo((unsigned)(p0 >> 32)), bhi((unsigned)(p0 >> 32))};
        const float q1[4] = {blo((unsigned)p1), bhi((unsigned)p1), blo((unsigned)(p1 >> 32)), bhi((unsigned)(p1 >> 32))};
        float r0[4], r1[4];
#pragma unroll
        for (int e = 0; e < 4; ++e) { r0[e] = (st.o0[4 * g + e] * a2 + q0[e] * a1) * inv; r1[e] = (st.o1[4 * g + e] * a2 + q1[e] * a1) * inv; }
        *(unsigned long long*)(yrow + 8 * g + 4 * hi) = (unsigned long long)att::cvtpk(r0[0], r0[1]) | ((unsigned long long)att::cvtpk(r0[2], r0[3]) << 32);
        *(unsigned long long*)(yrow + 32 + 8 * g + 4 * hi) = (unsigned long long)att::cvtpk(r1[0], r1[1]) | ((unsigned long long)att::cvtpk(r1[2], r1[3]) << 32); }
}
constexpr size_t WS_MCNT = 768 * 1024;
constexpr size_t WS_MLIST = 51 * MiB + 512 * 1024;
constexpr size_t WS_MPM = 52 * MiB + 512 * 1024, WS_MPL = 53 * MiB + 256 * 1024;
__device__ __forceinline__ int moba_list_base(int b, int h, int j) { return (b * 4 + h) * 30720 + 256 * (15 * j - ((j * (j - 1)) >> 1)); }
__device__ __forceinline__ void moba_build(Frame& F, int l) {
    using namespace att;
    unsigned char* ws = ARGWS();
    const bf16* proj = (const bf16*)(ws + WS_PROJ); const float* kms = (const float*)(ws + WS_KMS) + (size_t)l * (BATCH * 16 * 4 * 64);
    unsigned* cnt = (unsigned*)(ws + WS_MCNT) + l * 256; unsigned short* list = (unsigned short*)(ws + WS_MLIST);
    const int lane = F.lane, r32 = lane & 31, hi = lane >> 5, w = F.wave;
    const int bh = F.vcu >> 4, blk = F.vcu & 15, b = bh >> 2, h = bh & 3, rowb = b * SEQ, tq = 256 * blk + 32 * w + r32;
    if (blk == 0) return;
    bf16x8 qf[4]; load_q(qf, proj + (size_t)(rowb + tq) * NPROJ + OFF_QC + h * 64, hi);
    unsigned picks; (void)moba_select(qf, kms, b, h, blk, r32, hi, picks);
    const int p0 = picks & 15, p1 = (picks >> 4) & 15, p2 = (picks >> 8) & 15;
    unsigned cntv = 0u;
#pragma unroll 1
    for (int j = 0; j < blk; ++j) { const bool pr = (hi == 0) && (p0 == j || p1 == j || p2 == j); const unsigned long long bal = __ballot(pr); if (lane == j) cntv = (unsigned)__popcll(bal); }
    unsigned basev = 0u;
    if (lane < 15 && cntv > 0u) basev = atomicAdd(cnt + (b * 4 + h) * 16 + lane, cntv);
#pragma unroll 1
    for (int j = 0; j < blk; ++j) { {
        const bool pr = (hi == 0) && (p0 == j || p1 == j || p2 == j); const unsigned long long bal = __ballot(pr);
        if (bal) { const unsigned bj = (unsigned)__shfl((int)basev, j);
            if (pr) { const unsigned pos = bj + (unsigned)__popcll(bal & ((1ull << lane) - 1ull)); const unsigned slot = (p0 == j) ? 0u : (p1 == j) ? 1u : 2u;
                list[moba_list_base(b, h, j) + pos] = (unsigned short)((unsigned)tq | (slot << 12)); } } } }
}
__device__ __forceinline__ void moba_lists(Frame& F, int l) {
    using namespace att;
    unsigned char* ws = ARGWS();
    const bf16* proj = (const bf16*)(ws + WS_PROJ);
    const unsigned* cnt = (const unsigned*)(ws + WS_MCNT) + l * 256; const unsigned short* list = (const unsigned short*)(ws + WS_MLIST);
    unsigned char* PB = (l == 0) ? (unsigned char*)ARGOUT() : ws + WS_W;
    float* pm = (float*)(ws + WS_MPM); float* pl = (float*)(ws + WS_MPL);
    asm volatile("" : "+v"(pm), "+v"(pl), "+v"(PB));
    const int lane = F.lane, r32 = lane & 31, hi = lane >> 5, w = F.wave, tid = F.tid;
    LAS unsigned char* L0 = F.lds + RING_OFF;
    constexpr int KB_BYTES = 256 * attc::KROW, VB_BYTES = 256 * attc::VROWC;
    LAS unsigned* cin = (LAS unsigned*)(L0 + KB_BYTES + VB_BYTES); LAS unsigned* pre = cin + 256;
    __syncthreads();
    unsigned cmine = 0u, cinc = 0u;
    constexpr unsigned SEGW = 256u;
    if (tid < 256) { cmine = cnt[tid]; cmine = cmine ? cmine + SEGW : 0u; cinc = cmine;
#pragma unroll
        for (int o = 1; o < 64; o <<= 1) { const unsigned t_ = (unsigned)__shfl_up((int)cinc, o); if (lane >= o) cinc += t_; }
        if (lane == 63) cin[w] = cinc; }
    __syncthreads();
    if (tid < 256) { unsigned off = 0u;
#pragma unroll
        for (int i = 0; i < 3; ++i) if (i < w) off += cin[i];
        pre[tid] = off + cinc - cmine; if (tid == 255) pre[256] = off + cinc; }
    __syncthreads();
    const unsigned T = pre[256];
    const unsigned lo = (unsigned)(((unsigned long long)T * (unsigned)F.vcu) >> 8), hi_ = (unsigned)(((unsigned long long)T * (unsigned)(F.vcu + 1)) >> 8);
    LAS unsigned* lrng = pre + 260;
    if (tid == 0) { lrng[0] = 256u; lrng[1] = 0u; }
    __syncthreads();
    if (tid < 256) { const unsigned sL = pre[tid] + SEGW, eL = pre[tid + 1]; if (eL > sL && sL < hi_ && eL > lo) { atomicMin((unsigned*)lrng, (unsigned)tid); atomicMax((unsigned*)lrng + 1, (unsigned)tid); } }
    __syncthreads();
    const int Lfirst = (int)lrng[0], Llast = (int)lrng[1];
    const int kfo = r32 * attc::KROW + 16 * hi;
    const int vfo = KB_BYTES + (4 * hi + ((lane & 15) >> 2)) * attc::VROWC + (((lane >> 4) & 1) * 16 + (lane & 3) * 4) * 2;
#pragma unroll 1
    for (int L = Lfirst; L <= Llast; ++L) {
        const unsigned sL = pre[L] + SEGW, eL = pre[L + 1]; const unsigned a = lo > sL ? lo : sL, e = hi_ < eL ? hi_ : eL;
        if (a >= e) continue;
        const int bh = L >> 4, j = L & 15, b = bh >> 2, h = bh & 3, rowb = b * SEQ;
        const float ns = 8.0f * exp2f(-(float)(2 * h + 2));
        const int lb = moba_list_base(b, h, j) - (int)sL;
        const int nt = (int)((e - a + 31u) >> 5);
        unsigned ent_n = 0u;
        if (w < nt) { const unsigned idx0 = a + 32u * (unsigned)w + (unsigned)r32; ent_n = list[lb + (int)(idx0 < e ? idx0 : a)]; }
        __syncthreads();
        { const bf16* Kg = proj + (size_t)(rowb + 256 * j) * NPROJ + OFF_KC + h * 64; const bf16* Vg = proj + (size_t)(rowb + 256 * j) * NPROJ + OFF_VC + h * 64;
          v4u kr[4], vr[4];
#pragma unroll
          for (int i = 0; i < 4; ++i) { const int c = tid + 512 * i, row = c >> 3, ch = c & 7; kr[i] = *(const v4u*)(Kg + (size_t)row * NPROJ + 8 * ch); vr[i] = *(const v4u*)(Vg + (size_t)row * NPROJ + 8 * ch); }
#pragma unroll
          for (int i = 0; i < 4; ++i) { const int c = tid + 512 * i, row = c >> 3, ch = c & 7; *(LAS v4u*)(L0 + row * attc::KROW + 16 * ch) = kr[i]; *(LAS v4u*)(L0 + KB_BYTES + row * attc::VROWC + 16 * ch) = vr[i]; } }
        __syncthreads();
#pragma unroll 1
        for (int t = w; t < nt; t += NWAVES) {
            const unsigned idx = a + 32u * (unsigned)t + (unsigned)r32; const bool valid = idx < e;
            const unsigned ent = ent_n; const int tq = (int)(ent & 4095u); const unsigned slot = ent >> 12;
            bf16x8 qf[4]; load_q(qf, proj + (size_t)(rowb + tq) * NPROJ + OFF_QC + h * 64, hi);
            if (t + NWAVES < nt) { const unsigned idx1 = idx + 32u * NWAVES; ent_n = list[lb + (int)(idx1 < e ? idx1 : a)]; }
            St st; st_init(st);
#pragma unroll 1
            for (int kt = 3; kt >= 0; --kt) {
                bf16x8 kf[2][4];
#pragma unroll
                for (int sub = 0; sub < 2; ++sub)
#pragma unroll
                    for (int d0 = 0; d0 < 4; ++d0) kf[sub][d0] = *(const LAS bf16x8*)(L0 + kfo + (64 * kt + 32 * sub) * attc::KROW + 32 * d0);
                f32x16 s0, s1; bias_vecs<1>(s0, s1, ns);
#pragma unroll
                for (int d0 = 0; d0 < 4; ++d0) { s0 = ATT_MFMA(kf[0][d0], qf[d0], s0); s1 = ATT_MFMA(kf[1][d0], qf[d0], s1); }
                tile_core<0, 1, attc::VROWC>(st, s0, s1, ns * (float)(256 * j + 64 * kt + 4 * hi), valid, 0, 0, L0 + vfo + 64 * kt * attc::VROWC);
            }
            const float lt = half_sum(st.l), inv = 1.0f / lt;
            if (valid) {
                const size_t pidx = (size_t)(rowb + tq) * 4 + h;
                bf16* orow = (bf16*)(PB + (size_t)slot * (8 * MiB)) + pidx * 64;
#pragma unroll
                for (int g = 0; g < 4; ++g) {
                    unsigned long long w0 = (unsigned long long)cvtpk(st.o0[4 * g] * inv, st.o0[4 * g + 1] * inv) | ((unsigned long long)cvtpk(st.o0[4 * g + 2] * inv, st.o0[4 * g + 3] * inv) << 32);
                    unsigned long long w1 = (unsigned long long)cvtpk(st.o1[4 * g] * inv, st.o1[4 * g + 1] * inv) | ((unsigned long long)cvtpk(st.o1[4 * g + 2] * inv, st.o1[4 * g + 3] * inv) << 32);
                    *(unsigned long long*)(orow + 8 * g + 4 * hi) = w0; *(unsigned long long*)(orow + 32 + 8 * g + 4 * hi) = w1; }
                if (hi == 0) { pm[(size_t)slot * (M * 4) + pidx] = st.m; pl[(size_t)slot * (M * 4) + pidx] = lt; }
            }
        }
    }
    __syncthreads();
}
__device__ __forceinline__ void moba_own256_merge(Frame& F, int l) {
    using namespace att;
    unsigned char* ws = ARGWS();
    const bf16* proj = (const bf16*)(ws + WS_PROJ); bf16* y = (bf16*)(ws + WS_Y);
    const unsigned char* PB = (l == 0) ? (const unsigned char*)ARGOUT() : ws + WS_W;
    const float* pm = (const float*)(ws + WS_MPM); const float* pl = (const float*)(ws + WS_MPL);
    const int lane = F.lane, r32 = lane & 31, hi = lane >> 5, w = F.wave, tid = F.tid;
    LAS unsigned char* L0 = F.lds + RING_OFF;
    constexpr int KB_BYTES = 256 * attc::KROW;
    const int bh = F.vcu >> 4, blk = F.vcu & 15, b = bh >> 2, h = bh & 3, rowb = b * SEQ, tq = 256 * blk + 32 * w + r32;
    const float ns = 8.0f * exp2f(-(float)(2 * h + 2));
    const int kfo = r32 * attc::KROW + 16 * hi;
    const int vfo = KB_BYTES + (4 * hi + ((lane & 15) >> 2)) * attc::VROWC + (((lane >> 4) & 1) * 16 + (lane & 3) * 4) * 2;
    bf16x8 qf[4]; load_q(qf, proj + (size_t)(rowb + tq) * NPROJ + OFF_QC + h * 64, hi);
    __syncthreads();
    { const bf16* Kg = proj + (size_t)(rowb + 256 * blk) * NPROJ + OFF_KC + h * 64; const bf16* Vg = proj + (size_t)(rowb + 256 * blk) * NPROJ + OFF_VC + h * 64;
      v4u kr[4], vr[4];
#pragma unroll
      for (int i = 0; i < 4; ++i) { const int c = tid + 512 * i, row = c >> 3, ch = c & 7; kr[i] = *(const v4u*)(Kg + (size_t)row * NPROJ + 8 * ch); vr[i] = *(const v4u*)(Vg + (size_t)row * NPROJ + 8 * ch); }
#pragma unroll
      for (int i = 0; i < 4; ++i) { const int c = tid + 512 * i, row = c >> 3, ch = c & 7; *(LAS v4u*)(L0 + row * attc::KROW + 16 * ch) = kr[i]; *(LAS v4u*)(L0 + KB_BYTES + row * attc::VROWC + 16 * ch) = vr[i]; } }
    const size_t pidx = (size_t)(rowb + tq) * 4 + h; const int nsel = blk < 3 ? blk : 3;
    float mp[3], lp[3];
#pragma unroll
    for (int s = 0; s < 3; ++s) { mp[s] = -1e30f; lp[s] = 0.f; if (s < nsel) { mp[s] = pm[(size_t)s * (M * 4) + pidx]; lp[s] = pl[(size_t)s * (M * 4) + pidx]; } }
    __syncthreads();
    St st; st_init(st);
    const int ktl = w >> 1;
#pragma unroll 1
    for (int kt = ktl; kt >= 0; --kt) {
        bf16x8 kf[2][4];
#pragma unroll
        for (int sub = 0; sub < 2; ++sub)
#pragma unroll
            for (int d0 = 0; d0 < 4; ++d0) kf[sub][d0] = *(const LAS bf16x8*)(L0 + kfo + (64 * kt + 32 * sub) * attc::KROW + 32 * d0);
        f32x16 s0, s1; bias_vecs<1>(s0, s1, ns);
#pragma unroll
        for (int d0 = 0; d0 < 4; ++d0) { s0 = ATT_MFMA(kf[0][d0], qf[d0], s0); s1 = ATT_MFMA(kf[1][d0], qf[d0], s1); }
        const int tk0 = 256 * blk + 64 * kt + 4 * hi;
        if (kt == ktl) tile_core<1, 1, attc::VROWC>(st, s0, s1, ns * (float)tk0, true, tq - tk0, BIGD, L0 + vfo + 64 * kt * attc::VROWC);
        else tile_core<0, 1, attc::VROWC>(st, s0, s1, ns * (float)tk0, true, 0, 0, L0 + vfo + 64 * kt * attc::VROWC);
    }
    float mm = st.m;
#pragma unroll
    for (int s = 0; s < 3; ++s) mm = fmaxf(mm, mp[s]);
    const float a1 = __builtin_amdgcn_exp2f(C2 * (st.m - mm));
    float ap[3];
#pragma unroll
    for (int s = 0; s < 3; ++s) ap[s] = __builtin_amdgcn_exp2f(C2 * (mp[s] - mm)) * lp[s];
    const float inv = 1.0f / (half_sum(st.l) * a1 + ap[0] + ap[1] + ap[2]);
    bf16* yrow = y + (size_t)(rowb + tq) * DM + 768 + h * 64;
#pragma unroll
    for (int g = 0; g < 4; ++g) {
        float r0[4], r1[4];
#pragma unroll
        for (int e = 0; e < 4; ++e) { r0[e] = st.o0[4 * g + e] * a1; r1[e] = st.o1[4 * g + e] * a1; }
#pragma unroll
        for (int s = 0; s < 3; ++s) { if (s < nsel) {
            const bf16* orow = (const bf16*)(PB + (size_t)s * (8 * MiB)) + pidx * 64;
            const unsigned long long p0 = *(const unsigned long long*)(orow + 8 * g + 4 * hi), p1 = *(const unsigned long long*)(orow + 32 + 8 * g + 4 * hi);
            r0[0] += blo((unsigned)p0) * ap[s]; r0[1] += bhi((unsigned)p0) * ap[s]; r0[2] += blo((unsigned)(p0 >> 32)) * ap[s]; r0[3] += bhi((unsigned)(p0 >> 32)) * ap[s];
            r1[0] += blo((unsigned)p1) * ap[s]; r1[1] += bhi((unsigned)p1) * ap[s]; r1[2] += blo((unsigned)(p1 >> 32)) * ap[s]; r1[3] += bhi((unsigned)(p1 >> 32)) * ap[s]; } }
        *(unsigned long long*)(yrow + 8 * g + 4 * hi) = (unsigned long long)cvtpk(r0[0] * inv, r0[1] * inv) | ((unsigned long long)cvtpk(r0[2] * inv, r0[3] * inv) << 32);
        *(unsigned long long*)(yrow + 32 + 8 * g + 4 * hi) = (unsigned long long)cvtpk(r1[0] * inv, r1[1] * inv) | ((unsigned long long)cvtpk(r1[2] * inv, r1[3] * inv) << 32); }
    __syncthreads();
}

namespace ssd {
typedef float f32x16 __attribute__((ext_vector_type(16)));
typedef short v4i16_t __attribute__((ext_vector_type(4)));
constexpr int RS_BTR = 320, RS_XTR = 576;
constexpr int RS_ROW = 272;
constexpr int RS_XH = 192;
#define SSD_MFMA(a, b, c) __builtin_amdgcn_mfma_f32_32x32x16_bf16((a), (b), (c), 0, 0, 0)
__device__ __forceinline__ bf16x8 trpair(LAS unsigned char* p, int rs4  ) {
    const v4i16_t lo = __builtin_amdgcn_ds_read_tr16_b64_v4i16((LAS v4i16_t*)p);
    const v4i16_t hh = __builtin_amdgcn_ds_read_tr16_b64_v4i16((LAS v4i16_t*)(p + rs4));
    return __builtin_shufflevector(lo, hh, 0, 1, 2, 3, 4, 5, 6, 7);
}
__device__ __forceinline__ float chunk_acs(float d0, float d1  , float A, LAS float* acs, LAS float* dts, int lane) {
    float s0 = d0 * A, s1 = d1 * A;
#pragma unroll
    for (int o = 1; o < 64; o <<= 1) { const float t0 = __shfl_up(s0, o), t1 = __shfl_up(s1, o); if (lane >= o) { s0 += t0; s1 += t1; } }
    const float tot0 = __shfl(s0, 63); s1 += tot0;
    acs[lane] = s0; acs[64 + lane] = s1; dts[lane] = d0; dts[64 + lane] = d1;
    return __shfl(s1, 63);
}
__device__ __forceinline__ void conv_load(v4u (&raw)[11], const bf16* proj, int rowg0, bool first_chunk, int rb, int c0) {
#pragma unroll
    for (int j = 0; j < 11; ++j) { const int rr = 8 * rb - 3 + j;
        if (first_chunk && rr < 0) raw[j] = (v4u){0u, 0u, 0u, 0u}; else raw[j] = *(const v4u*)(proj + (size_t)(rowg0 + rr) * NPROJ + OFF_XBC + c0); }
}
__device__ __forceinline__ void conv_compute(const v4u (&raw)[11], const float* cw, const float* cb, int rb, int c0, LAS unsigned char* dst, int rs, const LAS float* rowscale) {
    float w[4][8], bs[8];
#pragma unroll
    for (int j = 0; j < 4; ++j) { const f32x4 a = *(const f32x4*)(cw + j * 1024 + c0), b = *(const f32x4*)(cw + j * 1024 + c0 + 4);
        w[j][0] = a.x; w[j][1] = a.y; w[j][2] = a.z; w[j][3] = a.w; w[j][4] = b.x; w[j][5] = b.y; w[j][6] = b.z; w[j][7] = b.w; }
    { const f32x4 a = *(const f32x4*)(cb + c0), b = *(const f32x4*)(cb + c0 + 4); bs[0] = a.x; bs[1] = a.y; bs[2] = a.z; bs[3] = a.w; bs[4] = b.x; bs[5] = b.y; bs[6] = b.z; bs[7] = b.w; }
#pragma unroll
    for (int r = 0; r < 8; ++r) {
        float o[8];
#pragma unroll
        for (int e = 0; e < 8; ++e) o[e] = bs[e];
#pragma unroll
        for (int j = 0; j < 4; ++j) { const v4u u = raw[r + j];
            o[0] += w[j][0] * blo(u.x); o[1] += w[j][1] * bhi(u.x); o[2] += w[j][2] * blo(u.y); o[3] += w[j][3] * bhi(u.y);
            o[4] += w[j][4] * blo(u.z); o[5] += w[j][5] * bhi(u.z); o[6] += w[j][6] * blo(u.w); o[7] += w[j][7] * bhi(u.w); }
        const float sc = rowscale ? rowscale[8 * rb + r] : 1.0f;
#pragma unroll
        for (int e = 0; e < 8; ++e) o[e] = o[e] * __builtin_amdgcn_rcpf(1.0f + __builtin_amdgcn_exp2f(-1.4426950408889634f * o[e])) * sc;
        v4u q; q.x = pk2(o[0], o[1]); q.y = pk2(o[2], o[3]); q.z = pk2(o[4], o[5]); q.w = pk2(o[6], o[7]);
        *(LAS v4u*)(dst + (8 * rb + r) * rs) = q;
    }
}
}
constexpr size_t WS_CDEC = 50 * MiB + 512 * 1024;

__device__ __forceinline__ void ssd_states(Frame& F, int l) {
    unsigned char* ws = ARGWS();
    const bf16* proj = (const bf16*)(ws + WS_PROJ); const float* dt = (const float*)(ws + WS_DT); float* states = (float*)(ws + WS_ST); float* cdec = (float*)(ws + WS_CDEC);
    const float* cw = ARGF(7) + (size_t)l * 4 * 1024; const float* cb = ARGF(8) + (size_t)l * 1024; const float* alog = ARGF(10) + l * 8;
    const int lane = F.lane, w = F.wave, tid = F.tid, hi = lane >> 5;
    LAS float* acs = (LAS float*)(F.lds + RING_OFF);
    LAS float* wl = acs + 512;
    LAS unsigned char* Bt = F.lds + RING_OFF + 4096;
    LAS unsigned char* Xt = Bt + 128 * ssd::RS_BTR;
    for (int u = F.vcu; u < BATCH * 32 * 2; u += F.G) {
        const int b = u >> 6, c = (u >> 1) & 31, g = u & 1, rowg0 = b * SEQ + c * 128;
        v4u rawx[11], rawb[11];
        ssd::conv_load(rawx, proj, rowg0, c == 0, tid >> 5, g * 256 + 8 * (tid & 31));
        if (tid < 256) ssd::conv_load(rawb, proj, rowg0, c == 0, tid >> 4, 512 + g * 128 + 8 * (tid & 15));
        float dta = 0.f, dtb = 0.f, Ah = 0.f;
        if (w < 4) { dta = dt[(size_t)(rowg0 + lane) * 8 + 4 * g + w]; dtb = dt[(size_t)(rowg0 + 64 + lane) * 8 + 4 * g + w]; Ah = alog[4 * g + w]; }
        __syncthreads();
        if (w < 4) { const int hh = 4 * g + w; const float A = -__expf(Ah);
            const float last = ssd::chunk_acs(dta, dtb, A, acs + 128 * w, wl + 128 * w, lane);
            const float a0 = acs[128 * w + lane], a1 = acs[128 * w + 64 + lane];
            wl[128 * w + lane] = wl[128 * w + lane] * __expf(last - a0); wl[128 * w + 64 + lane] = wl[128 * w + 64 + lane] * __expf(last - a1);
            if (lane == 0) cdec[(size_t)(b * 32 + c) * 8 + hh] = __expf(last); }
        __syncthreads();
        { const int rb = tid >> 5, ch = tid & 31, c0 = g * 256 + 8 * ch;
          ssd::conv_compute(rawx, cw, cb, rb, c0, Xt + 16 * ch, ssd::RS_XTR, wl + 128 * (ch >> 3)); }
        if (tid < 256) { const int rb = tid >> 4, ch = tid & 15, c0 = 512 + g * 128 + 8 * ch;
          ssd::conv_compute(rawb, cw, cb, rb, c0, Bt + 16 * ch, ssd::RS_BTR, nullptr); }
        __syncthreads();
        { const int hl = w >> 1, ph = w & 1, hh = 4 * g + hl;
          LAS unsigned char* xa = Xt + (8 * hi + ((lane & 15) >> 2)) * ssd::RS_XTR + (hl * 64 + 32 * ph + 16 * ((lane >> 4) & 1) + 4 * (lane & 3)) * 2;
          LAS unsigned char* ba = Bt + (8 * hi + ((lane & 15) >> 2)) * ssd::RS_BTR + (16 * ((lane >> 4) & 1) + 4 * (lane & 3)) * 2;
          float* sp = states + ((size_t)((b * 32 + c) * 8 + hh)) * 8192 + (size_t)(32 * ph) * 128 + (lane & 31);
#pragma unroll
          for (int nt = 0; nt < 4; ++nt) {
              ssd::f32x16 acc;
#pragma unroll
              for (int r = 0; r < 16; ++r) acc[r] = 0.f;
#pragma unroll
              for (int kk = 0; kk < 8; ++kk) {
                  const bf16x8 af = ssd::trpair(xa + 16 * kk * ssd::RS_XTR, 4 * ssd::RS_XTR);
                  const bf16x8 bfr = ssd::trpair(ba + 16 * kk * ssd::RS_BTR + 64 * nt, 4 * ssd::RS_BTR);
                  acc = SSD_MFMA(af, bfr, acc); }
#pragma unroll
              for (int r = 0; r < 16; ++r) sp[(size_t)((r & 3) + 8 * (r >> 2) + 4 * hi) * 128 + 32 * nt] = acc[r];
          } }
    }
    __syncthreads();
}
__device__ __forceinline__ void ssd_scan(Frame& F) {
    unsigned char* ws = ARGWS();
    const float* states = (const float*)(ws + WS_ST); const float* cdec = (const float*)(ws + WS_CDEC); unsigned* stb = (unsigned*)((unsigned char*)ARGOUT() + 32 * MiB);
    const int gt = F.vcu * (NWAVES * 64) + F.tid;
    if (gt < BATCH * 8 * 4096) {
        const int b = gt >> 15, h = (gt >> 12) & 7, e = gt & 4095;
        typedef float f32x2 __attribute__((ext_vector_type(2)));
        f32x2 v[32]; float dc[32];
#pragma unroll
        for (int c = 0; c < 32; ++c) { v[c] = *(const f32x2*)(states + ((size_t)((b * 32 + c) * 8 + h)) * 8192 + 2 * e); dc[c] = cdec[(size_t)(b * 32 + c) * 8 + h]; }
        f32x2 run = {0.f, 0.f};
#pragma unroll
        for (int c = 0; c < 32; ++c) { const f32x2 t = v[c]; stb[((size_t)((b * 32 + c) * 8 + h)) * 4096 + e] = pk2(run.x, run.y); run = run * dc[c] + t; }
    }
}
__device__ __forceinline__ void ssd_out(Frame& F, int l) {
    unsigned char* ws = ARGWS();
    const bf16* proj = (const bf16*)(ws + WS_PROJ); const float* dt = (const float*)(ws + WS_DT); const bf16* stb = (const bf16*)((unsigned char*)ARGOUT() + 32 * MiB); bf16* y = (bf16*)(ws + WS_Y);
    const float* cw = ARGF(7) + (size_t)l * 4 * 1024; const float* cb = ARGF(8) + (size_t)l * 1024; const float* alog = ARGF(10) + l * 8;
    const float* dsk = ARGF(11) + l * 8; const float* nw = ARGF(12) + (size_t)l * 512;
    const int lane = F.lane, w = F.wave, tid = F.tid, hi = lane >> 5, r32 = lane & 31;
    LAS float* acs = (LAS float*)(F.lds + RING_OFF);
    LAS float* dts = acs + 512;
    LAS float* rss = dts + 512;
    LAS unsigned* CBT = (LAS unsigned*)(F.lds + RING_OFF + 8192);
    LAS unsigned char* Ct = F.lds + RING_OFF + 8192 + 20480;
    LAS unsigned char* Bt = Ct + 128 * ssd::RS_ROW;
    LAS unsigned char* Xh = Bt;
    static_assert(8192 + 20480 + 128 * ssd::RS_ROW + 128 * ssd::RS_XTR <= RING_BYTES, "stage Z LDS map");
    const int wq = w & 3, pt = w >> 2;
    for (int u = F.vcu; u < BATCH * 32 * 2; u += F.G) {
        const int b = u >> 6, c = (u >> 1) & 31, g = u & 1, rowg0 = b * SEQ + c * 128;
        v4u rawbc[11], rawx[11];
        ssd::conv_load(rawbc, proj, rowg0, c == 0, (tid & 255) >> 4, 512 + (tid >> 8) * 256 + g * 128 + 8 * (tid & 15));
        ssd::conv_load(rawx, proj, rowg0, c == 0, tid >> 5, g * 256 + 8 * (tid & 31));
        float dta = 0.f, dtb = 0.f, Ah = 0.f;
        if (w < 4) { dta = dt[(size_t)(rowg0 + lane) * 8 + 4 * g + w]; dtb = dt[(size_t)(rowg0 + 64 + lane) * 8 + 4 * g + w]; Ah = alog[4 * g + w]; }
        __syncthreads();
        if (tid < 128) rss[tid] = 0.f;
        if (w < 4) { const float A = -__expf(Ah); (void)ssd::chunk_acs(dta, dtb, A, acs + 128 * w, dts + 128 * w, lane); }
        { const int rb = (tid & 255) >> 4, ch = tid & 15, which = tid >> 8, c0 = 512 + which * 256 + g * 128 + 8 * ch;
          ssd::conv_compute(rawbc, cw, cb, rb, c0, (which ? Ct : Bt) + 16 * ch, ssd::RS_ROW, nullptr); }
        __syncthreads();
#pragma unroll 1
        for (int id = w; id < 10; id += NWAVES) {
            const int tl = (id >= 6) ? 3 : (id >= 3) ? 2 : (id >= 1) ? 1 : 0, ts = id - ((tl * (tl + 1)) >> 1);
            ssd::f32x16 t16;
#pragma unroll
            for (int r = 0; r < 16; ++r) t16[r] = 0.f;
#pragma unroll
            for (int k0 = 0; k0 < 8; ++k0) { const bf16x8 bfr = *(const LAS bf16x8*)(Bt + (32 * ts + r32) * ssd::RS_ROW + (16 * k0 + 8 * hi) * 2);
                const bf16x8 cfr = *(const LAS bf16x8*)(Ct + (32 * tl + r32) * ssd::RS_ROW + (16 * k0 + 8 * hi) * 2);
                t16 = SSD_MFMA(bfr, cfr, t16); }
#pragma unroll
            for (int q = 0; q < 8; ++q) CBT[(id * 8 + q) * 64 + lane] = att::cvtpk(t16[2 * q], t16[2 * q + 1]);
        }
        __syncthreads();
        { const int rb = tid >> 5, ch = tid & 31; ssd::conv_compute(rawx, cw, cb, rb, g * 256 + 8 * ch, Xh + 16 * ch, ssd::RS_XTR, nullptr); }
        __syncthreads();
        unsigned dmask = 0u;
#pragma unroll
        for (int r = 0; r < 16; ++r) dmask |= ((((r & 3) + 8 * (r >> 2) + 4 * hi) <= r32) ? 1u : 0u) << r;
        asm volatile("" : "+v"(dmask));
        bf16x8 sfr[8];
#pragma unroll
        for (int k0 = 0; k0 < 8; ++k0) sfr[k0] = *(const bf16x8*)(stb + ((size_t)((b * 32 + c) * 8 + 4 * g)) * 8192 + (size_t)(32 * pt + r32) * 128 + 8 * hi + 16 * k0);
        ssd::f32x16 yg0, yg1, yg2, yg3;
#pragma unroll
        for (int hl = 0; hl < 4; ++hl) {
            const int hh = 4 * g + hl, lt = (wq + hl) & 3, lrow = 32 * lt + r32;
            bf16x8 cf[8];
#pragma unroll
            for (int k0 = 0; k0 < 8; ++k0) cf[k0] = *(const LAS bf16x8*)(Ct + lrow * ssd::RS_ROW + (16 * k0 + 8 * hi) * 2);
            ssd::f32x16 acc;
#pragma unroll
            for (int r = 0; r < 16; ++r) acc[r] = 0.f;
#pragma unroll
            for (int k0 = 0; k0 < 8; ++k0) acc = SSD_MFMA(sfr[k0], cf[k0], acc);
            if (hl < 3) {
#pragma unroll
                for (int k0 = 0; k0 < 8; ++k0) sfr[k0] = *(const bf16x8*)(stb + ((size_t)((b * 32 + c) * 8 + hh + 1)) * 8192 + (size_t)(32 * pt + r32) * 128 + 8 * hi + 16 * k0); }
            const float al = acs[128 * hl + lrow]; const float el = __expf(al);
#pragma unroll
            for (int r = 0; r < 16; ++r) acc[r] *= el;
            LAS unsigned char* xa = Xh + (4 * hi + ((lane & 15) >> 2)) * ssd::RS_XTR + (hl * 64 + 32 * pt + 16 * ((lane >> 4) & 1) + 4 * (lane & 3)) * 2;
            const int tid0 = (lt * (lt + 1)) >> 1;
#pragma unroll
            for (int st = 0; st < 4; ++st) { if (st <= lt) {
                float sc[16];
#pragma unroll
                for (int g4 = 0; g4 < 4; ++g4) { const int s0 = 32 * st + 8 * g4 + 4 * hi;
                    const f32x4 as = *(const LAS f32x4*)(acs + 128 * hl + s0), ds = *(const LAS f32x4*)(dts + 128 * hl + s0);
                    const unsigned c01 = CBT[((tid0 + st) * 8 + 2 * g4) * 64 + lane], c23 = CBT[((tid0 + st) * 8 + 2 * g4 + 1) * 64 + lane];
                    const float cv[4] = {blo(c01), bhi(c01), blo(c23), bhi(c23)};
#pragma unroll
                    for (int e = 0; e < 4; ++e) sc[4 * g4 + e] = cv[e] * __expf(fminf(al - as[e], 0.f)) * ds[e]; }
                if (st == lt) {
#pragma unroll
                    for (int r = 0; r < 16; ++r) sc[r] = ((dmask >> r) & 1u) ? sc[r] : 0.f; }
#pragma unroll
                for (int s2 = 0; s2 < 2; ++s2) { v4u pw; pw.x = att::cvtpk(sc[8 * s2], sc[8 * s2 + 1]); pw.y = att::cvtpk(sc[8 * s2 + 2], sc[8 * s2 + 3]); pw.z = att::cvtpk(sc[8 * s2 + 4], sc[8 * s2 + 5]); pw.w = att::cvtpk(sc[8 * s2 + 6], sc[8 * s2 + 7]);
                    const bf16x8 xf = ssd::trpair(xa + (32 * st + 16 * s2) * ssd::RS_XTR, 8 * ssd::RS_XTR);
                    acc = SSD_MFMA(xf, __builtin_bit_cast(bf16x8, pw), acc); } } }
            const float Dk = dsk[hh]; float ssq = 0.f; ssd::f32x16 yv16;
#pragma unroll
            for (int g4 = 0; g4 < 4; ++g4) { float yv[4]; const unsigned long long zz = *(const unsigned long long*)(proj + (size_t)(rowg0 + lrow) * NPROJ + OFF_Z + hh * 64 + 32 * pt + 4 * hi + 8 * g4);
                const unsigned long long xx = *(const LAS unsigned long long*)(Xh + lrow * ssd::RS_XTR + (hl * 64 + 32 * pt + 8 * g4 + 4 * hi) * 2);
                const float zf[4] = {blo((unsigned)zz), bhi((unsigned)zz), blo((unsigned)(zz >> 32)), bhi((unsigned)(zz >> 32))};
                const float xf[4] = {blo((unsigned)xx), bhi((unsigned)xx), blo((unsigned)(xx >> 32)), bhi((unsigned)(xx >> 32))};
#pragma unroll
                for (int e = 0; e < 4; ++e) { const float v = (acc[4 * g4 + e] + Dk * xf[e]) * (zf[e] * __builtin_amdgcn_rcpf(1.0f + __builtin_amdgcn_exp2f(-1.4426950408889634f * zf[e]))); yv[e] = v; ssq += v * v; yv16[4 * g4 + e] = v; } }
            if (hl == 0) yg0 = yv16; else if (hl == 1) yg1 = yv16; else if (hl == 2) yg2 = yv16; else yg3 = yv16;
            ssq += __shfl_xor(ssq, 32);
            if (hi == 0) (void)__hip_atomic_fetch_add(rss + lrow, ssq, __ATOMIC_RELAXED, __HIP_MEMORY_SCOPE_WORKGROUP);
        }
        __syncthreads();
#pragma unroll
        for (int hl = 0; hl < 4; ++hl) {
            const int lrow = 32 * ((wq + hl) & 3) + r32;
            const float rstd = 1.0f / sqrtf(rss[lrow] * (1.0f / 256.0f) + EPS);
            bf16* yr = y + (size_t)(rowg0 + lrow) * DM + 256 + g * 256 + hl * 64 + 32 * pt + 4 * hi;
            const float* nwp = nw + g * 256 + hl * 64 + 32 * pt + 4 * hi;
            const ssd::f32x16 yv = (hl == 0) ? yg0 : (hl == 1) ? yg1 : (hl == 2) ? yg2 : yg3;
#pragma unroll
            for (int g4 = 0; g4 < 4; ++g4) { const f32x4 wv = *(const f32x4*)(nwp + 8 * g4);
                *(unsigned long long*)(yr + 8 * g4) = (unsigned long long)att::cvtpk(yv[4 * g4] * rstd * wv.x, yv[4 * g4 + 1] * rstd * wv.y) | ((unsigned long long)att::cvtpk(yv[4 * g4 + 2] * rstd * wv.z, yv[4 * g4 + 3] * rstd * wv.w) << 32); } }
    }
    __syncthreads();
}

constexpr int PH_PER_LAYER = 7, N_PHASES = 1 + DEPTH * PH_PER_LAYER;
#define IN(k) (lo <= (k) && (k) < hi)
#define FRESH() do { asm volatile("" : "+s"(F.wave), "+s"(F.vcu), "+s"(F.G)); F.lane = lane_id(); asm volatile("" : "+v"(F.lane)); F.tid = F.wave * 64 + F.lane; bx = (int)blockIdx.x; asm volatile("" : "+s"(bx)); } while (0)
#define SEAM(k) do { if (IN(k) && IN((k) + 1)) { int w0_ = F.wave; asm volatile("" : "+s"(w0_)); xcd_barrier(bar, w0_ == 0 && lane_id() == 0); } } while (0)

template <int l> __device__ __forceinline__ void layer_phases(Frame& F, const int lo, const int hi, const XcdBarrier& bar) {
    int bx;
        const int pb = 1 + l * PH_PER_LAYER;
        if (IN(pb + 0)) { FRESH();
            if (l > 0) { dt_rows_b(F, (const bf16*)ARGOUT(), l); FRESH(); }
            unsigned char* ws = ARGWS(); unsigned char* wb = ws + WS_W + (size_t)l * W_LAYER;
            pg8::Gemm g{l == 0 ? (const bf16*)(ws + WS_XB) : (const bf16*)ARGOUT(), (const bf16*)(wb + W_IN), M, NPROJ, DM}; pg8::StaticOrder S; S.init(M, NPROJ, F.G, bx);
            pg8::EpiProj E{(bf16*)(ws + WS_PROJ), l == 0 ? (const float*)(ws + WS_RSTD) : (const float*)(ws + WS_SSQ2), ARGF(3) + l * 64, ARGF(4) + l * 64, ARGF(5) + l * 64, ARGF(6) + l * 64, (float*)(ws + WS_KMS) + (size_t)l * (BATCH * 16 * 4 * 64)};
            pg8::gemm_phase<pg8::EpiProj, pg8::StaticOrder, true, true>(F.lds + RING_OFF, g, S, E, F.wave);
        }
        SEAM(pb + 0);
        if (IN(pb + 1)) { FRESH(); ssd_states(F, l); FRESH(); mixA1_coop(F); FRESH(); moba_build(F, l); }
        SEAM(pb + 1);
        if (IN(pb + 2)) { FRESH(); ssd_scan(F); FRESH(); moba_lists(F, l); FRESH(); mixA23_mfma(F); }
        SEAM(pb + 2);
        if (IN(pb + 3)) { FRESH(); ssd_out(F, l); FRESH(); moba_own256_merge(F, l); }
        SEAM(pb + 3);
        if (IN(pb + 4)) { FRESH();
            unsigned char* ws = ARGWS(); unsigned char* wb = ws + WS_W + (size_t)l * W_LAYER; float* out = ARGOUT();
            pg8::Gemm g{(const bf16*)(ws + WS_Y), (const bf16*)(wb + W_OUT), M, DM, DM}; pg8::StaticOrder S; S.init(M, DM, F.G, bx);
            pg8::EpiRes1 E{l == 0 ? (const bf16*)(ws + WS_XB) : (const bf16*)out, (bf16*)(ws + WS_XB), (float*)(ws + WS_SSQ) + (size_t)l * M};
            pg8::gemm_phase<pg8::EpiRes1, pg8::StaticOrder, true, false>(F.lds + RING_OFF, g, S, E, F.wave);
        }
        SEAM(pb + 4);
        if (IN(pb + 5)) { FRESH();
            unsigned char* ws = ARGWS(); unsigned char* wb = ws + WS_W + (size_t)l * W_LAYER;
            pg8::Gemm g{(const bf16*)(ws + WS_XB), (const bf16*)(wb + W_1), M, FF, DM}; pg8::StaticOrder S; S.init(M, FF, F.G, bx);
            pg8::EpiRelu2 E{(bf16*)(ws + WS_H), (const float*)(ws + WS_SSQ) + (size_t)l * M};
            pg8::gemm_phase<pg8::EpiRelu2, pg8::StaticOrder, true, true>(F.lds + RING_OFF, g, S, E, F.wave);
        }
        SEAM(pb + 5);
        if (IN(pb + 6)) { FRESH();
            unsigned char* ws = ARGWS(); unsigned char* wb = ws + WS_W + (size_t)l * W_LAYER;
            pg8::Gemm g{(const bf16*)(ws + WS_H), (const bf16*)(wb + W_2), M, DM, FF}; pg8::StaticOrder S; S.init(M, DM, F.G, bx);
            pg8::EpiRes2 E{ARGOUT(), (const bf16*)(ws + WS_XB), (l + 1 < DEPTH) ? (bf16*)ARGOUT() : (bf16*)nullptr, (float*)(ws + WS_SSQ2)};
            pg8::gemm_phase<pg8::EpiRes2, pg8::StaticOrder, true, true>(F.lds + RING_OFF, g, S, E, F.wave);
        }
        SEAM(pb + 6);
}

struct Args { const float* in[17]; float* out; unsigned char* ws; int ph_lo, ph_hi; };
__global__ void __launch_bounds__(NWAVES * 64, 2) mk_fwd(Args args) {
    extern __shared__ __attribute__((aligned(16))) unsigned char lds[];
    Frame F;
    F.lds = (LAS unsigned char*)lds;
    F.MISC = (volatile LAS unsigned*)(F.lds + MISC_OFF);
    F.tid = threadIdx.x; F.lane = F.tid & 63; F.wave = __builtin_amdgcn_readfirstlane(F.tid >> 6);
    F.G = gridDim.x; { const int bx = blockIdx.x; F.vcu = (F.G % 8 == 0) ? (bx % 8) * (F.G / 8) + bx / 8 : bx; }
    for (int u = F.tid; u < (LDS_BYTES - LDSCTL_OFF) / 4; u += NWAVES * 64) ((LAS unsigned*)(F.lds + LDSCTL_OFF))[u] = 0u;
    __syncthreads();
    const int lo = args.ph_lo, hi = args.ph_hi;
    XcdBarrier bar; bar.bar = (unsigned*)(ARGWS() + WS_CTL) + CW_BAR; bar.x = 0; bar.st = nullptr;
    if (hi - lo > 1) bar = xcd_barrier_post((unsigned*)(ARGWS() + WS_CTL) + CW_BAR, F.MISC + 8);
    int bx;
    if (IN(0)) { FRESH(); p0_weights(F); __syncthreads(); pre_rows(F, ARGF(0), 0); }
    SEAM(0);
    layer_phases<0>(F, lo, hi, bar);
    layer_phases<1>(F, lo, hi, bar);
#undef IN
#undef SEAM
}

#ifndef MK_N_LAUNCHES
#define MK_N_LAUNCHES 1
#endif
extern "C" void kernel_launch(void* const* d_in, const int* in_sizes, int n_in, void* d_out, int out_size, void* d_ws, size_t ws_size, hipStream_t stream) {
    static int grid = 0;
    if (grid == 0) {
        if (n_in != 17 || in_sizes[0] != M * DM || out_size != M * DM || ws_size < WS_END) { fprintf(stderr, "kernel_launch: unexpected shapes (n_in %d, in0 %d, out %d, ws %zu)\n", n_in, n_in > 0 ? in_sizes[0] : -1, out_size, ws_size); grid = -1; return; }
        int dev = 0, cus = 0, per_cu = 0;
        if (hipGetDevice(&dev) != hipSuccess || hipDeviceGetAttribute(&cus, hipDeviceAttributeMultiprocessorCount, dev) != hipSuccess) { grid = -1; return; }
        if (hipFuncSetAttribute((const void*)mk_fwd, hipFuncAttributeMaxDynamicSharedMemorySize, LDS_BYTES) != hipSuccess) { fprintf(stderr, "kernel_launch: hipFuncSetAttribute failed\n"); grid = -1; return; }
        if (hipOccupancyMaxActiveBlocksPerMultiprocessor(&per_cu, (const void*)mk_fwd, NWAVES * 64, LDS_BYTES) != hipSuccess || per_cu < 1) { fprintf(stderr, "kernel_launch: occupancy query says %d blocks per CU\n", per_cu); }
        (void)hipGetLastError();
        if (cus < 256) { fprintf(stderr, "kernel_launch: built for 256 CUs, device has %d\n", cus); grid = -1; return; }
        grid = 256;
    }
    if (grid < 0) return;
    if (hipMemsetAsync((char*)d_ws + WS_CTL, 0, CTL_ZERO_BYTES, stream) != hipSuccess) { fprintf(stderr, "kernel_launch: memset failed\n"); return; }
    Args a{};
    for (int i = 0; i < 17; ++i) a.in[i] = (const float*)d_in[i];
    a.out = (float*)d_out; a.ws = (unsigned char*)d_ws;
    const int NL = MK_N_LAUNCHES;
    if (NL == 1) { a.ph_lo = 0; a.ph_hi = N_PHASES; hipLaunchKernelGGL(mk_fwd, dim3(grid), dim3(NWAVES * 64), LDS_BYTES, stream, a); }
    else { for (int p = 0; p < N_PHASES; ++p) { a.ph_lo = p; a.ph_hi = p + 1; hipLaunchKernelGGL(mk_fwd, dim3(grid), dim3(NWAVES * 64), LDS_BYTES, stream, a); } }
    const hipError_t le = hipPeekAtLastError();
    if (le != hipSuccess) fprintf(stderr, "kernel_launch: launch failed: %s\n", hipGetErrorName(le));
}
```

```cpp
#include <hip/hip_runtime.h>
#include <cstdio>
#include <cstdint>
#include <cmath>
__device__ __forceinline__ int lane_id() { return (int)__builtin_amdgcn_mbcnt_hi(~0u, __builtin_amdgcn_mbcnt_lo(~0u, 0u)); }
namespace pg8 {
#define PG8_LAS __attribute__((address_space(3)))
typedef unsigned short bf16_t;
typedef short bf16x8 __attribute__((ext_vector_type(8)));
typedef float f32x4 __attribute__((ext_vector_type(4)));
typedef unsigned u32x4 __attribute__((ext_vector_type(4)));
constexpr int BM = 256, BK = 64, HALF = 128, HTB = HALF * BK * 2  , STAGE_BYTES = 8 * HTB, NXCD = 8, WGM = 8;

__host__ __device__ __forceinline__ int lds_byte(int r, int c) { const int st = (r >> 4) * 2 + (c >> 5), rr = r & 15, cc = c & 31, ob = rr * 64 + cc * 2; return st * 1024 + (ob ^ (((ob >> 9) & 1) << 5)); }
__host__ __device__ __forceinline__ void stage_rc(int b, int& R, int& C) { const int st = b / 1024, sb = b % 1024, swz = sb ^ (((sb >> 9) & 1) << 5); R = (st >> 1) * 16 + swz / 64; C = (st & 1) * 32 + (swz % 64) / 2; }
__host__ __device__ __forceinline__ int perm32(int rho) { const int n = rho >> 4, i = rho & 15; return 8 * (i >> 2) + 4 * n + (i & 3); }

struct Unit { int pm, pn; };
struct Gemm { const bf16_t* A; const bf16_t* Bt; int M, N, K; };

struct StaticOrder {
    int nM, nN, nwg, G, c;
    __host__ __device__ void init(int M, int N, int G_, int c_) { nM = M / BM; nN = N / BM; nwg = nM * nN; G = G_; c = c_; }
    __host__ __device__ bool next(int i, Unit& u) const {
        const long L = (long)i * G + c; if (L >= nwg) return false;
        int wgid = (int)L; { const int q = nwg / NXCD, r = nwg % NXCD, xcd = wgid % NXCD, off = wgid / NXCD; wgid = (xcd < r ? xcd * (q + 1) : r * (q + 1) + (xcd - r) * q) + off; }
        const int nig = WGM * nN, gid = wgid / nig, fm = gid * WGM, gsz = (nM - fm) < WGM ? (nM - fm) : WGM;
        u.pm = fm + ((wgid % nig) % gsz); u.pn = ((wgid % nig) / gsz + (int)(L % NXCD)) % nN; return true;
    }
    __device__ __forceinline__ void a_ready(const Unit&) const {}
    __device__ __forceinline__ void done(const Unit&) const {}
};

__device__ __forceinline__ unsigned cvt_pk_bf16(float lo, float hi) { unsigned r; asm volatile("v_cvt_pk_bf16_f32 %0, %1, %2" : "=v"(r) : "v"(lo), "v"(hi)); return r; }
typedef float f32x2 __attribute__((ext_vector_type(2)));
typedef unsigned u32x2 __attribute__((ext_vector_type(2)));
struct EpiProj {
    static constexpr bool PERM = true, AFTER_DRAIN = false, ROWSCALE = true;
    __device__ __forceinline__ const float* rowsum() const { return rss; }
    bf16_t* P; const float* rss; const float *g0, *g1, *g2, *g3;
    float* kms;
    __device__ __forceinline__ void operator()(const f32x4 (&acc)[2][2][4][2], const Unit& u, int wr, int wc, int fr, int fq, const PG8_LAS float* rl) const {
        const int pn = u.pn; const int nsel = (pn == 0) ? 0 : (pn == 1) ? 1 : (pn == 3) ? 2 : (pn == 4) ? 3 : -1;
        const int row0 = u.pm * BM + wr * 64 + fr;
        const float* nw = (nsel == 0) ? g0 : (nsel == 1) ? g1 : (nsel == 2) ? g2 : g3;
        f32x4 g[2][2];
#pragma unroll
        for (int bj = 0; bj < 2; ++bj)
#pragma unroll
            for (int n = 0; n < 2; ++n) g[bj][n] = (nsel >= 0) ? *(const f32x4*)(nw + 32 * bj + 8 * fq + 4 * n) : (f32x4){1.f, 1.f, 1.f, 1.f};
        f32x4 cs[2][2];
#pragma unroll
        for (int bj = 0; bj < 2; ++bj)
#pragma unroll
            for (int n = 0; n < 2; ++n) cs[bj][n] = (f32x4){0.f, 0.f, 0.f, 0.f};
#pragma unroll
        for (int ai = 0; ai < 2; ++ai)
#pragma unroll
            for (int m = 0; m < 4; ++m) {
                const int row = row0 + ai * HALF + m * 16; const float r = rl[ai * HALF + wr * 64 + m * 16 + fr];
                f32x4 v[2][2]; float ss = 0.f;
#pragma unroll
                for (int bj = 0; bj < 2; ++bj)
#pragma unroll
                    for (int n = 0; n < 2; ++n) { v[bj][n] = acc[ai][bj][m][n] * r; const f32x4 x = v[bj][n]; ss += (x[0] * x[0] + x[1] * x[1]) + (x[2] * x[2] + x[3] * x[3]); }
                if (nsel >= 0) {
                    ss += __shfl_xor(ss, 16); ss += __shfl_xor(ss, 32);
                    const float hr = 1.0f / sqrtf(ss * (1.0f / 64.0f) + 1e-6f);
#pragma unroll
                    for (int bj = 0; bj < 2; ++bj)
#pragma unroll
                        for (int n = 0; n < 2; ++n) { v[bj][n] = v[bj][n] * hr * g[bj][n]; cs[bj][n] += v[bj][n]; }
                }
                bf16_t* rowp = P + (size_t)row * 3072 + pn * BM + wc * 64 + 8 * fq;
#pragma unroll
                for (int bj = 0; bj < 2; ++bj) { u32x4 w; w.x = cvt_pk_bf16(v[bj][0][0], v[bj][0][1]); w.y = cvt_pk_bf16(v[bj][0][2], v[bj][0][3]); w.z = cvt_pk_bf16(v[bj][1][0], v[bj][1][1]); w.w = cvt_pk_bf16(v[bj][1][2], v[bj][1][3]);
                    *(u32x4*)(rowp + 32 * bj) = w; }
            }
        if (nsel == 3) {
            float* dst = kms + ((size_t)(u.pm * 4 + wc)) * 64 + 8 * fq;
#pragma unroll
            for (int bj = 0; bj < 2; ++bj)
#pragma unroll
                for (int n = 0; n < 2; ++n)
#pragma unroll
                    for (int e = 0; e < 4; ++e) { float s = cs[bj][n][e]; s += __shfl_xor(s, 1); s += __shfl_xor(s, 2); s += __shfl_xor(s, 4); s += __shfl_xor(s, 8);
                        if (fr == 0) atomicAdd(dst + 32 * bj + 4 * n + e, s); }
        }
    }
};
struct EpiRes1 {
    static constexpr bool PERM = true, AFTER_DRAIN = false, ROWSCALE = false;
    const bf16_t* baseb; bf16_t* xb; float* ssq;
    __device__ __forceinline__ void operator()(const f32x4 (&acc)[2][2][4][2], const Unit& u, int wr, int wc, int fr, int fq, const PG8_LAS float* rl) const {
        const int col0 = u.pn * BM + wc * 32 + 8 * fq;
        u32x4 hb[2][4][2];
#pragma unroll
        for (int ai = 0; ai < 2; ++ai)
#pragma unroll
            for (int m = 0; m < 4; ++m) { const size_t off = (size_t)(u.pm * BM + ai * HALF + wr * 64 + m * 16 + fr) * 1024 + col0;
#pragma unroll
                for (int bj = 0; bj < 2; ++bj) hb[ai][m][bj] = *(const u32x4*)(baseb + off + bj * HALF); }
#pragma unroll
        for (int ai = 0; ai < 2; ++ai)
#pragma unroll
            for (int m = 0; m < 4; ++m) {
                const int row = u.pm * BM + ai * HALF + wr * 64 + m * 16 + fr; const size_t off = (size_t)row * 1024 + col0; float ss = 0.f;
#pragma unroll
                for (int bj = 0; bj < 2; ++bj) { const size_t o2 = off + bj * HALF;
                    const u32x4 h = hb[ai][m][bj];
                    f32x4 o0, o1;
                    o0[0] = __uint_as_float(h.x << 16); o0[1] = __uint_as_float(h.x & 0xffff0000u); o0[2] = __uint_as_float(h.y << 16); o0[3] = __uint_as_float(h.y & 0xffff0000u);
                    o1[0] = __uint_as_float(h.z << 16); o1[1] = __uint_as_float(h.z & 0xffff0000u); o1[2] = __uint_as_float(h.w << 16); o1[3] = __uint_as_float(h.w & 0xffff0000u);
                    o0 = o0 + acc[ai][bj][m][0]; o1 = o1 + acc[ai][bj][m][1];
                    u32x4 w; w.x = cvt_pk_bf16(o0[0], o0[1]); w.y = cvt_pk_bf16(o0[2], o0[3]); w.z = cvt_pk_bf16(o1[0], o1[1]); w.w = cvt_pk_bf16(o1[2], o1[3]); *(u32x4*)(xb + o2) = w;
                    { const f32x4 q0 = o0 * o0, q1 = o1 * o1, qs = q0 + q1; ss += (qs[0] + qs[1]) + (qs[2] + qs[3]); } }
                ss += __shfl_xor(ss, 16); ss += __shfl_xor(ss, 32);
                if (fq == 0) atomicAdd(ssq + row, ss);
            }
    }
};
struct EpiRelu2 {
    static constexpr bool PERM = true, AFTER_DRAIN = false, ROWSCALE = true;
    __device__ __forceinline__ const float* rowsum() const { return ssq; }
    bf16_t* H; const float* ssq;
    __device__ __forceinline__ void operator()(const f32x4 (&acc)[2][2][4][2], const Unit& u, int wr, int wc, int fr, int fq, const PG8_LAS float* rl) const {
        const int col0 = u.pn * BM + wc * 32 + 8 * fq;
#pragma unroll
        for (int ai = 0; ai < 2; ++ai)
#pragma unroll
            for (int m = 0; m < 4; ++m) {
                const int row = u.pm * BM + ai * HALF + wr * 64 + m * 16 + fr; const float r = rl[ai * HALF + wr * 64 + m * 16 + fr];
                bf16_t* rowp = H + (size_t)row * 4096 + col0;
                const float r2 = r * r;
#pragma unroll
                for (int bj = 0; bj < 2; ++bj) { const f32x4 z4 = {0.f, 0.f, 0.f, 0.f};
                    const f32x4 m0 = __builtin_elementwise_max(acc[ai][bj][m][0], z4), m1 = __builtin_elementwise_max(acc[ai][bj][m][1], z4);
                    const f32x4 v0 = (m0 * m0) * r2, v1 = (m1 * m1) * r2;
                    u32x4 w; w.x = cvt_pk_bf16(v0[0], v0[1]); w.y = cvt_pk_bf16(v0[2], v0[3]); w.z = cvt_pk_bf16(v1[0], v1[1]); w.w = cvt_pk_bf16(v1[2], v1[3]);
                    *(u32x4*)(rowp + bj * HALF) = w; }
            }
    }
};
struct EpiRes2 {
    static constexpr bool PERM = true, AFTER_DRAIN = false, ROWSCALE = false;
    float* out; const bf16_t* xhi; bf16_t* xnb; float* ssqn;
    __device__ __forceinline__ void operator()(const f32x4 (&acc)[2][2][4][2], const Unit& u, int wr, int wc, int fr, int fq, const PG8_LAS float* rl) const {
        const int col0 = u.pn * BM + wc * 32 + 8 * fq;
        u32x4 hb[2][4][2];
#pragma unroll
        for (int ai = 0; ai < 2; ++ai)
#pragma unroll
            for (int m = 0; m < 4; ++m) { const size_t off = (size_t)(u.pm * BM + ai * HALF + wr * 64 + m * 16 + fr) * 1024 + col0;
#pragma unroll
                for (int bj = 0; bj < 2; ++bj) hb[ai][m][bj] = *(const u32x4*)(xhi + off + bj * HALF); }
#pragma unroll
        for (int ai = 0; ai < 2; ++ai)
#pragma unroll
            for (int m = 0; m < 4; ++m) {
                const int row = u.pm * BM + ai * HALF + wr * 64 + m * 16 + fr; const size_t off = (size_t)row * 1024 + col0; float ss = 0.f;
#pragma unroll
                for (int bj = 0; bj < 2; ++bj) { const size_t o2 = off + bj * HALF;
                    const u32x4 h = hb[ai][m][bj];
                    f32x4 o0, o1;
                    o0[0] = __uint_as_float(h.x << 16); o0[1] = __uint_as_float(h.x & 0xffff0000u); o0[2] = __uint_as_float(h.y << 16); o0[3] = __uint_as_float(h.y & 0xffff0000u);
                    o1[0] = __uint_as_float(h.z << 16); o1[1] = __uint_as_float(h.z & 0xffff0000u); o1[2] = __uint_as_float(h.w << 16); o1[3] = __uint_as_float(h.w & 0xffff0000u);
                    o0 = o0 + acc[ai][bj][m][0]; o1 = o1 + acc[ai][bj][m][1];
                    if (xnb) { u32x4 w; w.x = cvt_pk_bf16(o0[0], o0[1]); w.y = cvt_pk_bf16(o0[2], o0[3]); w.z = cvt_pk_bf16(o1[0], o1[1]); w.w = cvt_pk_bf16(o1[2], o1[3]); *(u32x4*)(xnb + o2) = w;
                        { const f32x4 q0 = o0 * o0, q1 = o1 * o1, qs = q0 + q1; ss += (qs[0] + qs[1]) + (qs[2] + qs[3]); } }
                    else { *(f32x4*)(out + o2) = o0; *(f32x4*)(out + o2 + 4) = o1; } }
                if (xnb) { ss += __shfl_xor(ss, 16); ss += __shfl_xor(ss, 32); if (fq == 0) atomicAdd(ssqn + row, ss); }
            }
    }
};
template <class Epi, class Sched, bool ALIGN_EPI = false, bool SP2 = false>
__device__ __forceinline__ void gemm_phase(PG8_LAS unsigned char* lds, const Gemm g, const Sched& S, const Epi& E, const int wave_in) {
    int tid_ = wave_in * 64 + lane_id(); asm volatile("" : "+v"(tid_));
    const int tid = tid_, wid = __builtin_amdgcn_readfirstlane(tid >> 6), lane = tid & 63, wr = wid >> 2, wc = wid & 3, fr = lane & 15, fq = lane >> 4;
    const int K = g.K, nt = K / BK;
    unsigned voffA[2], voffB[2];
#pragma unroll
    for (int i = 0; i < 2; ++i) { int R, C; stage_rc(tid * 16 + i * 8192, R, C); const int Rb = Epi::PERM ? ((R & ~31) + perm32(R & 31)) : R;
        voffA[i] = (unsigned)(R * K + C) * 2u; voffB[i] = (unsigned)(Rb * K + C) * 2u; }
    const size_t kstep = (size_t)(BK * 2);
    const size_t hstep = (size_t)HALF * K * 2;
    const size_t tstep = 2 * hstep;
    const unsigned ldsw = (unsigned)wid * 1024u;
    const int aoff = lds_byte(wr * 64 + fr, fq * 8), boff = lds_byte(wc * 32 + fr, fq * 8);
#define PG8_SA(b, h) (((b) * 2 + (h)) * HTB)
#define PG8_SB(b, h) ((4 + (b) * 2 + (h)) * HTB)
#define PG8_STAGE(bufoff, gbase, voff) do { _Pragma("unroll") for (int _i = 0; _i < 2; ++_i) \
        __builtin_amdgcn_global_load_lds((const unsigned*)((const char*)(gbase) + (voff)[_i]), (PG8_LAS unsigned*)(lds + (bufoff) + ldsw + _i * 8192), 16, 0, 0); } while (0)
#define PG8_LDA(dst, b, h) do { _Pragma("unroll") for (int m = 0; m < 4; ++m) _Pragma("unroll") for (int k = 0; k < 2; ++k) dst[m][k] = *(const PG8_LAS bf16x8*)(lds + PG8_SA(b, h) + aoff + m * 2048 + k * 1024); } while (0)
#define PG8_LDB(dst, b, h) do { _Pragma("unroll") for (int n = 0; n < 2; ++n) _Pragma("unroll") for (int k = 0; k < 2; ++k) dst[n][k] = *(const PG8_LAS bf16x8*)(lds + PG8_SB(b, h) + boff + n * 2048 + k * 1024); } while (0)
#define PG8_MMA(ai, bj, At, Bt) do { __builtin_amdgcn_s_setprio(1); _Pragma("unroll") for (int m = 0; m < 4; ++m) _Pragma("unroll") for (int n = 0; n < 2; ++n) _Pragma("unroll") for (int k = 0; k < 2; ++k) \
        acc[ai][bj][m][n] = __builtin_amdgcn_mfma_f32_16x16x32_bf16(Bt[n][k], At[m][k], acc[ai][bj][m][n], 0, 0, 0); __builtin_amdgcn_s_setprio(0); } while (0)
#define PG8_WAIT_V(n) asm volatile("s_waitcnt vmcnt(" #n ")" ::: "memory")
#define PG8_WAIT_L(n) asm volatile("s_waitcnt lgkmcnt(" #n ")" ::: "memory")
#define PG8_BAR __builtin_amdgcn_s_barrier()
#define PG8_SCHED __builtin_amdgcn_sched_barrier(0)
    Unit cur, nxt; int ui = 0;
    if (!S.next(0, cur)) return;
    f32x4 acc[2][2][4][2];
#pragma unroll
    for (int a = 0; a < 2; ++a)
#pragma unroll
        for (int b = 0; b < 2; ++b)
#pragma unroll
            for (int m = 0; m < 4; ++m)
#pragma unroll
                for (int n = 0; n < 2; ++n) acc[a][b][m][n] = (f32x4){0.f, 0.f, 0.f, 0.f};
    bf16x8 At[4][2], B0[2][2], B1[2][2];
    const char* cA = (const char*)g.A + (size_t)cur.pm * tstep; const char* cB = (const char*)g.Bt + (size_t)cur.pn * tstep;
    S.a_ready(cur);
    PG8_LAS float* rbuf = (PG8_LAS float*)(lds + 8 * HTB); float rs_next = 0.f;
    if constexpr (Epi::ROWSCALE) { if (tid < BM) rs_next = E.rowsum()[cur.pm * BM + tid]; }
    if constexpr (SP2) {
        PG8_STAGE(PG8_SB(0, 0), cB, voffB); PG8_STAGE(PG8_SB(0, 1), cB + hstep, voffB); PG8_STAGE(PG8_SA(0, 0), cA, voffA); PG8_STAGE(PG8_SA(0, 1), cA + hstep, voffA);
        if (wr == 1) PG8_BAR;
        PG8_WAIT_V(2); PG8_BAR;
        PG8_STAGE(PG8_SB(1, 0), cB + kstep, voffB); PG8_STAGE(PG8_SA(1, 0), cA + kstep, voffA); PG8_STAGE(PG8_SB(1, 1), cB + hstep + kstep, voffB);
        PG8_WAIT_V(6); PG8_BAR;
        if constexpr (Epi::ROWSCALE) { if (tid < BM) rbuf[tid] = 1.0f / sqrtf(rs_next * (1.0f / 1024.0f) + 1e-6f); }
    } else {
        PG8_STAGE(PG8_SB(0, 0), cB, voffB); PG8_STAGE(PG8_SA(0, 0), cA, voffA); PG8_STAGE(PG8_SB(0, 1), cB + hstep, voffB); PG8_STAGE(PG8_SA(0, 1), cA + hstep, voffA);
        if (wr == 1) PG8_BAR;
        PG8_WAIT_V(4); PG8_BAR;
        PG8_STAGE(PG8_SB(1, 0), cB + kstep, voffB); PG8_STAGE(PG8_SA(1, 0), cA + kstep, voffA); PG8_STAGE(PG8_SB(1, 1), cB + hstep + kstep, voffB);
        PG8_WAIT_V(6); PG8_BAR;
        if constexpr (Epi::ROWSCALE) { if (tid < BM) rbuf[tid] = 1.0f / sqrtf(rs_next * (1.0f / 1024.0f) + 1e-6f); }
    }
    for (;;) {
        const bool has_next = S.next(ui + 1, nxt);
        const char* nA = has_next ? (const char*)g.A + (size_t)nxt.pm * tstep : cA; const char* nB = has_next ? (const char*)g.Bt + (size_t)nxt.pn * tstep : cB;
        for (int t = 0; t < nt; t += 2) {
            const bool last = (t == nt - 2);
            const char* a1 = cA + (size_t)(t + 1) * kstep;
            const char* a2 = last ? nA : cA + (size_t)(t + 2) * kstep; const char* b2 = last ? nB : cB + (size_t)(t + 2) * kstep;
            const char* a3 = a2 + kstep; const char* b3 = b2 + kstep;
            if (last && has_next) S.a_ready(nxt);
            if constexpr (SP2) {
            PG8_LDB(B0, 0, 0); PG8_LDB(B1, 0, 1); PG8_SCHED; PG8_LDA(At, 0, 0); PG8_STAGE(PG8_SA(1, 1), a1 + hstep, voffA);
            PG8_WAIT_V(8); PG8_WAIT_L(0); PG8_BAR; PG8_MMA(0, 0, At, B0); PG8_MMA(0, 1, At, B1); PG8_BAR; PG8_SCHED;
            PG8_LDA(At, 0, 1); PG8_STAGE(PG8_SB(0, 0), b2, voffB); PG8_STAGE(PG8_SB(0, 1), b2 + hstep, voffB); PG8_STAGE(PG8_SA(0, 0), a2, voffA);
            PG8_WAIT_V(8); PG8_WAIT_L(0); PG8_BAR; PG8_MMA(1, 0, At, B0); PG8_MMA(1, 1, At, B1); PG8_BAR; PG8_SCHED;
            PG8_LDB(B0, 1, 0); PG8_LDB(B1, 1, 1); PG8_SCHED; PG8_LDA(At, 1, 0); PG8_STAGE(PG8_SA(0, 1), a2 + hstep, voffA);
            PG8_WAIT_V(8); PG8_WAIT_L(0); PG8_BAR; PG8_MMA(0, 0, At, B0); PG8_MMA(0, 1, At, B1); PG8_BAR; PG8_SCHED;
            PG8_LDA(At, 1, 1); PG8_STAGE(PG8_SB(1, 0), b3, voffB); PG8_STAGE(PG8_SB(1, 1), b3 + hstep, voffB); PG8_STAGE(PG8_SA(1, 0), a3, voffA);
            PG8_WAIT_V(8); PG8_WAIT_L(0); PG8_BAR; PG8_MMA(1, 0, At, B0); PG8_MMA(1, 1, At, B1); PG8_BAR; PG8_SCHED;
            } else {
            PG8_LDB(B0, 0, 0); PG8_SCHED; PG8_LDA(At, 0, 0); PG8_STAGE(PG8_SA(1, 1), a1 + hstep, voffA);
            PG8_WAIT_L(8); PG8_BAR; PG8_WAIT_L(0); PG8_MMA(0, 0, At, B0); PG8_BAR; PG8_SCHED;
            PG8_LDB(B1, 0, 1); PG8_STAGE(PG8_SB(0, 0), b2, voffB);
            PG8_BAR; PG8_WAIT_L(0); PG8_MMA(0, 1, At, B1); PG8_BAR;
            PG8_LDA(At, 0, 1); PG8_STAGE(PG8_SA(0, 0), a2, voffA);
            PG8_BAR; PG8_WAIT_L(0); PG8_MMA(1, 0, At, B0); PG8_BAR; PG8_SCHED;
            PG8_STAGE(PG8_SB(0, 1), b2 + hstep, voffB);
            PG8_WAIT_V(6); PG8_BAR; PG8_MMA(1, 1, At, B1); PG8_BAR;
            PG8_LDB(B0, 1, 0); PG8_SCHED; PG8_LDA(At, 1, 0); PG8_STAGE(PG8_SA(0, 1), a2 + hstep, voffA);
            PG8_WAIT_L(8); PG8_BAR; PG8_WAIT_L(0); PG8_MMA(0, 0, At, B0); PG8_BAR; PG8_SCHED;
            PG8_LDB(B1, 1, 1); PG8_STAGE(PG8_SB(1, 0), b3, voffB);
            PG8_BAR; PG8_WAIT_L(0); PG8_MMA(0, 1, At, B1); PG8_BAR;
            PG8_LDA(At, 1, 1); PG8_STAGE(PG8_SA(1, 0), a3, voffA);
            PG8_BAR; PG8_WAIT_L(0); PG8_MMA(1, 0, At, B0); PG8_BAR; PG8_SCHED;
            PG8_STAGE(PG8_SB(1, 1), b3 + hstep, voffB);
            PG8_WAIT_V(6); PG8_BAR; PG8_MMA(1, 1, At, B1); PG8_BAR;
            }
        }
        if constexpr (Epi::ROWSCALE) { if (has_next && tid < BM) rs_next = E.rowsum()[nxt.pm * BM + tid]; }
        if constexpr (ALIGN_EPI) { if (wr == 0) PG8_BAR; }
        if constexpr (!Epi::AFTER_DRAIN) { E(acc, cur, wr, wc, fr, fq, rbuf + (ui & 1) * BM); S.done(cur); }
        if constexpr (Epi::ROWSCALE) { if (has_next && tid < BM) rbuf[((ui + 1) & 1) * BM + tid] = 1.0f / sqrtf(rs_next * (1.0f / 1024.0f) + 1e-6f); }
        if (!has_next) break;
#pragma unroll
        for (int a = 0; a < 2; ++a)
#pragma unroll
            for (int b = 0; b < 2; ++b)
#pragma unroll
                for (int m = 0; m < 4; ++m)
#pragma unroll
                    for (int n = 0; n < 2; ++n) acc[a][b][m][n] = (f32x4){0.f, 0.f, 0.f, 0.f};
        cur = nxt; cA = nA; cB = nB; ++ui;
        if constexpr (ALIGN_EPI) { if (wr == 1) PG8_BAR; }
    }
    PG8_WAIT_V(0);
    if constexpr (!ALIGN_EPI) { if (wr == 0) PG8_BAR; }
    PG8_BAR;
    if constexpr (Epi::AFTER_DRAIN) { E.fused(acc, cur, wr, wc, fr, fq, lds, wid, lane); S.done(cur); }
#undef PG8_SA
#undef PG8_SB
#undef PG8_STAGE
#undef PG8_LDA
#undef PG8_LDB
#undef PG8_MMA
#undef PG8_WAIT_V
#undef PG8_WAIT_L
#undef PG8_BAR
#undef PG8_SCHED
}
}
#define GAS __attribute__((address_space(1)))
#define LAS __attribute__((address_space(3)))
typedef unsigned short bf16;
typedef unsigned v4u __attribute__((ext_vector_type(4)));
typedef float f32x4 __attribute__((ext_vector_type(4)));
typedef short bf16x8 __attribute__((ext_vector_type(8)));
typedef GAS unsigned gu32;
typedef GAS unsigned long long gu64;
#define RLX_AGENT __ATOMIC_RELAXED, __HIP_MEMORY_SCOPE_AGENT
#define LDS_WAIT() asm volatile("s_waitcnt lgkmcnt(0)" ::: "memory")
#define VM_WAIT() asm volatile("s_waitcnt vmcnt(0)" ::: "memory")
__device__ __forceinline__ unsigned long long rt() { return __builtin_amdgcn_s_memrealtime(); }
__device__ __forceinline__ unsigned f2bf(float f) { unsigned u = __builtin_bit_cast(unsigned, f); return (u + 0x7fffu + ((u >> 16) & 1u)) >> 16; }
__device__ __forceinline__ unsigned pk2(float lo, float hi) { typedef float f2_t __attribute__((ext_vector_type(2))); typedef __bf16 b2_t __attribute__((ext_vector_type(2))); const f2_t v = {lo, hi}; return __builtin_bit_cast(unsigned, __builtin_convertvector(v, b2_t)); }
#define XB_TMO      128
#define XB_XCNT(j)  (256  + 64 * (j))
#define XB_XSUB(j)  (1280 + 64 * (j))
#define XB_XGEN(j)  (2304 + 64 * (j))
#define XB_TOP      3328
#define XB_TOPGEN   3392
#define XCD_BAR_WORDS 3456
#define XB_SPIN_CAP (1u << 18)

__device__ __forceinline__ unsigned xb_ld(unsigned* p)              { return __hip_atomic_load(p, __ATOMIC_RELAXED, __HIP_MEMORY_SCOPE_AGENT); }
__device__ __forceinline__ unsigned xb_add(unsigned* p, unsigned v) { return __hip_atomic_fetch_add(p, v, __ATOMIC_RELAXED, __HIP_MEMORY_SCOPE_AGENT); }
__device__ __forceinline__ unsigned xb_xcc_id() { return (unsigned)__builtin_amdgcn_s_getreg((3 << 11) | 20) & 0xFu; }
#define XB_SPIN(cond, bar) do { unsigned _sp = 0; while (cond) { __builtin_amdgcn_s_sleep(1); \
    if ((++_sp & 255u) == 0u) { if (xb_ld(&(bar)[XB_TMO])) break; if (_sp > XB_SPIN_CAP) { atomicAdd(&(bar)[XB_TMO], 1u); break; } } } } while (0)

struct XcdBarrier {
    unsigned* bar; unsigned x;
    volatile LAS unsigned* st;
};

__device__ __forceinline__ XcdBarrier xcd_barrier_post(unsigned* bar, volatile LAS unsigned* st) {
    XcdBarrier b; b.bar = bar; b.x = xb_xcc_id(); b.st = st;
    if (threadIdx.x == 0) (void)xb_add(&bar[XB_XCNT(b.x)], 1u);
    return b;
}
__device__ __forceinline__ void xcd_barrier_complete(unsigned* bar, unsigned x, unsigned& nloc, unsigned& nx) {
    const unsigned G = gridDim.x * gridDim.y * gridDim.z;
    unsigned sum, cnt, mine, sp = 0u;
    for (;;) {
        sum = 0u; cnt = 0u; mine = 0u;
#pragma unroll
        for (unsigned j = 0; j < 16; ++j) { const unsigned c = xb_ld(&bar[XB_XCNT(j)]); sum += c; cnt += (c > 0u) ? 1u : 0u; mine = (j == x) ? c : mine; }
        if (sum == G) break;
        __builtin_amdgcn_s_sleep(1);
        if ((++sp & 255u) == 0u) { if (xb_ld(&bar[XB_TMO])) break; if (sp > XB_SPIN_CAP) { atomicAdd(&bar[XB_TMO], 1u); break; } }
    }
    nloc = mine > 0u ? mine : 1u; nx = cnt > 0u ? cnt : 1u;
}

__device__ __forceinline__ void xcd_barrier(const XcdBarrier& b, const bool leader  ) {
    asm volatile("s_waitcnt vmcnt(0)" ::: "memory");
    __syncthreads();
    unsigned zoff_ = 0u; asm volatile("s_mov_b32 %0, 0" : "=s"(zoff_)); unsigned* bar_ = b.bar + zoff_; const unsigned bx_ = b.x + zoff_;
    if (leader) {
        unsigned* bar = bar_;
        __builtin_amdgcn_s_waitcnt(0);
        unsigned nloc = b.st[0], nx = b.st[1];
        if (nloc == 0u) { xcd_barrier_complete(bar, bx_, nloc, nx); b.st[0] = nloc; b.st[1] = nx; }
        const unsigned old = xb_add(&bar[XB_XSUB(bx_)], 1u);
        const unsigned gen = old / nloc;
        if (old + 1u == (gen + 1u) * nloc) {
            __builtin_amdgcn_fence(__ATOMIC_RELEASE, "agent");
            asm volatile("s_waitcnt vmcnt(0)" ::: "memory");
            const unsigned og = xb_add(&bar[XB_TOP], 1u);
            const unsigned tg = og / nx;
            if (og + 1u == (tg + 1u) * nx) xb_add(&bar[XB_TOPGEN], 1u);
            else XB_SPIN(xb_ld(&bar[XB_TOPGEN]) == tg, bar);
            __builtin_amdgcn_fence(__ATOMIC_ACQUIRE, "agent");
            asm volatile("s_waitcnt vmcnt(0)" ::: "memory");
        } else {
            XB_SPIN(xb_ld(&bar[XB_TOPGEN]) == gen, bar);
            __builtin_amdgcn_fence(__ATOMIC_ACQUIRE, "agent");
            asm volatile("s_waitcnt vmcnt(0)" ::: "memory");
        }
    }
    __syncthreads();
}
constexpr int NWAVES = 8;
constexpr int BATCH = 4, SEQ = 4096, DM = 1024, M = BATCH * SEQ, DIN = 3080, NPROJ = 3072, FF = 4096, DEPTH = 2;
constexpr int OFF_QA = 0, OFF_KA = 256, OFF_VA = 512, OFF_QC = 768, OFF_KC = 1024, OFF_VC = 1280, OFF_Z = 1536, OFF_XBC = 2048;
constexpr float EPS = 1e-6f;
constexpr size_t MiB = 1u << 20;
constexpr size_t WS_CTL = 0, CTL_ZERO_BYTES = 1 * MiB;
constexpr size_t WS_KMS = 512 * 1024;
constexpr size_t WS_SSQ2 = 384 * 1024;
constexpr size_t WS_SSQ = 256 * 1024;
constexpr size_t WS_W = 2 * MiB, W_LAYER = 24 * MiB, W_IN = 0, W_OUT = 6 * MiB, W_1 = 8 * MiB, W_2 = 16 * MiB;
constexpr size_t WS_RSTD = 50 * MiB, WS_DT = 51 * MiB, WS_KMEAN = 52 * MiB;
constexpr size_t WS_PROJ = 56 * MiB, WS_Y = 152 * MiB, WS_H = 56 * MiB, WS_XB = 184 * MiB, WS_ST = 216 * MiB, WS_END = 256 * MiB;
static_assert(WS_PROJ + (size_t)M * NPROJ * 2 <= WS_Y && WS_Y + (size_t)M * DM * 2 <= WS_XB && WS_H + (size_t)M * FF * 2 <= WS_XB && WS_XB + (size_t)M * DM * 2 <= WS_ST && WS_ST + 32 * MiB <= WS_END, "d_ws map");
constexpr int CW_BAR = 4096;
constexpr int RING_OFF = 0, RING_BYTES = 143360;
constexpr int LDSCTL_OFF = RING_BYTES, MISC_OFF = LDSCTL_OFF + 320;
constexpr int LDS_BYTES = 147456;

struct Frame {
    LAS unsigned char* lds; volatile LAS unsigned* MISC;
    int tid, lane, wave, vcu, G;
};
typedef const __attribute__((address_space(4))) unsigned char* kptr_t;
__device__ __forceinline__ kptr_t kargs() { kptr_t p = (kptr_t)__builtin_amdgcn_kernarg_segment_ptr(); asm volatile("" : "+s"(p)); return p; }
#define ARGF(i) (*(const float* const __attribute__((address_space(4)))*)(kargs() + 8 * (i)))
#define ARGOUT() (*(float* const __attribute__((address_space(4)))*)(kargs() + 8 * 17))
#define ARGWS() (*(unsigned char* const __attribute__((address_space(4)))*)(kargs() + 8 * 18))
__device__ __forceinline__ float wave_sum(float v) {
#pragma unroll
    for (int o = 1; o < 64; o <<= 1) v += __shfl_xor(v, o);
    return v;
}
__device__ __forceinline__ float wave_max(float v) {
#pragma unroll
    for (int o = 1; o < 64; o <<= 1) v = fmaxf(v, __shfl_xor(v, o));
    return v;
}
__device__ __forceinline__ float blo(unsigned w) { return __uint_as_float(w << 16); }
__device__ __forceinline__ float bhi(unsigned w) { return __uint_as_float(w & 0xffff0000u); }
__device__ __forceinline__ float bf2f(bf16 u) { return __uint_as_float((unsigned)u << 16); }

__device__ __forceinline__ void p0_transpose_item(const float* W, int ldw, int K, int nblk, bf16* WT, LAS float* scr, int item, int lane, const float* kscale, bool perm) {
    const int kb = item / nblk, nb = item % nblk, k0 = 64 * kb, n0 = 32 * nb;
#pragma unroll
    for (int i = 0; i < 8; ++i) { const int kk = 8 * i + (lane >> 3), c4 = 4 * (lane & 7); f32x4 v = __builtin_nontemporal_load((const f32x4*)(W + (size_t)(k0 + kk) * ldw + n0 + c4));
        if (kscale) v = v * kscale[k0 + kk]; LAS float* d = scr + kk * 33 + c4; d[0] = v.x; d[1] = v.y; d[2] = v.z; d[3] = v.w; }
    LDS_WAIT(); asm volatile("" ::: "memory");
    const int c = lane & 7;
#pragma unroll
    for (int j = 0; j < 4; ++j) { const int n = (lane >> 3) + 8 * j; const LAS float* s = scr + (8 * c) * 33 + n;
        v4u o; o.x = pk2(s[0 * 33], s[1 * 33]); o.y = pk2(s[2 * 33], s[3 * 33]); o.z = pk2(s[4 * 33], s[5 * 33]); o.w = pk2(s[6 * 33], s[7 * 33]);
        int cc = n0 + n; if (perm) { const int cl = cc & 255; cc = (cc & ~255) + 128 * ((cl >> 5) & 1) + 32 * (cl >> 6) + (cl & 31); }
        *(GAS v4u*)(WT + (size_t)cc * K + k0 + 8 * c) = o; }
    LDS_WAIT(); asm volatile("" ::: "memory");
}
__device__ __forceinline__ void p0_weights(Frame& F) {
    LAS float* scr = (LAS float*)(F.lds + RING_OFF + F.wave * 16384);
    const int gw = F.vcu * NWAVES + F.wave, NGW = F.G * NWAVES;
    constexpr int I_IN = (DM / 64) * (NPROJ / 32), I_O = (DM / 64) * (DM / 32), I_1 = (DM / 64) * (FF / 32), I_2 = (FF / 64) * (DM / 32);
    constexpr int PER_L = I_IN + I_O + I_1 + I_2;
    for (int it = gw; it < DEPTH * PER_L; it += NGW) {
        const int l = it / PER_L; int r = it % PER_L;
        unsigned char* wb = ARGWS() + WS_W + (size_t)l * W_LAYER;
        if (r < I_IN) { p0_transpose_item(ARGF(2) + (size_t)l * DM * DIN, DIN, DM, NPROJ / 32, (bf16*)(wb + W_IN), scr, r, F.lane, ARGF(1) + l * DM, true); continue; } r -= I_IN;
        if (r < I_O) { p0_transpose_item(ARGF(13) + (size_t)l * DM * DM, DM, DM, DM / 32, (bf16*)(wb + W_OUT), scr, r, F.lane, nullptr, false); continue; } r -= I_O;
        if (r < I_1) { p0_transpose_item(ARGF(15) + (size_t)l * DM * FF, FF, DM, FF / 32, (bf16*)(wb + W_1), scr, r, F.lane, ARGF(14) + l * DM, false); continue; } r -= I_1;
        p0_transpose_item(ARGF(16) + (size_t)l * FF * DM, DM, FF, DM / 32, (bf16*)(wb + W_2), scr, r, F.lane, nullptr, false);
    }
}
__device__ __forceinline__ void pre_rows(Frame& F, const float* xs, int l) {
    LAS float* wdt = (LAS float*)(F.lds + RING_OFF);
    const float* win = ARGF(2) + (size_t)l * DM * DIN; const float* nw = ARGF(1) + l * DM;
#pragma unroll
    for (int m = 0; m < 2; ++m) { const int k = F.tid + 512 * m; const float g = nw[k];
        const f32x4 a = *(const f32x4*)(win + (size_t)k * DIN + NPROJ), b = *(const f32x4*)(win + (size_t)k * DIN + NPROJ + 4);
        wdt[0 * DM + k] = g * a.x; wdt[1 * DM + k] = g * a.y; wdt[2 * DM + k] = g * a.z; wdt[3 * DM + k] = g * a.w; wdt[4 * DM + k] = g * b.x; wdt[5 * DM + k] = g * b.y; wdt[6 * DM + k] = g * b.z; wdt[7 * DM + k] = g * b.w; }
    __syncthreads();
    const int gw = F.vcu * NWAVES + F.wave, NGW = F.G * NWAVES;
    bf16* xb = (bf16*)(ARGWS() + WS_XB); float* rstd1 = (float*)(ARGWS() + WS_RSTD); float* dt = (float*)(ARGWS() + WS_DT);
    const float bias = (F.lane < 8) ? ARGF(9)[l * 8 + F.lane] : 0.f;
    for (int row0 = gw; row0 < M; row0 += 2 * NGW) {
        f32x4 v[2][4]; float ss[2] = {0.f, 0.f};
#pragma unroll
        for (int q = 0; q < 2; ++q) { const f32x4* xr = (const f32x4*)(xs + (size_t)(row0 + q * NGW) * DM) + F.lane;
#pragma unroll
            for (int j = 0; j < 4; ++j) v[q][j] = __builtin_nontemporal_load(xr + 64 * j); }
#pragma unroll
        for (int q = 0; q < 2; ++q) {
            const int row = row0 + q * NGW;
#pragma unroll
            for (int j = 0; j < 4; ++j) ss[q] += (v[q][j].x * v[q][j].x + v[q][j].y * v[q][j].y) + (v[q][j].z * v[q][j].z + v[q][j].w * v[q][j].w);
            const float ssw = wave_sum(ss[q]); const float rstd = 1.0f / sqrtf(ssw * (1.0f / DM) + EPS);
            unsigned long long* o8 = (unsigned long long*)(xb + (size_t)row * DM) + F.lane;
#pragma unroll
            for (int j = 0; j < 4; ++j) o8[64 * j] = (unsigned long long)pk2(v[q][j].x, v[q][j].y) | ((unsigned long long)pk2(v[q][j].z, v[q][j].w) << 32);
            float mine = 0.f;
#pragma unroll
            for (int jj = 0; jj < 8; ++jj) { float d = 0.f;
#pragma unroll
                for (int j = 0; j < 4; ++j) { const f32x4 w = *(const LAS f32x4*)(wdt + jj * DM + 256 * j + 4 * F.lane); d += (v[q][j].x * w.x + v[q][j].y * w.y) + (v[q][j].z * w.z + v[q][j].w * w.w); }
                d = wave_sum(d); if (F.lane == jj) mine = d; }
            if (F.lane < 8) { const float r = mine * rstd + bias; dt[(size_t)row * 8 + F.lane] = fmaxf(r, 0.f) + log1pf(expf(-fabsf(r))); }
            if (F.lane == 0) rstd1[row] = ssw;
        }
    }
    __syncthreads();
}

constexpr int DTW_RS = 2064;
__device__ __forceinline__ void dt_rows_b(Frame& F, const bf16* xs, int l) {
    LAS unsigned char* wdt = F.lds + RING_OFF;
    LAS float* part = (LAS float*)(F.lds + RING_OFF + 16 * DTW_RS);
    static_assert(M == 64 * 256, "dt_rows_b: 64 rows per workgroup on 256 workgroups");
    const int lane = F.lane, w = F.wave, r = lane & 15, q = lane >> 4, t = w >> 1, kh = w & 1;
    const int row0 = F.vcu * 64 + 16 * t;
    const float* win = ARGF(2) + (size_t)l * DM * DIN; const float* nw = ARGF(1) + l * DM;
    float wg[2]; f32x4 wu0[2], wu1[2];
#pragma unroll
    for (int m = 0; m < 2; ++m) { const int kk = F.tid + 512 * m; wg[m] = nw[kk]; wu0[m] = *(const f32x4*)(win + (size_t)kk * DIN + NPROJ); wu1[m] = *(const f32x4*)(win + (size_t)kk * DIN + NPROJ + 4); }
    bf16x8 a[8][2];
    { const bf16* xr = xs + (size_t)(row0 + r) * DM + 512 * kh + 16 * q;
#pragma unroll
      for (int s = 0; s < 8; ++s) { a[s][0] = *(const bf16x8*)(xr + 64 * s); a[s][1] = *(const bf16x8*)(xr + 64 * s + 8); } }
#pragma unroll
    for (int m = 0; m < 2; ++m) { const int kk = F.tid + 512 * m; const float g = wg[m];
        const f32x4 u0 = wu0[m], u1 = wu1[m];
        const float v[8] = {g * u0.x, g * u0.y, g * u0.z, g * u0.w, g * u1.x, g * u1.y, g * u1.z, g * u1.w};
#pragma unroll
        for (int jj = 0; jj < 8; ++jj) { const unsigned h = f2bf(v[jj]); const unsigned lo = f2bf(v[jj] - __uint_as_float(h << 16));
            *(LAS unsigned short*)(wdt + jj * DTW_RS + 2 * kk) = (unsigned short)h; *(LAS unsigned short*)(wdt + (8 + jj) * DTW_RS + 2 * kk) = (unsigned short)lo; } }
    const float* ssq = (const float*)(ARGWS() + WS_SSQ2); float* dt = (float*)(ARGWS() + WS_DT);
    float ssr[4];
#pragma unroll
    for (int e = 0; e < 4; ++e) ssr[e] = ssq[row0 + 4 * q + e];
    const float bias = ARGF(9)[l * 8 + (r & 7)];
    __syncthreads();
    f32x4 acc = {0.f, 0.f, 0.f, 0.f};
    { LAS unsigned char* wb = wdt + r * DTW_RS + (512 * kh + 16 * q) * 2;
#pragma unroll
      for (int s = 0; s < 8; ++s)
#pragma unroll
          for (int h = 0; h < 2; ++h) acc = __builtin_amdgcn_mfma_f32_16x16x32_bf16(a[s][h], *(const LAS bf16x8*)(wb + (64 * s + 8 * h) * 2), acc, 0, 0, 0); }
    if (kh == 1) {
#pragma unroll
        for (int e = 0; e < 4; ++e) part[(t * 4 + e) * 64 + lane] = acc[e]; }
    __syncthreads();
    if (kh == 0) {
#pragma unroll
        for (int e = 0; e < 4; ++e) { float d = acc[e] + part[(t * 4 + e) * 64 + lane]; d += __shfl_xor(d, 8);
            const float rstd = 1.0f / sqrtf(ssr[e] * (1.0f / DM) + EPS); const float rr = d * rstd + bias;
            if (r < 8) dt[(size_t)(row0 + 4 * q + e) * 8 + r] = fmaxf(rr, 0.f) + log1pf(expf(-fabsf(rr))); } }
    __syncthreads();
}
namespace att {
typedef float f32x16 __attribute__((ext_vector_type(16)));
typedef short v4i16_t __attribute__((ext_vector_type(4)));
typedef __bf16 bf16x2_t __attribute__((ext_vector_type(2)));
typedef float f32x2_t __attribute__((ext_vector_type(2)));
constexpr float C2 = 0.125f * 1.4426950408889634f;
constexpr int VROW = 192, VT_BYTES = 64 * VROW;
constexpr int BIGD = 1 << 28;
#define ATT_MFMA(a, b, c) __builtin_amdgcn_mfma_f32_32x32x16_bf16((a), (b), (c), 0, 0, 0)
__device__ __forceinline__ unsigned cvtpk(float lo, float hi) { f32x2_t v = {lo, hi}; return __builtin_bit_cast(unsigned, __builtin_convertvector(v, bf16x2_t)); }
__device__ __forceinline__ int clampt(int t) { return t < 0 ? 0 : (t > SEQ - 1 ? SEQ - 1 : t); }
__device__ __forceinline__ float half_max(float v) { auto rr = __builtin_amdgcn_permlane32_swap(__float_as_uint(v), __float_as_uint(v), false, false); return fmaxf(__uint_as_float(rr[0]), __uint_as_float(rr[1])); }
__device__ __forceinline__ float half_sum(float v) { auto rr = __builtin_amdgcn_permlane32_swap(__float_as_uint(v), __float_as_uint(v), false, false); return __uint_as_float(rr[0]) + __uint_as_float(rr[1]); }
struct St { f32x16 o0, o1; float m, l; };
template <int D> __device__ __forceinline__ void bias_vecs(f32x16& b0, f32x16& b1, float ns) {
#pragma unroll
    for (int r = 0; r < 16; ++r) { const int e0 = (r & 3) + 8 * (r >> 2); b0[r] = ns * (float)(D * e0); b1[r] = ns * (float)(D * (e0 + 32)); }
}
template <int MODE, int D, int VR>
__device__ __forceinline__ void tile_core(St& st, f32x16& u0, f32x16& u1, float zoff, bool okl, int D0, int maxd, LAS unsigned char* vrd) {
    if (MODE == 1) {
#pragma unroll
        for (int r = 0; r < 16; ++r) { const int e0 = (r & 3) + 8 * (r >> 2);
            u0[r] = ((unsigned)(D0 - D * e0) <= (unsigned)maxd) ? u0[r] : -INFINITY; u1[r] = ((unsigned)(D0 - D * (e0 + 32)) <= (unsigned)maxd) ? u1[r] : -INFINITY; }
    }
    float tmax = fmaxf(u0[0], u1[0]);
#pragma unroll
    for (int r = 1; r < 16; ++r) tmax = fmaxf(tmax, fmaxf(u0[r], u1[r]));
    tmax = (MODE == 0 && !okl) ? -INFINITY : tmax + zoff;
    tmax = half_max(tmax);
    if (__any(tmax > st.m)) { const float mn = fmaxf(st.m, tmax), al = __builtin_amdgcn_exp2f(C2 * (st.m - mn));
#pragma unroll
        for (int r = 0; r < 16; ++r) { st.o0[r] *= al; st.o1[r] *= al; }
        st.l *= al; st.m = mn; }
    const float off = (MODE == 0 && !okl) ? -INFINITY : C2 * (zoff - st.m);
    float ps = 0.f;
#pragma unroll
    for (int r = 0; r < 16; ++r) { u0[r] = __builtin_amdgcn_exp2f(fmaf(u0[r], C2, off)); u1[r] = __builtin_amdgcn_exp2f(fmaf(u1[r], C2, off)); ps += u0[r] + u1[r]; }
    st.l += ps;
    __builtin_amdgcn_s_setprio(1);
#pragma unroll
    for (int sub = 0; sub < 2; ++sub)
#pragma unroll
        for (int s = 0; s < 2; ++s) {
            v4u pw;
            if (sub == 0) { pw.x = cvtpk(u0[8 * s], u0[8 * s + 1]); pw.y = cvtpk(u0[8 * s + 2], u0[8 * s + 3]); pw.z = cvtpk(u0[8 * s + 4], u0[8 * s + 5]); pw.w = cvtpk(u0[8 * s + 6], u0[8 * s + 7]); }
            else { pw.x = cvtpk(u1[8 * s], u1[8 * s + 1]); pw.y = cvtpk(u1[8 * s + 2], u1[8 * s + 3]); pw.z = cvtpk(u1[8 * s + 4], u1[8 * s + 5]); pw.w = cvtpk(u1[8 * s + 6], u1[8 * s + 7]); }
            const bf16x8 pb = __builtin_bit_cast(bf16x8, pw);
#pragma unroll
            for (int dblk = 0; dblk < 2; ++dblk) {
                const v4i16_t lo = __builtin_amdgcn_ds_read_tr16_b64_v4i16((LAS v4i16_t*)(vrd + (32 * sub + 16 * s) * VR + 64 * dblk));
                const v4i16_t hh = __builtin_amdgcn_ds_read_tr16_b64_v4i16((LAS v4i16_t*)(vrd + (32 * sub + 16 * s + 8) * VR + 64 * dblk));
                const bf16x8 va = __builtin_shufflevector(lo, hh, 0, 1, 2, 3, 4, 5, 6, 7);
                if (dblk == 0) st.o0 = ATT_MFMA(va, pb, st.o0); else st.o1 = ATT_MFMA(va, pb, st.o1);
            }
        }
    __builtin_amdgcn_s_setprio(0);
}
template <int D>
__device__ __forceinline__ void run(St& st, const bf16x8 (&qf)[4], const unsigned char* Kb, const unsigned char* Vb, int tkb, int ntiles,
                                    int tq, int maxd, float ns, LAS unsigned char* vl, int lane) {
    const int r32 = lane & 31, hi = lane >> 5;
    LAS unsigned char* vrd = vl + (4 * hi + ((lane & 15) >> 2)) * VROW + (((lane >> 4) & 1) * 16 + (lane & 3) * 4) * 2;
    LAS unsigned char* vwr = vl + (lane >> 3) * VROW + 16 * (lane & 7);
    f32x16 b0, b1; bias_vecs<D>(b0, b1, ns);
    bf16x8 kf[2][4]; v4u vr[8];
#define ATT_LOADK(t) do { _Pragma("unroll") for (int sub = 0; sub < 2; ++sub) { const unsigned o_ = (unsigned)clampt(tkb + D * (64 * (t) + 32 * sub + r32)) * (unsigned)(NPROJ * 2) + 16u * hi; \
        _Pragma("unroll") for (int d0 = 0; d0 < 4; ++d0) kf[sub][d0] = *(const bf16x8*)(Kb + o_ + 32 * d0); } } while (0)
#define ATT_LOADV(t) do { _Pragma("unroll") for (int i2 = 0; i2 < 8; ++i2) { const unsigned o_ = (unsigned)clampt(tkb + D * (64 * (t) + (lane >> 3) + 8 * i2)) * (unsigned)(NPROJ * 2) + 16u * (lane & 7); \
        vr[i2] = *(const v4u*)(Vb + o_); } } while (0)
    ATT_LOADK(ntiles - 1); ATT_LOADV(ntiles - 1);
    for (int t = ntiles - 1; t >= 0; --t) {
#pragma unroll
        for (int i2 = 0; i2 < 8; ++i2) *(LAS v4u*)(vwr + 8 * i2 * VROW) = vr[i2];
        const int tn = (t > 0) ? t - 1 : 0;
        ATT_LOADV(tn);
        f32x16 s0 = b0, s1 = b1;
#pragma unroll
        for (int d0 = 0; d0 < 4; ++d0) { s0 = ATT_MFMA(kf[0][d0], qf[d0], s0); s1 = ATT_MFMA(kf[1][d0], qf[d0], s1); }
        ATT_LOADK(tn);
        const int tk0 = tkb + D * (64 * t + 4 * hi);
        tile_core<1, D, VROW>(st, s0, s1, ns * (float)tk0, true, tq - tk0, maxd, vrd);
    }
#undef ATT_LOADK
#undef ATT_LOADV
}
__device__ __forceinline__ void st_init(St& st) {
#pragma unroll
    for (int r = 0; r < 16; ++r) { st.o0[r] = 0.f; st.o1[r] = 0.f; }
    st.m = -1e30f; st.l = 0.f;
}
__device__ __forceinline__ void load_q(bf16x8 (&qf)[4], const bf16* qrow, int hi) {
#pragma unroll
    for (int d0 = 0; d0 < 4; ++d0) qf[d0] = *(const bf16x8*)(qrow + 16 * d0 + 8 * hi);
}
__device__ __forceinline__ void st_store(St& st, bf16* yrow, int hi) {
    const float lt = half_sum(st.l), inv = 1.0f / lt;
#pragma unroll
    for (int g = 0; g < 4; ++g) {
        unsigned long long w0 = (unsigned long long)cvtpk(st.o0[4 * g] * inv, st.o0[4 * g + 1] * inv) | ((unsigned long long)cvtpk(st.o0[4 * g + 2] * inv, st.o0[4 * g + 3] * inv) << 32);
        unsigned long long w1 = (unsigned long long)cvtpk(st.o1[4 * g] * inv, st.o1[4 * g + 1] * inv) | ((unsigned long long)cvtpk(st.o1[4 * g + 2] * inv, st.o1[4 * g + 3] * inv) << 32);
        *(unsigned long long*)(yrow + 8 * g + 4 * hi) = w0; *(unsigned long long*)(yrow + 32 + 8 * g + 4 * hi) = w1; }
}
__device__ __forceinline__ unsigned moba_select(const bf16x8 (&qf)[4], const float* kms, int b, int h, int blk, int r32, int hi, unsigned& picks) {
    f32x16 gt;
#pragma unroll
    for (int r = 0; r < 16; ++r) gt[r] = 0.f;
    { const float* kp = kms + ((size_t)((b * 16 + (r32 & 15)) * 4 + h)) * 64 + 8 * hi;
#pragma unroll
      for (int d0 = 0; d0 < 4; ++d0) { const f32x4 a = *(const f32x4*)(kp + 16 * d0) * (1.0f / 256.0f), c = *(const f32x4*)(kp + 16 * d0 + 4) * (1.0f / 256.0f);
          v4u hw, lw; hw.x = cvtpk(a.x, a.y); hw.y = cvtpk(a.z, a.w); hw.z = cvtpk(c.x, c.y); hw.w = cvtpk(c.z, c.w);
          lw.x = cvtpk(a.x - blo(hw.x), a.y - bhi(hw.x)); lw.y = cvtpk(a.z - blo(hw.y), a.w - bhi(hw.y)); lw.z = cvtpk(c.x - blo(hw.z), c.y - bhi(hw.z)); lw.w = cvtpk(c.z - blo(hw.w), c.w - bhi(hw.w));
          gt = ATT_MFMA(__builtin_bit_cast(bf16x8, hw), qf[d0], gt); gt = ATT_MFMA(__builtin_bit_cast(bf16x8, lw), qf[d0], gt); } }
    float og[8];
#pragma unroll
    for (int r = 0; r < 8; ++r) og[r] = __shfl_xor(gt[r], 32);
    float G[16];
#pragma unroll
    for (int n = 0; n < 16; ++n) { const int rn = (n & 3) + 4 * (n >> 3); G[n] = (((n >> 2) & 1) == hi) ? gt[rn] : og[rn]; }
    unsigned selmask = 0u; picks = 0xfffu;
#pragma unroll
    for (int s = 0; s < 3; ++s) { float bv = -INFINITY; int best = -1;
#pragma unroll
        for (int n = 0; n < 16; ++n) { if (n < blk && !((selmask >> n) & 1u) && G[n] > bv) { bv = G[n]; best = n; } }
        if (best >= 0) { selmask |= 1u << best; picks = (picks & ~(15u << (4 * s))) | ((unsigned)best << (4 * s)); } }
    return selmask;
}
}

constexpr size_t WS_PAO = 248 * MiB, WS_PAM = 54 * MiB, WS_PAL = 54 * MiB + 256 * 1024;
namespace attc {
constexpr int KROW = 144, VROWC = 192;
constexpr int KT_BYTES = 128 * KROW, VT_BYTES_C = 128 * VROWC, STAGE = KT_BYTES + VT_BYTES_C;
}
__device__ __forceinline__ void mixA1_coop(Frame& F) {
    using namespace att;
    unsigned char* ws = ARGWS();
    const bf16* proj = (const bf16*)(ws + WS_PROJ); bf16* pao = (bf16*)(ws + WS_PAO); float* pam = (float*)(ws + WS_PAM); float* pal = (float*)(ws + WS_PAL);
    const int lane = F.lane, r32 = lane & 31, hi = lane >> 5, w = F.wave, tid = F.tid;
    LAS unsigned char* L0 = F.lds + RING_OFF;
    const int bh = F.vcu >> 4, qb = F.vcu & 15, b = bh >> 2, h = bh & 3, rowb = b * SEQ, t0 = 256 * qb, tq = t0 + 32 * w + r32;
    const float ns = 8.0f * exp2f(-(float)(2 * h + 1));
    const bf16* Kg = proj + (size_t)rowb * NPROJ + OFF_KA + h * 64; const bf16* Vg = proj + (size_t)rowb * NPROJ + OFF_VA + h * 64;
    const int lrow0 = tid >> 3, lch = tid & 7;
    const int koff = lrow0 * attc::KROW + 16 * lch, voff = attc::KT_BYTES + lrow0 * attc::VROWC + 16 * lch;
    const int kfo = r32 * attc::KROW + 16 * hi;
    const int vfo = attc::KT_BYTES + (4 * hi + ((lane & 15) >> 2)) * attc::VROWC + (((lane >> 4) & 1) * 16 + (lane & 3) * 4) * 2;
    f32x16 b0, b1; bias_vecs<1>(b0, b1, ns);
    bf16x8 qf[4]; load_q(qf, proj + (size_t)(rowb + tq) * NPROJ + OFF_QA + h * 64, hi);
    St st; st_init(st);
    const int s_lo = (qb == 0) ? 1 : 0;
    v4u kr[2], vr[2];
#define MA_LOAD(s) do { _Pragma("unroll") for (int j = 0; j < 2; ++j) { const size_t o_ = (size_t)(t0 - 128 + 128 * (s) + 64 * j + lrow0) * NPROJ + 8 * lch; kr[j] = *(const v4u*)(Kg + o_); vr[j] = *(const v4u*)(Vg + o_); } } while (0)
#define MA_STORE(buf) do { LAS unsigned char* sb_ = L0 + (buf) * attc::STAGE; _Pragma("unroll") for (int j = 0; j < 2; ++j) { *(LAS v4u*)(sb_ + koff + 64 * j * attc::KROW) = kr[j]; *(LAS v4u*)(sb_ + voff + 64 * j * attc::VROWC) = vr[j]; } } while (0)
    __syncthreads();
    MA_LOAD(2); MA_STORE(0); MA_LOAD(1);
#pragma unroll 1
    for (int i = 0; i < 3 - s_lo; ++i) {
        const int s = 2 - i;
        __syncthreads();
        if (s - 1 >= s_lo) { MA_STORE((i + 1) & 1); if (s - 2 >= s_lo) MA_LOAD(s - 2); }
        LAS unsigned char* sb = L0 + (i & 1) * attc::STAGE;
#pragma unroll
        for (int u = 1; u >= 0; --u) {
            const int ta = t0 - 128 + 128 * s + 64 * u;
            if (ta <= t0 + 32 * w + 31 && ta + 63 >= t0 + 32 * w - 128) {
                bf16x8 kf[2][4];
#pragma unroll
                for (int sub = 0; sub < 2; ++sub)
#pragma unroll
                    for (int d0 = 0; d0 < 4; ++d0) kf[sub][d0] = *(const LAS bf16x8*)(sb + kfo + (64 * u + 32 * sub) * attc::KROW + 32 * d0);
                f32x16 s0 = b0, s1 = b1;
#pragma unroll
                for (int d0 = 0; d0 < 4; ++d0) { s0 = ATT_MFMA(kf[0][d0], qf[d0], s0); s1 = ATT_MFMA(kf[1][d0], qf[d0], s1); }
                const int tk0 = ta + 4 * hi;
                tile_core<1, 1, attc::VROWC>(st, s0, s1, ns * (float)tk0, true, tq - tk0, tq < 128 ? tq : 128, sb + vfo + 64 * u * attc::VROWC);
            }
        }
    }
#undef MA_LOAD
#undef MA_STORE
    const float lt = half_sum(st.l), inv = 1.0f / lt;
    bf16* orow = pao + ((size_t)(rowb + tq) * 4 + h) * 64;
#pragma unroll
    for (int g = 0; g < 4; ++g) {
        unsigned long long w0 = (unsigned long long)cvtpk(st.o0[4 * g] * inv, st.o0[4 * g + 1] * inv) | ((unsigned long long)cvtpk(st.o0[4 * g + 2] * inv, st.o0[4 * g + 3] * inv) << 32);
        unsigned long long w1 = (unsigned long long)cvtpk(st.o1[4 * g] * inv, st.o1[4 * g + 1] * inv) | ((unsigned long long)cvtpk(st.o1[4 * g + 2] * inv, st.o1[4 * g + 3] * inv) << 32);
        *(unsigned long long*)(orow + 8 * g + 4 * hi) = w0; *(unsigned long long*)(orow + 32 + 8 * g + 4 * hi) = w1; }
    if (hi == 0) { pam[(size_t)(rowb + tq) * 4 + h] = st.m; pal[(size_t)(rowb + tq) * 4 + h] = lt; }
    __syncthreads();
}
__device__ __forceinline__ void mixA23_mfma(Frame& F) {
    unsigned char* ws = ARGWS();
    const bf16* proj = (const bf16*)(ws + WS_PROJ); bf16* y = (bf16*)(ws + WS_Y);
    const bf16* pao = (const bf16*)(ws + WS_PAO); const float* pam = (const float*)(ws + WS_PAM); const float* pal = (const float*)(ws + WS_PAL);
    const int lane = F.lane, r32 = lane & 31, hi = lane >> 5, w = F.wave;
    LAS unsigned char* vl = F.lds + RING_OFF + w * att::VT_BYTES;
    const int gw = F.vcu * NWAVES + w;
    const int bh = gw >> 7, r16 = (gw >> 3) & 15, ig = gw & 7;
    const int b = bh >> 2, h = bh & 3, rowb = b * SEQ, tq0 = r16 + 512 * ig, tq = tq0 + 16 * r32;
    bf16x8 qf[4]; att::load_q(qf, proj + (size_t)(rowb + tq) * NPROJ + OFF_QA + h * 64, hi);
    att::St st; att::st_init(st);
    const float ns = 8.0f * exp2f(-(float)(2 * h + 1));
    const unsigned char* Kb = (const unsigned char*)(proj + (size_t)rowb * NPROJ + OFF_KA + h * 64); const unsigned char* Vb = (const unsigned char*)(proj + (size_t)rowb * NPROJ + OFF_VA + h * 64);
    att::run<4>(st, qf, Kb, Vb, tq0 - 512, 4, tq, tq < 512 ? tq : 512, ns, vl, lane);
    att::run<16>(st, qf, Kb, Vb, tq0 - 2048, 3, tq, tq < 2048 ? tq : 2048, ns, vl, lane);
    const size_t pidx = (size_t)(rowb + tq) * 4 + h;
    const float m1 = pam[pidx], l1 = pal[pidx], l2 = att::half_sum(st.l), mm = fmaxf(st.m, m1);
    const float a2 = __builtin_amdgcn_exp2f(att::C2 * (st.m - mm)), a1 = __builtin_amdgcn_exp2f(att::C2 * (m1 - mm)) * l1;
    const float inv = 1.0f / (l2 * a2 + a1);
    const bf16* orow = pao + pidx * 64; bf16* yrow = y + (size_t)(rowb + tq) * DM + h * 64;
    unsigned long long pp0[4], pp1[4];
#pragma unroll
    for (int g = 0; g < 4; ++g) { pp0[g] = *(const unsigned long long*)(orow + 8 * g + 4 * hi); pp1[g] = *(const unsigned long long*)(orow + 32 + 8 * g + 4 * hi); }
#pragma unroll
    for (int g = 0; g < 4; ++g) {
        const unsigned long long p0 = pp0[g], p1 = pp1[g];
        const float q0[4] = {blo((unsigned)p0), bhi((unsigned)p0), blo((unsigned)(p0 >> 32)), bhi((unsigned)(p0 >> 32))};
        const float q1[4] = {blo((unsigned)p1), bhi((unsigned)p1), blo((unsigned)(p1 >> 32)), bhi((unsigned)(p1 >> 32))};
        float r0[4], r1[4];
#pragma unroll
        for (int e = 0; e < 4; ++e) { r0[e] = (st.o0[4 * g + e] * a2 + q0[e] * a1) * inv; r1[e] = (st.o1[4 * g + e] * a2 + q1[e] * a1) * inv; }
        *(unsigned long long*)(yrow + 8 * g + 4 * hi) = (unsigned long long)att::cvtpk(r0[0], r0[1]) | ((unsigned long long)att::cvtpk(r0[2], r0[3]) << 32);
        *(unsigned long long*)(yrow + 32 + 8 * g + 4 * hi) = (unsigned long long)att::cvtpk(r1[0], r1[1]) | ((unsigned long long)att::cvtpk(r1[2], r1[3]) << 32); }
}
constexpr size_t WS_MCNT = 768 * 1024;
constexpr size_t WS_MLIST = 51 * MiB + 512 * 1024;
constexpr size_t WS_MPM = 52 * MiB + 512 * 1024, WS_MPL = 53 * MiB + 256 * 1024;
__device__ __forceinline__ int moba_list_base(int b, int h, int j) { return (b * 4 + h) * 30720 + 256 * (15 * j - ((j * (j - 1)) >> 1)); }
__device__ __forceinline__ void moba_build(Frame& F, int l) {
    using namespace att;
    unsigned char* ws = ARGWS();
    const bf16* proj = (const bf16*)(ws + WS_PROJ); const float* kms = (const float*)(ws + WS_KMS) + (size_t)l * (BATCH * 16 * 4 * 64);
    unsigned* cnt = (unsigned*)(ws + WS_MCNT) + l * 256; unsigned short* list = (unsigned short*)(ws + WS_MLIST);
    const int lane = F.lane, r32 = lane & 31, hi = lane >> 5, w = F.wave;
    const int bh = F.vcu >> 4, blk = F.vcu & 15, b = bh >> 2, h = bh & 3, rowb = b * SEQ, tq = 256 * blk + 32 * w + r32;
    if (blk == 0) return;
    bf16x8 qf[4]; load_q(qf, proj + (size_t)(rowb + tq) * NPROJ + OFF_QC + h * 64, hi);
    unsigned picks; (void)moba_select(qf, kms, b, h, blk, r32, hi, picks);
    const int p0 = picks & 15, p1 = (picks >> 4) & 15, p2 = (picks >> 8) & 15;
    unsigned cntv = 0u;
#pragma unroll 1
    for (int j = 0; j < blk; ++j) { const bool pr = (hi == 0) && (p0 == j || p1 == j || p2 == j); const unsigned long long bal = __ballot(pr); if (lane == j) cntv = (unsigned)__popcll(bal); }
    unsigned basev = 0u;
    if (lane < 15 && cntv > 0u) basev = atomicAdd(cnt + (b * 4 + h) * 16 + lane, cntv);
#pragma unroll 1
    for (int j = 0; j < blk; ++j) { {
        const bool pr = (hi == 0) && (p0 == j || p1 == j || p2 == j); const unsigned long long bal = __ballot(pr);
        if (bal) { const unsigned bj = (unsigned)__shfl((int)basev, j);
            if (pr) { const unsigned pos = bj + (unsigned)__popcll(bal & ((1ull << lane) - 1ull)); const unsigned slot = (p0 == j) ? 0u : (p1 == j) ? 1u : 2u;
                list[moba_list_base(b, h, j) + pos] = (unsigned short)((unsigned)tq | (slot << 12)); } } } }
}
__device__ __forceinline__ void moba_lists(Frame& F, int l) {
    using namespace att;
    unsigned char* ws = ARGWS();
    const bf16* proj = (const bf16*)(ws + WS_PROJ);
    const unsigned* cnt = (const unsigned*)(ws + WS_MCNT) + l * 256; const unsigned short* list = (const unsigned short*)(ws + WS_MLIST);
    unsigned char* PB = (l == 0) ? (unsigned char*)ARGOUT() : ws + WS_W;
    float* pm = (float*)(ws + WS_MPM); float* pl = (float*)(ws + WS_MPL);
    asm volatile("" : "+v"(pm), "+v"(pl), "+v"(PB));
    const int lane = F.lane, r32 = lane & 31, hi = lane >> 5, w = F.wave, tid = F.tid;
    LAS unsigned char* L0 = F.lds + RING_OFF;
    constexpr int KB_BYTES = 256 * attc::KROW, VB_BYTES = 256 * attc::VROWC;
    LAS unsigned* cin = (LAS unsigned*)(L0 + KB_BYTES + VB_BYTES); LAS unsigned* pre = cin + 256;
    __syncthreads();
    unsigned cmine = 0u, cinc = 0u;
    constexpr unsigned SEGW = 256u;
    if (tid < 256) { cmine = cnt[tid]; cmine = cmine ? cmine + SEGW : 0u; cinc = cmine;
#pragma unroll
        for (int o = 1; o < 64; o <<= 1) { const unsigned t_ = (unsigned)__shfl_up((int)cinc, o); if (lane >= o) cinc += t_; }
        if (lane == 63) cin[w] = cinc; }
    __syncthreads();
    if (tid < 256) { unsigned off = 0u;
#pragma unroll
        for (int i = 0; i < 3; ++i) if (i < w) off += cin[i];
        pre[tid] = off + cinc - cmine; if (tid == 255) pre[256] = off + cinc; }
    __syncthreads();
    const unsigned T = pre[256];
    const unsigned lo = (unsigned)(((unsigned long long)T * (unsigned)F.vcu) >> 8), hi_ = (unsigned)(((unsigned long long)T * (unsigned)(F.vcu + 1)) >> 8);
    LAS unsigned* lrng = pre + 260;
    if (tid == 0) { lrng[0] = 256u; lrng[1] = 0u; }
    __syncthreads();
    if (tid < 256) { const unsigned sL = pre[tid] + SEGW, eL = pre[tid + 1]; if (eL > sL && sL < hi_ && eL > lo) { atomicMin((unsigned*)lrng, (unsigned)tid); atomicMax((unsigned*)lrng + 1, (unsigned)tid); } }
    __syncthreads();
    const int Lfirst = (int)lrng[0], Llast = (int)lrng[1];
    const int kfo = r32 * attc::KROW + 16 * hi;
    const int vfo = KB_BYTES + (4 * hi + ((lane & 15) >> 2)) * attc::VROWC + (((lane >> 4) & 1) * 16 + (lane & 3) * 4) * 2;
#pragma unroll 1
    for (int L = Lfirst; L <= Llast; ++L) {
        const unsigned sL = pre[L] + SEGW, eL = pre[L + 1]; const unsigned a = lo > sL ? lo : sL, e = hi_ < eL ? hi_ : eL;
        if (a >= e) continue;
        const int bh = L >> 4, j = L & 15, b = bh >> 2, h = bh & 3, rowb = b * SEQ;
        const float ns = 8.0f * exp2f(-(float)(2 * h + 2));
        const int lb = moba_list_base(b, h, j) - (int)sL;
        const int nt = (int)((e - a + 31u) >> 5);
        unsigned ent_n = 0u;
        if (w < nt) { const unsigned idx0 = a + 32u * (unsigned)w + (unsigned)r32; ent_n = list[lb + (int)(idx0 < e ? idx0 : a)]; }
        __syncthreads();
        { const bf16* Kg = proj + (size_t)(rowb + 256 * j) * NPROJ + OFF_KC + h * 64; const bf16* Vg = proj + (size_t)(rowb + 256 * j) * NPROJ + OFF_VC + h * 64;
          v4u kr[4], vr[4];
#pragma unroll
          for (int i = 0; i < 4; ++i) { const int c = tid + 512 * i, row = c >> 3, ch = c & 7; kr[i] = *(const v4u*)(Kg + (size_t)row * NPROJ + 8 * ch); vr[i] = *(const v4u*)(Vg + (size_t)row * NPROJ + 8 * ch); }
#pragma unroll
          for (int i = 0; i < 4; ++i) { const int c = tid + 512 * i, row = c >> 3, ch = c & 7; *(LAS v4u*)(L0 + row * attc::KROW + 16 * ch) = kr[i]; *(LAS v4u*)(L0 + KB_BYTES + row * attc::VROWC + 16 * ch) = vr[i]; } }
        __syncthreads();
#pragma unroll 1
        for (int t = w; t < nt; t += NWAVES) {
            const unsigned idx = a + 32u * (unsigned)t + (unsigned)r32; const bool valid = idx < e;
            const unsigned ent = ent_n; const int tq = (int)(ent & 4095u); const unsigned slot = ent >> 12;
            bf16x8 qf[4]; load_q(qf, proj + (size_t)(rowb + tq) * NPROJ + OFF_QC + h * 64, hi);
            if (t + NWAVES < nt) { const unsigned idx1 = idx + 32u * NWAVES; ent_n = list[lb + (int)(idx1 < e ? idx1 : a)]; }
            St st; st_init(st);
#pragma unroll 1
            for (int kt = 3; kt >= 0; --kt) {
                bf16x8 kf[2][4];
#pragma unroll
                for (int sub = 0; sub < 2; ++sub)
#pragma unroll
                    for (int d0 = 0; d0 < 4; ++d0) kf[sub][d0] = *(const LAS bf16x8*)(L0 + kfo + (64 * kt + 32 * sub) * attc::KROW + 32 * d0);
                f32x16 s0, s1; bias_vecs<1>(s0, s1, ns);
#pragma unroll
                for (int d0 = 0; d0 < 4; ++d0) { s0 = ATT_MFMA(kf[0][d0], qf[d0], s0); s1 = ATT_MFMA(kf[1][d0], qf[d0], s1); }
                tile_core<0, 1, attc::VROWC>(st, s0, s1, ns * (float)(256 * j + 64 * kt + 4 * hi), valid, 0, 0, L0 + vfo + 64 * kt * attc::VROWC);
            }
            const float lt = half_sum(st.l), inv = 1.0f / lt;
            if (valid) {
                const size_t pidx = (size_t)(rowb + tq) * 4 + h;
                bf16* orow = (bf16*)(PB + (size_t)slot * (8 * MiB)) + pidx * 64;
#pragma unroll
                for (int g = 0; g < 4; ++g) {
                    unsigned long long w0 = (unsigned long long)cvtpk(st.o0[4 * g] * inv, st.o0[4 * g + 1] * inv) | ((unsigned long long)cvtpk(st.o0[4 * g + 2] * inv, st.o0[4 * g + 3] * inv) << 32);
                    unsigned long long w1 = (unsigned long long)cvtpk(st.o1[4 * g] * inv, st.o1[4 * g + 1] * inv) | ((unsigned long long)cvtpk(st.o1[4 * g + 2] * inv, st.o1[4 * g + 3] * inv) << 32);
                    *(unsigned long long*)(orow + 8 * g + 4 * hi) = w0; *(unsigned long long*)(orow + 32 + 8 * g + 4 * hi) = w1; }
                if (hi == 0) { pm[(size_t)slot * (M * 4) + pidx] = st.m; pl[(size_t)slot * (M * 4) + pidx] = lt; }
            }
        }
    }
    __syncthreads();
}
__device__ __forceinline__ void moba_own256_merge(Frame& F, int l) {
    using namespace att;
    unsigned char* ws = ARGWS();
    const bf16* proj = (const bf16*)(ws + WS_PROJ); bf16* y = (bf16*)(ws + WS_Y);
    const unsigned char* PB = (l == 0) ? (const unsigned char*)ARGOUT() : ws + WS_W;
    const float* pm = (const float*)(ws + WS_MPM); const float* pl = (const float*)(ws + WS_MPL);
    const int lane = F.lane, r32 = lane & 31, hi = lane >> 5, w = F.wave, tid = F.tid;
    LAS unsigned char* L0 = F.lds + RING_OFF;
    constexpr int KB_BYTES = 256 * attc::KROW;
    const int bh = F.vcu >> 4, blk = F.vcu & 15, b = bh >> 2, h = bh & 3, rowb = b * SEQ, tq = 256 * blk + 32 * w + r32;
    const float ns = 8.0f * exp2f(-(float)(2 * h + 2));
    const int kfo = r32 * attc::KROW + 16 * hi;
    const int vfo = KB_BYTES + (4 * hi + ((lane & 15) >> 2)) * attc::VROWC + (((lane >> 4) & 1) * 16 + (lane & 3) * 4) * 2;
    bf16x8 qf[4]; load_q(qf, proj + (size_t)(rowb + tq) * NPROJ + OFF_QC + h * 64, hi);
    __syncthreads();
    { const bf16* Kg = proj + (size_t)(rowb + 256 * blk) * NPROJ + OFF_KC + h * 64; const bf16* Vg = proj + (size_t)(rowb + 256 * blk) * NPROJ + OFF_VC + h * 64;
      v4u kr[4], vr[4];
#pragma unroll
      for (int i = 0; i < 4; ++i) { const int c = tid + 512 * i, row = c >> 3, ch = c & 7; kr[i] = *(const v4u*)(Kg + (size_t)row * NPROJ + 8 * ch); vr[i] = *(const v4u*)(Vg + (size_t)row * NPROJ + 8 * ch); }
#pragma unroll
      for (int i = 0; i < 4; ++i) { const int c = tid + 512 * i, row = c >> 3, ch = c & 7; *(LAS v4u*)(L0 + row * attc::KROW + 16 * ch) = kr[i]; *(LAS v4u*)(L0 + KB_BYTES + row * attc::VROWC + 16 * ch) = vr[i]; } }
    const size_t pidx = (size_t)(rowb + tq) * 4 + h; const int nsel = blk < 3 ? blk : 3;
    float mp[3], lp[3];
#pragma unroll
    for (int s = 0; s < 3; ++s) { mp[s] = -1e30f; lp[s] = 0.f; if (s < nsel) { mp[s] = pm[(size_t)s * (M * 4) + pidx]; lp[s] = pl[(size_t)s * (M * 4) + pidx]; } }
    __syncthreads();
    St st; st_init(st);
    const int ktl = w >> 1;
#pragma unroll 1
    for (int kt = ktl; kt >= 0; --kt) {
        bf16x8 kf[2][4];
#pragma unroll
        for (int sub = 0; sub < 2; ++sub)
#pragma unroll
            for (int d0 = 0; d0 < 4; ++d0) kf[sub][d0] = *(const LAS bf16x8*)(L0 + kfo + (64 * kt + 32 * sub) * attc::KROW + 32 * d0);
        f32x16 s0, s1; bias_vecs<1>(s0, s1, ns);
#pragma unroll
        for (int d0 = 0; d0 < 4; ++d0) { s0 = ATT_MFMA(kf[0][d0], qf[d0], s0); s1 = ATT_MFMA(kf[1][d0], qf[d0], s1); }
        const int tk0 = 256 * blk + 64 * kt + 4 * hi;
        if (kt == ktl) tile_core<1, 1, attc::VROWC>(st, s0, s1, ns * (float)tk0, true, tq - tk0, BIGD, L0 + vfo + 64 * kt * attc::VROWC);
        else tile_core<0, 1, attc::VROWC>(st, s0, s1, ns * (float)tk0, true, 0, 0, L0 + vfo + 64 * kt * attc::VROWC);
    }
    float mm = st.m;
#pragma unroll
    for (int s = 0; s < 3; ++s) mm = fmaxf(mm, mp[s]);
    const float a1 = __builtin_amdgcn_exp2f(C2 * (st.m - mm));
    float ap[3];
#pragma unroll
    for (int s = 0; s < 3; ++s) ap[s] = __builtin_amdgcn_exp2f(C2 * (mp[s] - mm)) * lp[s];
    const float inv = 1.0f / (half_sum(st.l) * a1 + ap[0] + ap[1] + ap[2]);
    bf16* yrow = y + (size_t)(rowb + tq) * DM + 768 + h * 64;
    unsigned long long pp0[3][4], pp1[3][4];
#pragma unroll
    for (int s = 0; s < 3; ++s)
#pragma unroll
        for (int g = 0; g < 4; ++g) { pp0[s][g] = 0ull; pp1[s][g] = 0ull;
            if (s < nsel) { const bf16* orow = (const bf16*)(PB + (size_t)s * (8 * MiB)) + pidx * 64; pp0[s][g] = *(const unsigned long long*)(orow + 8 * g + 4 * hi); pp1[s][g] = *(const unsigned long long*)(orow + 32 + 8 * g + 4 * hi); } }
#pragma unroll
    for (int g = 0; g < 4; ++g) {
        float r0[4], r1[4];
#pragma unroll
        for (int e = 0; e < 4; ++e) { r0[e] = st.o0[4 * g + e] * a1; r1[e] = st.o1[4 * g + e] * a1; }
#pragma unroll
        for (int s = 0; s < 3; ++s) { if (s < nsel) {
            const unsigned long long p0 = pp0[s][g], p1 = pp1[s][g];
            r0[0] += blo((unsigned)p0) * ap[s]; r0[1] += bhi((unsigned)p0) * ap[s]; r0[2] += blo((unsigned)(p0 >> 32)) * ap[s]; r0[3] += bhi((unsigned)(p0 >> 32)) * ap[s];
            r1[0] += blo((unsigned)p1) * ap[s]; r1[1] += bhi((unsigned)p1) * ap[s]; r1[2] += blo((unsigned)(p1 >> 32)) * ap[s]; r1[3] += bhi((unsigned)(p1 >> 32)) * ap[s]; } }
        *(unsigned long long*)(yrow + 8 * g + 4 * hi) = (unsigned long long)cvtpk(r0[0] * inv, r0[1] * inv) | ((unsigned long long)cvtpk(r0[2] * inv, r0[3] * inv) << 32);
        *(unsigned long long*)(yrow + 32 + 8 * g + 4 * hi) = (unsigned long long)cvtpk(r1[0] * inv, r1[1] * inv) | ((unsigned long long)cvtpk(r1[2] * inv, r1[3] * inv) << 32); }
    __syncthreads();
}

namespace ssd {
typedef float f32x16 __attribute__((ext_vector_type(16)));
typedef short v4i16_t __attribute__((ext_vector_type(4)));
constexpr int RS_BTR = 320, RS_XTR = 576;
constexpr int RS_ROW = 272;
constexpr int RS_XH = 192;
#define SSD_MFMA(a, b, c) __builtin_amdgcn_mfma_f32_32x32x16_bf16((a), (b), (c), 0, 0, 0)
__device__ __forceinline__ bf16x8 trpair(LAS unsigned char* p, int rs4  ) {
    const v4i16_t lo = __builtin_amdgcn_ds_read_tr16_b64_v4i16((LAS v4i16_t*)p);
    const v4i16_t hh = __builtin_amdgcn_ds_read_tr16_b64_v4i16((LAS v4i16_t*)(p + rs4));
    return __builtin_shufflevector(lo, hh, 0, 1, 2, 3, 4, 5, 6, 7);
}
__device__ __forceinline__ float chunk_acs(float d0, float d1  , float A, LAS float* acs, LAS float* dts, int lane) {
    float s0 = d0 * A, s1 = d1 * A;
#pragma unroll
    for (int o = 1; o < 64; o <<= 1) { const float t0 = __shfl_up(s0, o), t1 = __shfl_up(s1, o); if (lane >= o) { s0 += t0; s1 += t1; } }
    const float tot0 = __shfl(s0, 63); s1 += tot0;
    acs[lane] = s0; acs[64 + lane] = s1; dts[lane] = d0; dts[64 + lane] = d1;
    return __shfl(s1, 63);
}
__device__ __forceinline__ void conv_load(v4u (&raw)[11], const bf16* proj, int rowg0, bool first_chunk, int rb, int c0) {
#pragma unroll
    for (int j = 0; j < 11; ++j) { const int rr = 8 * rb - 3 + j;
        if (first_chunk && rr < 0) raw[j] = (v4u){0u, 0u, 0u, 0u}; else raw[j] = *(const v4u*)(proj + (size_t)(rowg0 + rr) * NPROJ + OFF_XBC + c0); }
}
__device__ __forceinline__ void conv_compute(const v4u (&raw)[11], const float* cw, const float* cb, int rb, int c0, LAS unsigned char* dst, int rs, const LAS float* rowscale) {
    float w[4][8], bs[8];
#pragma unroll
    for (int j = 0; j < 4; ++j) { const f32x4 a = *(const f32x4*)(cw + j * 1024 + c0), b = *(const f32x4*)(cw + j * 1024 + c0 + 4);
        w[j][0] = a.x; w[j][1] = a.y; w[j][2] = a.z; w[j][3] = a.w; w[j][4] = b.x; w[j][5] = b.y; w[j][6] = b.z; w[j][7] = b.w; }
    { const f32x4 a = *(const f32x4*)(cb + c0), b = *(const f32x4*)(cb + c0 + 4); bs[0] = a.x; bs[1] = a.y; bs[2] = a.z; bs[3] = a.w; bs[4] = b.x; bs[5] = b.y; bs[6] = b.z; bs[7] = b.w; }
#pragma unroll
    for (int r = 0; r < 8; ++r) {
        float o[8];
#pragma unroll
        for (int e = 0; e < 8; ++e) o[e] = bs[e];
#pragma unroll
        for (int j = 0; j < 4; ++j) { const v4u u = raw[r + j];
            o[0] += w[j][0] * blo(u.x); o[1] += w[j][1] * bhi(u.x); o[2] += w[j][2] * blo(u.y); o[3] += w[j][3] * bhi(u.y);
            o[4] += w[j][4] * blo(u.z); o[5] += w[j][5] * bhi(u.z); o[6] += w[j][6] * blo(u.w); o[7] += w[j][7] * bhi(u.w); }
        const float sc = rowscale ? rowscale[8 * rb + r] : 1.0f;
#pragma unroll
        for (int e = 0; e < 8; ++e) o[e] = o[e] * __builtin_amdgcn_rcpf(1.0f + __builtin_amdgcn_exp2f(-1.4426950408889634f * o[e])) * sc;
        v4u q; q.x = pk2(o[0], o[1]); q.y = pk2(o[2], o[3]); q.z = pk2(o[4], o[5]); q.w = pk2(o[6], o[7]);
        *(LAS v4u*)(dst + (8 * rb + r) * rs) = q;
    }
}
}
constexpr size_t WS_CDEC = 50 * MiB + 512 * 1024;

__device__ __forceinline__ void ssd_states(Frame& F, int l) {
    unsigned char* ws = ARGWS();
    const bf16* proj = (const bf16*)(ws + WS_PROJ); const float* dt = (const float*)(ws + WS_DT); float* states = (float*)(ws + WS_ST); float* cdec = (float*)(ws + WS_CDEC);
    const float* cw = ARGF(7) + (size_t)l * 4 * 1024; const float* cb = ARGF(8) + (size_t)l * 1024; const float* alog = ARGF(10) + l * 8;
    const int lane = F.lane, w = F.wave, tid = F.tid, hi = lane >> 5;
    LAS float* acs = (LAS float*)(F.lds + RING_OFF);
    LAS float* wl = acs + 512;
    LAS unsigned char* Bt = F.lds + RING_OFF + 4096;
    LAS unsigned char* Xt = Bt + 128 * ssd::RS_BTR;
    for (int u = F.vcu; u < BATCH * 32 * 2; u += F.G) {
        const int b = u >> 6, c = (u >> 1) & 31, g = u & 1, rowg0 = b * SEQ + c * 128;
        v4u rawx[11], rawb[11];
        ssd::conv_load(rawx, proj, rowg0, c == 0, tid >> 5, g * 256 + 8 * (tid & 31));
        if (tid < 256) ssd::conv_load(rawb, proj, rowg0, c == 0, tid >> 4, 512 + g * 128 + 8 * (tid & 15));
        float dta = 0.f, dtb = 0.f, Ah = 0.f;
        if (w < 4) { dta = dt[(size_t)(rowg0 + lane) * 8 + 4 * g + w]; dtb = dt[(size_t)(rowg0 + 64 + lane) * 8 + 4 * g + w]; Ah = alog[4 * g + w]; }
        __syncthreads();
        if (w < 4) { const int hh = 4 * g + w; const float A = -__expf(Ah);
            const float last = ssd::chunk_acs(dta, dtb, A, acs + 128 * w, wl + 128 * w, lane);
            const float a0 = acs[128 * w + lane], a1 = acs[128 * w + 64 + lane];
            wl[128 * w + lane] = wl[128 * w + lane] * __expf(last - a0); wl[128 * w + 64 + lane] = wl[128 * w + 64 + lane] * __expf(last - a1);
            if (lane == 0) cdec[(size_t)(b * 32 + c) * 8 + hh] = __expf(last); }
        __syncthreads();
        { const int rb = tid >> 5, ch = tid & 31, c0 = g * 256 + 8 * ch;
          ssd::conv_compute(rawx, cw, cb, rb, c0, Xt + 16 * ch, ssd::RS_XTR, wl + 128 * (ch >> 3)); }
        if (tid < 256) { const int rb = tid >> 4, ch = tid & 15, c0 = 512 + g * 128 + 8 * ch;
          ssd::conv_compute(rawb, cw, cb, rb, c0, Bt + 16 * ch, ssd::RS_BTR, nullptr); }
        __syncthreads();
        { const int hl = w >> 1, ph = w & 1, hh = 4 * g + hl;
          LAS unsigned char* xa = Xt + (8 * hi + ((lane & 15) >> 2)) * ssd::RS_XTR + (hl * 64 + 32 * ph + 16 * ((lane >> 4) & 1) + 4 * (lane & 3)) * 2;
          LAS unsigned char* ba = Bt + (8 * hi + ((lane & 15) >> 2)) * ssd::RS_BTR + (16 * ((lane >> 4) & 1) + 4 * (lane & 3)) * 2;
          unsigned* sp = (unsigned*)states + ((size_t)((b * 32 + c) * 8 + hh)) * 4096 + (size_t)(32 * ph) * 64 + ((lane & 31) >> 1);
#pragma unroll
          for (int nt = 0; nt < 4; ++nt) {
              ssd::f32x16 acc;
#pragma unroll
              for (int r = 0; r < 16; ++r) acc[r] = 0.f;
#pragma unroll
              for (int kk = 0; kk < 8; ++kk) {
                  const bf16x8 af = ssd::trpair(xa + 16 * kk * ssd::RS_XTR, 4 * ssd::RS_XTR);
                  const bf16x8 bfr = ssd::trpair(ba + 16 * kk * ssd::RS_BTR + 64 * nt, 4 * ssd::RS_BTR);
                  acc = SSD_MFMA(af, bfr, acc); }
#pragma unroll
              for (int r = 0; r < 16; r += 2) {
                  const bool odd = lane & 1; const int rr = odd ? r + 1 : r;
                  const float send = odd ? acc[r] : acc[r + 1];
                  const float recv = __shfl_xor(send, 1);
                  sp[(size_t)((rr & 3) + 8 * (rr >> 2) + 4 * hi) * 64 + 16 * nt] = odd ? pk2(recv, acc[r + 1]) : pk2(acc[r], recv); }
          } }
    }
    __syncthreads();
}
__device__ __forceinline__ void ssd_scan(Frame& F) {
    unsigned char* ws = ARGWS();
    const float* states = (const float*)(ws + WS_ST); const float* cdec = (const float*)(ws + WS_CDEC); unsigned* stb = (unsigned*)((unsigned char*)ARGOUT() + 32 * MiB);
    const int gt = F.vcu * (NWAVES * 64) + F.tid;
    if (gt < BATCH * 8 * 4096) {
        const int b = gt >> 15, h = (gt >> 12) & 7, e = gt & 4095;
        typedef float f32x2 __attribute__((ext_vector_type(2)));
        f32x2 v[32]; float dc[32];
#pragma unroll
        for (int c = 0; c < 32; ++c) { const unsigned raw = ((const unsigned*)states)[((size_t)((b * 32 + c) * 8 + h)) * 4096 + e]; v[c] = (f32x2){blo(raw), bhi(raw)}; dc[c] = cdec[(size_t)(b * 32 + c) * 8 + h]; }
        f32x2 run = {0.f, 0.f};
#pragma unroll
        for (int c = 0; c < 32; ++c) { const f32x2 t = v[c]; stb[((size_t)((b * 32 + c) * 8 + h)) * 4096 + e] = pk2(run.x, run.y); run = run * dc[c] + t; }
    }
}
__device__ __forceinline__ void ssd_out(Frame& F, int l) {
    unsigned char* ws = ARGWS();
    const bf16* proj = (const bf16*)(ws + WS_PROJ); const float* dt = (const float*)(ws + WS_DT); const bf16* stb = (const bf16*)((unsigned char*)ARGOUT() + 32 * MiB); bf16* y = (bf16*)(ws + WS_Y);
    const float* cw = ARGF(7) + (size_t)l * 4 * 1024; const float* cb = ARGF(8) + (size_t)l * 1024; const float* alog = ARGF(10) + l * 8;
    const float* dsk = ARGF(11) + l * 8; const float* nw = ARGF(12) + (size_t)l * 512;
    const int lane = F.lane, w = F.wave, tid = F.tid, hi = lane >> 5, r32 = lane & 31;
    LAS float* acs = (LAS float*)(F.lds + RING_OFF);
    LAS float* dts = acs + 512;
    LAS float* rss = dts + 512;
    LAS unsigned* CBT = (LAS unsigned*)(F.lds + RING_OFF + 8192);
    LAS unsigned char* Ct = F.lds + RING_OFF + 8192 + 20480;
    LAS unsigned char* Bt = Ct + 128 * ssd::RS_ROW;
    LAS unsigned char* Xh = Bt;
    LAS unsigned char* YT = Bt; constexpr int YT_RS = 528;
    static_assert(8192 + 20480 + 128 * ssd::RS_ROW + 128 * ssd::RS_XTR <= RING_BYTES, "stage Z LDS map");
    const int wq = w & 3, pt = w >> 2;
    for (int u = F.vcu; u < BATCH * 32 * 2; u += F.G) {
        const int b = u >> 6, c = (u >> 1) & 31, g = u & 1, rowg0 = b * SEQ + c * 128;
        v4u rawbc[11], rawx[11];
        ssd::conv_load(rawbc, proj, rowg0, c == 0, (tid & 255) >> 4, 512 + (tid >> 8) * 256 + g * 128 + 8 * (tid & 15));
        ssd::conv_load(rawx, proj, rowg0, c == 0, tid >> 5, g * 256 + 8 * (tid & 31));
        float dta = 0.f, dtb = 0.f, Ah = 0.f;
        if (w < 4) { dta = dt[(size_t)(rowg0 + lane) * 8 + 4 * g + w]; dtb = dt[(size_t)(rowg0 + 64 + lane) * 8 + 4 * g + w]; Ah = alog[4 * g + w]; }
        __syncthreads();
        if (tid < 128) rss[tid] = 0.f;
        if (w < 4) { const float A = -__expf(Ah); (void)ssd::chunk_acs(dta, dtb, A, acs + 128 * w, dts + 128 * w, lane); }
        { const int rb = (tid & 255) >> 4, ch = tid & 15, which = tid >> 8, c0 = 512 + which * 256 + g * 128 + 8 * ch;
          ssd::conv_compute(rawbc, cw, cb, rb, c0, (which ? Ct : Bt) + 16 * ch, ssd::RS_ROW, nullptr); }
        __syncthreads();
#pragma unroll 1
        for (int id = w; id < 10; id += NWAVES) {
            const int tl = (id >= 6) ? 3 : (id >= 3) ? 2 : (id >= 1) ? 1 : 0, ts = id - ((tl * (tl + 1)) >> 1);
            ssd::f32x16 t16;
#pragma unroll
            for (int r = 0; r < 16; ++r) t16[r] = 0.f;
#pragma unroll
            for (int k0 = 0; k0 < 8; ++k0) { const bf16x8 bfr = *(const LAS bf16x8*)(Bt + (32 * ts + r32) * ssd::RS_ROW + (16 * k0 + 8 * hi) * 2);
                const bf16x8 cfr = *(const LAS bf16x8*)(Ct + (32 * tl + r32) * ssd::RS_ROW + (16 * k0 + 8 * hi) * 2);
                t16 = SSD_MFMA(bfr, cfr, t16); }
#pragma unroll
            for (int q = 0; q < 8; ++q) CBT[(id * 8 + q) * 64 + lane] = att::cvtpk(t16[2 * q], t16[2 * q + 1]);
        }
        __syncthreads();
        { const int rb = tid >> 5, ch = tid & 31; ssd::conv_compute(rawx, cw, cb, rb, g * 256 + 8 * ch, Xh + 16 * ch, ssd::RS_XTR, nullptr); }
        __syncthreads();
        unsigned dmask = 0u;
#pragma unroll
        for (int r = 0; r < 16; ++r) dmask |= ((((r & 3) + 8 * (r >> 2) + 4 * hi) <= r32) ? 1u : 0u) << r;
        asm volatile("" : "+v"(dmask));
        bf16x8 sfr[8];
#pragma unroll
        for (int k0 = 0; k0 < 8; ++k0) sfr[k0] = *(const bf16x8*)(stb + ((size_t)((b * 32 + c) * 8 + 4 * g)) * 8192 + (size_t)(32 * pt + r32) * 128 + 8 * hi + 16 * k0);
        ssd::f32x16 yg0, yg1, yg2, yg3;
#pragma unroll
        for (int hl = 0; hl < 4; ++hl) {
            const int hh = 4 * g + hl, lt = (wq + hl) & 3, lrow = 32 * lt + r32;
            bf16x8 cf[8];
#pragma unroll
            for (int k0 = 0; k0 < 8; ++k0) cf[k0] = *(const LAS bf16x8*)(Ct + lrow * ssd::RS_ROW + (16 * k0 + 8 * hi) * 2);
            ssd::f32x16 acc;
#pragma unroll
            for (int r = 0; r < 16; ++r) acc[r] = 0.f;
#pragma unroll
            for (int k0 = 0; k0 < 8; ++k0) acc = SSD_MFMA(sfr[k0], cf[k0], acc);
            if (hl < 3) {
#pragma unroll
                for (int k0 = 0; k0 < 8; ++k0) sfr[k0] = *(const bf16x8*)(stb + ((size_t)((b * 32 + c) * 8 + hh + 1)) * 8192 + (size_t)(32 * pt + r32) * 128 + 8 * hi + 16 * k0); }
            const float al = acs[128 * hl + lrow]; const float el = __expf(al);
#pragma unroll
            for (int r = 0; r < 16; ++r) acc[r] *= el;
            LAS unsigned char* xa = Xh + (4 * hi + ((lane & 15) >> 2)) * ssd::RS_XTR + (hl * 64 + 32 * pt + 16 * ((lane >> 4) & 1) + 4 * (lane & 3)) * 2;
            const int tid0 = (lt * (lt + 1)) >> 1;
#pragma unroll
            for (int st = 0; st < 4; ++st) { if (st <= lt) {
                float sc[16];
#pragma unroll
                for (int g4 = 0; g4 < 4; ++g4) { const int s0 = 32 * st + 8 * g4 + 4 * hi;
                    const f32x4 as = *(const LAS f32x4*)(acs + 128 * hl + s0), ds = *(const LAS f32x4*)(dts + 128 * hl + s0);
                    const unsigned c01 = CBT[((tid0 + st) * 8 + 2 * g4) * 64 + lane], c23 = CBT[((tid0 + st) * 8 + 2 * g4 + 1) * 64 + lane];
                    const float cv[4] = {blo(c01), bhi(c01), blo(c23), bhi(c23)};
#pragma unroll
                    for (int e = 0; e < 4; ++e) sc[4 * g4 + e] = cv[e] * __expf(fminf(al - as[e], 0.f)) * ds[e]; }
                if (st == lt) {
#pragma unroll
                    for (int r = 0; r < 16; ++r) sc[r] = ((dmask >> r) & 1u) ? sc[r] : 0.f; }
#pragma unroll
                for (int s2 = 0; s2 < 2; ++s2) { v4u pw; pw.x = att::cvtpk(sc[8 * s2], sc[8 * s2 + 1]); pw.y = att::cvtpk(sc[8 * s2 + 2], sc[8 * s2 + 3]); pw.z = att::cvtpk(sc[8 * s2 + 4], sc[8 * s2 + 5]); pw.w = att::cvtpk(sc[8 * s2 + 6], sc[8 * s2 + 7]);
                    const bf16x8 xf = ssd::trpair(xa + (32 * st + 16 * s2) * ssd::RS_XTR, 8 * ssd::RS_XTR);
                    acc = SSD_MFMA(xf, __builtin_bit_cast(bf16x8, pw), acc); } } }
            const float Dk = dsk[hh]; float ssq = 0.f; ssd::f32x16 yv16;
#pragma unroll
            for (int g4 = 0; g4 < 4; ++g4) { float yv[4]; const unsigned long long zz = *(const unsigned long long*)(proj + (size_t)(rowg0 + lrow) * NPROJ + OFF_Z + hh * 64 + 32 * pt + 4 * hi + 8 * g4);
                const unsigned long long xx = *(const LAS unsigned long long*)(Xh + lrow * ssd::RS_XTR + (hl * 64 + 32 * pt + 8 * g4 + 4 * hi) * 2);
                const float zf[4] = {blo((unsigned)zz), bhi((unsigned)zz), blo((unsigned)(zz >> 32)), bhi((unsigned)(zz >> 32))};
                const float xf[4] = {blo((unsigned)xx), bhi((unsigned)xx), blo((unsigned)(xx >> 32)), bhi((unsigned)(xx >> 32))};
#pragma unroll
                for (int e = 0; e < 4; ++e) { const float v = (acc[4 * g4 + e] + Dk * xf[e]) * (zf[e] * __builtin_amdgcn_rcpf(1.0f + __builtin_amdgcn_exp2f(-1.4426950408889634f * zf[e]))); yv[e] = v; ssq += v * v; yv16[4 * g4 + e] = v; } }
            if (hl == 0) yg0 = yv16; else if (hl == 1) yg1 = yv16; else if (hl == 2) yg2 = yv16; else yg3 = yv16;
            ssq += __shfl_xor(ssq, 32);
            if (hi == 0) (void)__hip_atomic_fetch_add(rss + lrow, ssq, __ATOMIC_RELAXED, __HIP_MEMORY_SCOPE_WORKGROUP);
        }
        __syncthreads();
#pragma unroll
        for (int hl = 0; hl < 4; ++hl) {
            const int lrow = 32 * ((wq + hl) & 3) + r32;
            const float rstd = 1.0f / sqrtf(rss[lrow] * (1.0f / 256.0f) + EPS);
            LAS unsigned char* yr = YT + lrow * YT_RS + (hl * 64 + 32 * pt + 4 * hi) * 2;
            const float* nwp = nw + g * 256 + hl * 64 + 32 * pt + 4 * hi;
            const ssd::f32x16 yv = (hl == 0) ? yg0 : (hl == 1) ? yg1 : (hl == 2) ? yg2 : yg3;
            f32x4 wv4[4];
#pragma unroll
            for (int g4 = 0; g4 < 4; ++g4) wv4[g4] = *(const f32x4*)(nwp + 8 * g4);
#pragma unroll
            for (int g4 = 0; g4 < 4; ++g4) { const f32x4 wv = wv4[g4];
                *(LAS unsigned long long*)(yr + 16 * g4) = (unsigned long long)att::cvtpk(yv[4 * g4] * rstd * wv.x, yv[4 * g4 + 1] * rstd * wv.y) | ((unsigned long long)att::cvtpk(yv[4 * g4 + 2] * rstd * wv.z, yv[4 * g4 + 3] * rstd * wv.w) << 32); } }
        __syncthreads();
#pragma unroll
        for (int i = 0; i < 8; ++i) { const int p = tid + 512 * i, row = p >> 5, c16 = p & 31;
            *(v4u*)(y + (size_t)(rowg0 + row) * DM + 256 + g * 256 + 8 * c16) = *(const LAS v4u*)(YT + row * YT_RS + 16 * c16); }
    }
    __syncthreads();
}

constexpr int PH_PER_LAYER = 7, N_PHASES = 1 + DEPTH * PH_PER_LAYER;
#define IN(k) (lo <= (k) && (k) < hi)
#define FRESH() do { asm volatile("" : "+s"(F.wave), "+s"(F.vcu), "+s"(F.G)); F.lane = lane_id(); asm volatile("" : "+v"(F.lane)); F.tid = F.wave * 64 + F.lane; bx = (int)blockIdx.x; asm volatile("" : "+s"(bx)); } while (0)
#define SEAM(k) do { if (IN(k) && IN((k) + 1)) { int w0_ = F.wave; asm volatile("" : "+s"(w0_)); xcd_barrier(bar, w0_ == 0 && lane_id() == 0); } } while (0)

template <int l> __device__ __forceinline__ void layer_phases(Frame& F, const int lo, const int hi, const XcdBarrier& bar) {
    int bx;
        const int pb = 1 + l * PH_PER_LAYER;
        if (IN(pb + 0)) { FRESH();
            unsigned char* ws = ARGWS(); unsigned char* wb = ws + WS_W + (size_t)l * W_LAYER;
            pg8::Gemm g{l == 0 ? (const bf16*)(ws + WS_XB) : (const bf16*)ARGOUT(), (const bf16*)(wb + W_IN), M, NPROJ, DM}; pg8::StaticOrder S; S.init(M, NPROJ, F.G, bx);
            pg8::EpiProj E{(bf16*)(ws + WS_PROJ), l == 0 ? (const float*)(ws + WS_RSTD) : (const float*)(ws + WS_SSQ2), ARGF(3) + l * 64, ARGF(4) + l * 64, ARGF(5) + l * 64, ARGF(6) + l * 64, (float*)(ws + WS_KMS) + (size_t)l * (BATCH * 16 * 4 * 64)};
            pg8::gemm_phase<pg8::EpiProj, pg8::StaticOrder, true, true>(F.lds + RING_OFF, g, S, E, F.wave);
            if (l > 0) { __syncthreads(); FRESH(); dt_rows_b(F, (const bf16*)ARGOUT(), l); }
        }
        SEAM(pb + 0);
        if (IN(pb + 1)) { FRESH(); moba_build(F, l); FRESH(); mixA1_coop(F); FRESH(); ssd_states(F, l); }
        SEAM(pb + 1);
        if (IN(pb + 2)) { FRESH(); ssd_scan(F); FRESH(); moba_lists(F, l); FRESH(); mixA23_mfma(F); }
        SEAM(pb + 2);
        if (IN(pb + 3)) { FRESH(); moba_own256_merge(F, l); FRESH(); ssd_out(F, l); }
        SEAM(pb + 3);
        if (IN(pb + 4)) { FRESH();
            unsigned char* ws = ARGWS(); unsigned char* wb = ws + WS_W + (size_t)l * W_LAYER; float* out = ARGOUT();
            pg8::Gemm g{(const bf16*)(ws + WS_Y), (const bf16*)(wb + W_OUT), M, DM, DM}; pg8::StaticOrder S; S.init(M, DM, F.G, bx);
            pg8::EpiRes1 E{l == 0 ? (const bf16*)(ws + WS_XB) : (const bf16*)out, (bf16*)(ws + WS_XB), (float*)(ws + WS_SSQ) + (size_t)l * M};
            pg8::gemm_phase<pg8::EpiRes1, pg8::StaticOrder, true, false>(F.lds + RING_OFF, g, S, E, F.wave);
        }
        SEAM(pb + 4);
        if (IN(pb + 5)) { FRESH();
            unsigned char* ws = ARGWS(); unsigned char* wb = ws + WS_W + (size_t)l * W_LAYER;
            pg8::Gemm g{(const bf16*)(ws + WS_XB), (const bf16*)(wb + W_1), M, FF, DM}; pg8::StaticOrder S; S.init(M, FF, F.G, bx);
            pg8::EpiRelu2 E{(bf16*)(ws + WS_H), (const float*)(ws + WS_SSQ) + (size_t)l * M};
            pg8::gemm_phase<pg8::EpiRelu2, pg8::StaticOrder, true, true>(F.lds + RING_OFF, g, S, E, F.wave);
        }
        SEAM(pb + 5);
        if (IN(pb + 6)) { FRESH();
            unsigned char* ws = ARGWS(); unsigned char* wb = ws + WS_W + (size_t)l * W_LAYER;
            pg8::Gemm g{(const bf16*)(ws + WS_H), (const bf16*)(wb + W_2), M, DM, FF}; pg8::StaticOrder S; S.init(M, DM, F.G, bx);
            pg8::EpiRes2 E{ARGOUT(), (const bf16*)(ws + WS_XB), (l + 1 < DEPTH) ? (bf16*)ARGOUT() : (bf16*)nullptr, (float*)(ws + WS_SSQ2)};
            pg8::gemm_phase<pg8::EpiRes2, pg8::StaticOrder, true, true>(F.lds + RING_OFF, g, S, E, F.wave);
        }
        SEAM(pb + 6);
}

struct Args { const float* in[17]; float* out; unsigned char* ws; int ph_lo, ph_hi; };
__global__ void __launch_bounds__(NWAVES * 64, 2) mk_fwd(Args args) {
    extern __shared__ __attribute__((aligned(16))) unsigned char lds[];
    Frame F;
    F.lds = (LAS unsigned char*)lds;
    F.MISC = (volatile LAS unsigned*)(F.lds + MISC_OFF);
    F.tid = threadIdx.x; F.lane = F.tid & 63; F.wave = __builtin_amdgcn_readfirstlane(F.tid >> 6);
    F.G = gridDim.x; { const int bx = blockIdx.x; F.vcu = (F.G % 8 == 0) ? (bx % 8) * (F.G / 8) + bx / 8 : bx; }
    for (int u = F.tid; u < (LDS_BYTES - LDSCTL_OFF) / 4; u += NWAVES * 64) ((LAS unsigned*)(F.lds + LDSCTL_OFF))[u] = 0u;
    __syncthreads();
    const int lo = args.ph_lo, hi = args.ph_hi;
    XcdBarrier bar; bar.bar = (unsigned*)(ARGWS() + WS_CTL) + CW_BAR; bar.x = 0; bar.st = nullptr;
    if (hi - lo > 1) bar = xcd_barrier_post((unsigned*)(ARGWS() + WS_CTL) + CW_BAR, F.MISC + 8);
    int bx;
    if (IN(0)) { FRESH(); p0_weights(F); __syncthreads(); pre_rows(F, ARGF(0), 0); }
    SEAM(0);
    layer_phases<0>(F, lo, hi, bar);
    layer_phases<1>(F, lo, hi, bar);
#undef IN
#undef SEAM
}

#ifndef MK_N_LAUNCHES
#define MK_N_LAUNCHES 1
#endif
extern "C" void kernel_launch(void* const* d_in, const int* in_sizes, int n_in, void* d_out, int out_size, void* d_ws, size_t ws_size, hipStream_t stream) {
    static int grid = 0;
    if (grid == 0) {
        if (n_in != 17 || in_sizes[0] != M * DM || out_size != M * DM || ws_size < WS_END) { fprintf(stderr, "kernel_launch: unexpected shapes (n_in %d, in0 %d, out %d, ws %zu)\n", n_in, n_in > 0 ? in_sizes[0] : -1, out_size, ws_size); grid = -1; return; }
        int dev = 0, cus = 0, per_cu = 0;
        if (hipGetDevice(&dev) != hipSuccess || hipDeviceGetAttribute(&cus, hipDeviceAttributeMultiprocessorCount, dev) != hipSuccess) { grid = -1; return; }
        if (hipFuncSetAttribute((const void*)mk_fwd, hipFuncAttributeMaxDynamicSharedMemorySize, LDS_BYTES) != hipSuccess) { fprintf(stderr, "kernel_launch: hipFuncSetAttribute failed\n"); grid = -1; return; }
        if (hipOccupancyMaxActiveBlocksPerMultiprocessor(&per_cu, (const void*)mk_fwd, NWAVES * 64, LDS_BYTES) != hipSuccess || per_cu < 1) { fprintf(stderr, "kernel_launch: occupancy query says %d blocks per CU\n", per_cu); }
        (void)hipGetLastError();
        if (cus < 256) { fprintf(stderr, "kernel_launch: built for 256 CUs, device has %d\n", cus); grid = -1; return; }
        grid = 256;
    }
    if (grid < 0) return;
    if (hipMemsetAsync((char*)d_ws + WS_CTL, 0, CTL_ZERO_BYTES, stream) != hipSuccess) { fprintf(stderr, "kernel_launch: memset failed\n"); return; }
    Args a{};
    for (int i = 0; i < 17; ++i) a.in[i] = (const float*)d_in[i];
    a.out = (float*)d_out; a.ws = (unsigned char*)d_ws;
    const int NL = MK_N_LAUNCHES;
    if (NL == 1) { a.ph_lo = 0; a.ph_hi = N_PHASES; hipLaunchKernelGGL(mk_fwd, dim3(grid), dim3(NWAVES * 64), LDS_BYTES, stream, a); }
    else { for (int p = 0; p < N_PHASES; ++p) { a.ph_lo = p; a.ph_hi = p + 1; hipLaunchKernelGGL(mk_fwd, dim3(grid), dim3(NWAVES * 64), LDS_BYTES, stream, a); } }
    const hipError_t le = hipPeekAtLastError();
    if (le != hipSuccess) fprintf(stderr, "kernel_launch: launch failed: %s\n", hipGetErrorName(le));
}
```
